# Optimizing an MI355X kernel written in HIP

```python
import math
import jax, jax.numpy as jnp
from jax import lax
import numpy as np

D_MODEL = 1024
BATCH = 8
SEQ = 8192
DEPTH = 2

HEAD_DIM = 64
MIX_WIDTH = D_MODEL
N_HEADS_A = (MIX_WIDTH // 2) // HEAD_DIM
N_KV_A = N_HEADS_A // 4
N_HEADS_B = (MIX_WIDTH // 2) // (2 * HEAD_DIM)
A_Q = N_HEADS_A * HEAD_DIM
A_KV = N_KV_A * HEAD_DIM
B_QK = N_HEADS_B * 2 * HEAD_DIM
B_V = N_HEADS_B * 2 * HEAD_DIM
IN_WIDTH = A_Q + 2 * A_KV + 2 * B_QK + B_V
D_FF = 7 * D_MODEL // 2
N_EXPERTS = 8
TOP_K = 2
EXPERT_BLOCK = 512
Q_BLOCK = 128
GRID_W = 64
ROPE_THETA = 10000.0
EPS = 1e-6
N_DENSE = (DEPTH + 1) // 2
N_MOE = DEPTH // 2

kernel_name = "hybrid_gqa_axial_diffattn_moe_encoder"


def rms_norm(x, g):
    xf = x.astype(jnp.float32)
    y = xf * lax.rsqrt(jnp.mean(xf * xf, axis=-1, keepdims=True) + EPS)
    return (y * g.astype(jnp.float32)).astype(x.dtype)


def rope_freqs(pos, dim):
    inv = ROPE_THETA ** (-jnp.arange(0, dim, 2, dtype=jnp.float32) / dim)
    ang = pos.astype(jnp.float32)[:, None] * inv[None, :]
    return jnp.cos(ang), jnp.sin(ang)


def apply_rope(x, cos, sin):
    half = x.shape[-1] // 2
    shape = (1, x.shape[1]) + (1,) * (x.ndim - 3) + (half,)
    c = cos.reshape(shape).astype(x.dtype)
    s = sin.reshape(shape).astype(x.dtype)
    x1, x2 = x[..., :half], x[..., half:]
    return jnp.concatenate([x1 * c - x2 * s, x2 * c + x1 * s], axis=-1)


def apply_axial_rope(x, row_cs, col_cs):
    half = x.shape[-1] // 2
    return jnp.concatenate([apply_rope(x[..., :half], *row_cs),
                            apply_rope(x[..., half:], *col_cs)], axis=-1)


def gqa_attention(q, k, v):
    b, s, hq, d = q.shape
    hkv = k.shape[2]
    g = hq // hkv
    nb = s // Q_BLOCK
    scale = d ** -0.5
    qb = jnp.moveaxis(q.reshape(b, nb, Q_BLOCK, hkv, g, d), 1, 0)

    def block(qblk):
        sc = jnp.einsum('bqhgd,bkhd->bhgqk', qblk, k, preferred_element_type=jnp.float32) * scale
        p = jax.nn.softmax(sc, axis=-1).astype(v.dtype)
        return jnp.einsum('bhgqk,bkhd->bqhgd', p, v)

    o = lax.map(block, qb)
    return jnp.moveaxis(o, 0, 1).reshape(b, s, hq * d)


def diff_attention(q, k, v, lam):
    b, s, h, _, d = q.shape
    nb = s // Q_BLOCK
    scale = d ** -0.5
    qb = jnp.moveaxis(q.reshape(b, nb, Q_BLOCK, h, 2, d), 1, 0)

    def block(qblk):
        sc = jnp.einsum('bqhmd,bkhmd->bhmqk', qblk, k, preferred_element_type=jnp.float32) * scale
        p = jax.nn.softmax(sc, axis=-1)
        a = (p[:, :, 0] - lam * p[:, :, 1]).astype(v.dtype)
        return jnp.einsum('bhqk,bkhe->bqhe', a, v)

    o = lax.map(block, qb)
    return jnp.moveaxis(o, 0, 1).reshape(b, s, h, v.shape[-1])


def swiglu(x, w_gate, w_up, w_down):
    return (jax.nn.silu(x @ w_gate) * (x @ w_up)) @ w_down


def moe_swiglu(x2d, w_router, w_gate, w_up, w_down):
    n, d = x2d.shape
    logits = jnp.matmul(x2d, w_router, preferred_element_type=jnp.float32)
    top_logit, top_e = lax.top_k(logits, TOP_K)
    top_w = jax.nn.softmax(top_logit, axis=-1)
    nk = n * TOP_K
    flat_e = top_e.reshape(nk)
    flat_tok = jnp.repeat(jnp.arange(n, dtype=jnp.int32), TOP_K)
    flat_w = top_w.reshape(nk)
    order = jnp.argsort(flat_e, stable=True)
    sorted_e = flat_e[order]
    counts = jnp.zeros((N_EXPERTS,), jnp.int32).at[flat_e].add(1)
    padded = ((counts + EXPERT_BLOCK - 1) // EXPERT_BLOCK) * EXPERT_BLOCK
    pad_end = jnp.cumsum(padded)
    pad_start = pad_end - padded
    grp_start = jnp.cumsum(counts) - counts
    rank = jnp.arange(nk, dtype=jnp.int32) - grp_start[sorted_e]
    dest = pad_start[sorted_e] + rank
    n_blocks = -(-nk // EXPERT_BLOCK) + N_EXPERTS
    cap = n_blocks * EXPERT_BLOCK
    slot_tok = jnp.zeros((cap,), jnp.int32).at[dest].set(flat_tok[order])
    slot_w = jnp.zeros((cap,), jnp.float32).at[dest].set(flat_w[order])
    block_start = jnp.arange(n_blocks, dtype=jnp.int32) * EXPERT_BLOCK
    block_expert = jnp.minimum(jnp.searchsorted(pad_end, block_start, side='right'), N_EXPERTS - 1)
    xs = x2d[slot_tok].reshape(n_blocks, EXPERT_BLOCK, d)

    def expert_block(args):
        xb, e = args
        return swiglu(xb, w_gate[e], w_up[e], w_down[e])

    ys = lax.map(expert_block, (xs, block_expert)).reshape(cap, d)
    ys = ys * slot_w[:, None].astype(ys.dtype)
    return jnp.zeros((n, d), x2d.dtype).at[slot_tok].add(ys)


def setup_inputs(seed: int = 0) -> dict:
    key = jax.random.key(seed)
    ks = jax.random.split(key, 20)
    f32 = jnp.float32

    def nrm(k, shape, scale):
        return jax.random.normal(k, shape, f32) * scale

    def gain(k, shape):
        return 1.0 + 0.05 * jax.random.normal(k, shape, f32)

    return {
        "x": jax.random.normal(ks[0], (BATCH, SEQ, D_MODEL), f32),
        "w_in": nrm(ks[1], (DEPTH, D_MODEL, IN_WIDTH), D_MODEL ** -0.5),
        "w_out": nrm(ks[2], (DEPTH, MIX_WIDTH, D_MODEL), MIX_WIDTH ** -0.5),
        "g_pre_mix": gain(ks[3], (DEPTH, D_MODEL)),
        "g_post_mix": gain(ks[4], (DEPTH, D_MODEL)),
        "g_pre_ffn": gain(ks[5], (DEPTH, D_MODEL)),
        "g_post_ffn": gain(ks[6], (DEPTH, D_MODEL)),
        "g_qnorm_a": gain(ks[7], (DEPTH, HEAD_DIM)),
        "g_knorm_a": gain(ks[8], (DEPTH, HEAD_DIM)),
        "g_out_a": gain(ks[9], (DEPTH, A_Q)),
        "diff_lambda": nrm(ks[10], (DEPTH, 4, HEAD_DIM), 0.1),
        "g_subln_b": gain(ks[11], (DEPTH, 2 * HEAD_DIM)),
        "w_gate_dense": nrm(ks[12], (N_DENSE, D_MODEL, D_FF), D_MODEL ** -0.5),
        "w_up_dense": nrm(ks[13], (N_DENSE, D_MODEL, D_FF), D_MODEL ** -0.5),
        "w_down_dense": nrm(ks[14], (N_DENSE, D_FF, D_MODEL), D_FF ** -0.5),
        "w_router": nrm(ks[15], (N_MOE, D_MODEL, N_EXPERTS), D_MODEL ** -0.5),
        "w_gate_moe": nrm(ks[16], (N_MOE, N_EXPERTS, D_MODEL, D_FF), D_MODEL ** -0.5),
        "w_up_moe": nrm(ks[17], (N_MOE, N_EXPERTS, D_MODEL, D_FF), D_MODEL ** -0.5),
        "w_down_moe": nrm(ks[18], (N_MOE, N_EXPERTS, D_FF, D_MODEL), D_FF ** -0.5),
    }


def reference(x, w_in, w_out, g_pre_mix, g_post_mix, g_pre_ffn, g_post_ffn,
              g_qnorm_a, g_knorm_a, g_out_a, diff_lambda, g_subln_b,
              w_gate_dense, w_up_dense, w_down_dense,
              w_router, w_gate_moe, w_up_moe, w_down_moe):
    b, s, d = x.shape
    rows = s // GRID_W
    row_idx = jnp.repeat(jnp.arange(rows, dtype=jnp.int32), GRID_W)
    col_idx = jnp.tile(jnp.arange(GRID_W, dtype=jnp.int32), rows)
    row_cs = rope_freqs(row_idx, HEAD_DIM // 2)
    col_cs = rope_freqs(col_idx, HEAD_DIM // 2)
    seq_cs = rope_freqs(jnp.arange(s, dtype=jnp.int32), HEAD_DIM)
    splits = np.cumsum([A_Q, A_KV, A_KV, B_QK, B_QK]).tolist()

    h = x
    for i in range(DEPTH):
        hn = rms_norm(h, g_pre_mix[i])
        proj = hn @ w_in[i]
        qa, ka, va, qb, kb, vb = jnp.split(proj, splits, axis=-1)

        qa = rms_norm(qa.reshape(b, s, N_HEADS_A, HEAD_DIM), g_qnorm_a[i])
        ka = rms_norm(ka.reshape(b, s, N_KV_A, HEAD_DIM), g_knorm_a[i])
        qa = apply_axial_rope(qa, row_cs, col_cs)
        ka = apply_axial_rope(ka, row_cs, col_cs)
        va = va.reshape(b, s, N_KV_A, HEAD_DIM)
        oa = rms_norm(gqa_attention(qa, ka, va), g_out_a[i])

        lam_init = 0.8 - 0.6 * math.exp(-0.3 * i)
        lp = diff_lambda[i].astype(jnp.float32)
        lam = jnp.exp(jnp.sum(lp[0] * lp[1])) - jnp.exp(jnp.sum(lp[2] * lp[3])) + lam_init
        qb = apply_rope(qb.reshape(b, s, N_HEADS_B, 2, HEAD_DIM), *seq_cs)
        kb = apply_rope(kb.reshape(b, s, N_HEADS_B, 2, HEAD_DIM), *seq_cs)
        vb = vb.reshape(b, s, N_HEADS_B, 2 * HEAD_DIM)
        ob = diff_attention(qb, kb, vb, lam)
        ob = (rms_norm(ob, g_subln_b[i]) * (1.0 - lam_init)).reshape(b, s, B_V)

        mix = jnp.concatenate([oa, ob], axis=-1) @ w_out[i]
        h = h + rms_norm(mix, g_post_mix[i])

        hn = rms_norm(h, g_pre_ffn[i])
        if i % 2 == 0:
            j = i // 2
            f = swiglu(hn, w_gate_dense[j], w_up_dense[j], w_down_dense[j])
        else:
            j = i // 2
            f = moe_swiglu(hn.reshape(b * s, d), w_router[j], w_gate_moe[j],
                           w_up_moe[j], w_down_moe[j]).reshape(b, s, d)
        h = h + rms_norm(f, g_post_ffn[i])
    return h
```

```cpp
#include <hip/hip_runtime.h>
#include <hip/hip_bf16.h>
#include <cstdio>
#include <cstdint>
#include <cmath>
namespace pg8 {
#define PG8_LAS __attribute__((address_space(3)))
typedef unsigned short bf16_t;
typedef short bf16x8 __attribute__((ext_vector_type(8)));
typedef float f32x4 __attribute__((ext_vector_type(4)));
typedef unsigned u32x4 __attribute__((ext_vector_type(4)));
constexpr int BM = 256, BK = 64, HALF = 128, HTB = HALF * BK * 2  , STAGE_BYTES = 8 * HTB, NXCD = 8, WGM = 8;

__host__ __device__ __forceinline__ int lds_byte(int r, int c) { const int st = (r >> 4) * 2 + (c >> 5), rr = r & 15, cc = c & 31, ob = rr * 64 + cc * 2; return st * 1024 + (ob ^ (((ob >> 9) & 1) << 5)); }
__host__ __device__ __forceinline__ void stage_rc(int b, int& R, int& C) { const int st = b / 1024, sb = b % 1024, swz = sb ^ (((sb >> 9) & 1) << 5); R = (st >> 1) * 16 + swz / 64; C = (st & 1) * 32 + (swz % 64) / 2; }
__host__ __device__ __forceinline__ int perm32(int rho) { const int n = rho >> 4, i = rho & 15; return 8 * (i >> 2) + 4 * n + (i & 3); }

struct Unit { int pm, pn; };
struct Gemm { const bf16_t* A; const bf16_t* Bt; int M, N, K; };

struct StaticOrder {
    int nM, nN, nwg, G, c, pm0; const PG8_LAS int* te; unsigned estride;
    __device__ void init(int nM_, int nN_, int G_, int c_, int pm0_) { nM = nM_; nN = nN_; nwg = nM * nN; G = G_; c = c_; pm0 = pm0_; estride = 0; te = nullptr; }
    __device__ bool next(int i, Unit& u) const {
        const long L = (long)i * G + c; if (L >= nwg) return false;
        int wgid = (int)L; { const int q = nwg / NXCD, r = nwg % NXCD, xcd = wgid % NXCD, off = wgid / NXCD; wgid = (xcd < r ? xcd * (q + 1) : r * (q + 1) + (xcd - r) * q) + off; }
        const int nig = WGM * nN, gid = wgid / nig, fm = gid * WGM, gsz = (nM - fm) < WGM ? (nM - fm) : WGM;
        u.pm = pm0 + fm + ((wgid % nig) % gsz); u.pn = (wgid % nig) / gsz; return true;
    }
    __device__ __forceinline__ size_t bofs(const Unit& u) const { if (estride == 0) return 0; const int e = __builtin_amdgcn_readfirstlane(te[u.pm]); return (size_t)e * estride; }
    __device__ __forceinline__ void a_ready(const Unit&) const {}
    __device__ __forceinline__ void done(const Unit&) const {}
};

__device__ __forceinline__ unsigned cvt_pk_bf16(float lo, float hi) { unsigned r; asm volatile("v_cvt_pk_bf16_f32 %0, %1, %2" : "=v"(r) : "v"(lo), "v"(hi)); return r; }

struct EpiBf16 {
    static constexpr bool PERM = true, AFTER_DRAIN = false;
    bf16_t* O; int ldc;
    __device__ __forceinline__ void operator()(const f32x4 (&acc)[2][2][4][2], const Unit& u, int wr, int wc, int fr, int fq) const {
        const int row0 = u.pm * BM + wr * 64 + fr; const int col0 = u.pn * BM + wc * 32 + 8 * fq;
#pragma unroll
        for (int ai = 0; ai < 2; ++ai)
#pragma unroll
            for (int m = 0; m < 4; ++m) { bf16_t* rowp = O + (size_t)(row0 + ai * HALF + m * 16) * ldc + col0;
#pragma unroll
                for (int bj = 0; bj < 2; ++bj) { const f32x4 v0 = acc[ai][bj][m][0], v1 = acc[ai][bj][m][1];
                    u32x4 w; w.x = cvt_pk_bf16(v0[0], v0[1]); w.y = cvt_pk_bf16(v0[2], v0[3]); w.z = cvt_pk_bf16(v1[0], v1[1]); w.w = cvt_pk_bf16(v1[2], v1[3]);
                    *(u32x4*)(rowp + bj * HALF) = w; } }
    }
};
__device__ __forceinline__ float silu_mul(float g, float u) { const float e = __builtin_amdgcn_exp2f(-1.4426950408889634f * g); return g * __builtin_amdgcn_rcpf(1.0f + e) * u; }
struct EpiSwiGLU {
    static constexpr bool PERM = true, AFTER_DRAIN = false;
    bf16_t* O; int ldc;
    __device__ __forceinline__ void operator()(const f32x4 (&acc)[2][2][4][2], const Unit& u, int wr, int wc, int fr, int fq) const {
        const int row0 = u.pm * BM + wr * 64 + fr; const int col0 = u.pn * HALF + wc * 32 + 8 * fq;
#pragma unroll
        for (int ai = 0; ai < 2; ++ai)
#pragma unroll
            for (int m = 0; m < 4; ++m) { bf16_t* rowp = O + (size_t)(row0 + ai * HALF + m * 16) * ldc + col0;
                const f32x4 g0 = acc[ai][0][m][0], g1 = acc[ai][0][m][1], u0 = acc[ai][1][m][0], u1 = acc[ai][1][m][1];
                u32x4 w; w.x = cvt_pk_bf16(silu_mul(g0[0], u0[0]), silu_mul(g0[1], u0[1])); w.y = cvt_pk_bf16(silu_mul(g0[2], u0[2]), silu_mul(g0[3], u0[3]));
                w.z = cvt_pk_bf16(silu_mul(g1[0], u1[0]), silu_mul(g1[1], u1[1])); w.w = cvt_pk_bf16(silu_mul(g1[2], u1[2]), silu_mul(g1[3], u1[3]));
                *(u32x4*)rowp = w; }
    }
};
struct EpiInProj {
    static constexpr bool PERM = false, AFTER_DRAIN = false;
    unsigned char* ws; size_t oQA, oKA, oVA, oQB, oKB, oVB; const float* gq; const float* gk; float qscale;
    __device__ __forceinline__ void operator()(const f32x4 (&acc)[2][2][4][2], const Unit& u, int wr, int wc, int fr_, int fq_) const {
        int fr = fr_, fq = fq_; asm volatile("" : "+v"(fr), "+v"(fq));
        const int pn = u.pn; int kind, pitch, col0; bf16_t* base;
        if (pn < 2) { kind = 0; base = (bf16_t*)(ws + oQA); pitch = 512; col0 = 64 * (4 * pn + wc); }
        else if (pn == 2) { if (wc < 2) { kind = 1; base = (bf16_t*)(ws + oKA); pitch = 128; col0 = 64 * wc; } else { kind = 2; base = (bf16_t*)(ws + oVA); pitch = 128; col0 = 64 * (wc - 2); } }
        else if (pn < 5) { kind = 3; base = (bf16_t*)(ws + oQB); pitch = 512; col0 = 64 * (4 * (pn - 3) + wc); }
        else if (pn < 7) { kind = 4; base = (bf16_t*)(ws + oKB); pitch = 512; col0 = 64 * (4 * (pn - 5) + wc); }
        else { kind = 2; base = (bf16_t*)(ws + oVB); pitch = 512; col0 = 64 * (4 * (pn - 7) + wc); }
        const int row0 = u.pm * BM + wr * 64 + fr;
        bf16_t* outp = base + (size_t)row0 * pitch + col0 + 16 * fq;
        const float L2T = 13.287712379549449f;
        if (kind == 2) {
#pragma unroll
            for (int ai = 0; ai < 2; ++ai)
#pragma unroll
                for (int m = 0; m < 4; ++m) { bf16_t* rp = outp + (size_t)(ai * HALF + m * 16) * pitch;
#pragma unroll
                    for (int bj = 0; bj < 2; ++bj) { const f32x4 v0 = acc[ai][bj][m][0], v1 = acc[ai][bj][m][1];
                        u32x4 w; w.x = cvt_pk_bf16(v0[0], v0[1]); w.y = cvt_pk_bf16(v0[2], v0[3]); w.z = cvt_pk_bf16(v1[0], v1[1]); w.w = cvt_pk_bf16(v1[2], v1[3]);
                        *(u32x4*)(rp + 8 * bj) = w; } }
        } else if (kind <= 1) {
            const float* g = kind == 0 ? gq : gk; const float sc = kind == 0 ? qscale : 1.0f;
            float inv[4];
#pragma unroll
            for (int e = 0; e < 4; ++e) inv[e] = __builtin_amdgcn_exp2f(-(float)(4 * fq + e) * (L2T / 16.0f)) * 0.15915494309189535f;
#pragma unroll
            for (int ai = 0; ai < 2; ++ai)
#pragma unroll
                for (int m = 0; m < 4; ++m) { const int row = row0 + ai * HALF + m * 16; const int t = row & 8191; const float pr = (float)(t >> 6), pc = (float)(t & 63);
                    f32x4 v[2][2]; float ss = 0.f;
#pragma unroll
                    for (int bj = 0; bj < 2; ++bj)
#pragma unroll
                        for (int n = 0; n < 2; ++n) { v[bj][n] = acc[ai][bj][m][n]; ss += (v[bj][n][0] * v[bj][n][0] + v[bj][n][1] * v[bj][n][1]) + (v[bj][n][2] * v[bj][n][2] + v[bj][n][3] * v[bj][n][3]); }
                    ss += __shfl_xor(ss, 16); ss += __shfl_xor(ss, 32);
                    const float rinv = __builtin_amdgcn_rsqf(ss * (1.0f / 64.0f) + 1e-6f) * sc;
#pragma unroll
                    for (int bj = 0; bj < 2; ++bj) { const float pos = bj == 0 ? pr : pc; const f32x4 gv0 = *(const f32x4*)(g + 32 * bj + 4 * fq), gv1 = *(const f32x4*)(g + 32 * bj + 16 + 4 * fq);
#pragma unroll
                        for (int e = 0; e < 4; ++e) { float rev = pos * inv[e]; rev = rev - __builtin_floorf(rev);
                            const float sn = __builtin_amdgcn_sinf(rev), cs = __builtin_amdgcn_cosf(rev);
                            const float x1 = v[bj][0][e] * rinv * gv0[e], x2 = v[bj][1][e] * rinv * gv1[e];
                            v[bj][0][e] = x1 * cs - x2 * sn; v[bj][1][e] = x2 * cs + x1 * sn; } }
                    bf16_t* rp = outp + (size_t)(ai * HALF + m * 16) * pitch;
#pragma unroll
                    for (int bj = 0; bj < 2; ++bj) { const f32x4 v0 = v[bj][0], v1 = v[bj][1];
                        u32x4 w; w.x = cvt_pk_bf16(v0[0], v0[1]); w.y = cvt_pk_bf16(v0[2], v0[3]); w.z = cvt_pk_bf16(v1[0], v1[1]); w.w = cvt_pk_bf16(v1[2], v1[3]);
                        *(u32x4*)(rp + 8 * bj) = w; }
                    __builtin_amdgcn_sched_barrier(0); }
        } else {
            const float sc = kind == 3 ? qscale : 1.0f;
            float inv[2][4];
#pragma unroll
            for (int n = 0; n < 2; ++n)
#pragma unroll
                for (int e = 0; e < 4; ++e) inv[n][e] = __builtin_amdgcn_exp2f(-(float)(16 * n + 4 * fq + e) * (L2T / 32.0f)) * 0.15915494309189535f;
#pragma unroll
            for (int ai = 0; ai < 2; ++ai)
#pragma unroll
                for (int m = 0; m < 4; ++m) { const int row = row0 + ai * HALF + m * 16; const float pos = (float)(row & 8191);
                    f32x4 v[2][2];
#pragma unroll
                    for (int n = 0; n < 2; ++n)
#pragma unroll
                        for (int e = 0; e < 4; ++e) { float rev = pos * inv[n][e]; rev = rev - __builtin_floorf(rev);
                            const float sn = __builtin_amdgcn_sinf(rev) * sc, cs = __builtin_amdgcn_cosf(rev) * sc;
                            const float x1 = acc[ai][0][m][n][e], x2 = acc[ai][1][m][n][e];
                            v[0][n][e] = x1 * cs - x2 * sn; v[1][n][e] = x2 * cs + x1 * sn; }
                    bf16_t* rp = outp + (size_t)(ai * HALF + m * 16) * pitch;
#pragma unroll
                    for (int bj = 0; bj < 2; ++bj) { const f32x4 v0 = v[bj][0], v1 = v[bj][1];
                        u32x4 w; w.x = cvt_pk_bf16(v0[0], v0[1]); w.y = cvt_pk_bf16(v0[2], v0[3]); w.z = cvt_pk_bf16(v1[0], v1[1]); w.w = cvt_pk_bf16(v1[2], v1[3]);
                        *(u32x4*)(rp + 8 * bj) = w; }
                    __builtin_amdgcn_sched_barrier(0); }
        }
    }
};

template <class Epi, class Sched, bool ALIGN_EPI = false, bool SP2 = false>
__device__ __forceinline__ void gemm_phase(PG8_LAS unsigned char* lds, const Gemm g, const Sched& S, const Epi& E) {
    int tid_ = threadIdx.x; asm volatile("" : "+v"(tid_));
    const int tid = tid_, wid = __builtin_amdgcn_readfirstlane(tid >> 6), lane = tid & 63, wr = wid >> 2, wc = wid & 3, fr = lane & 15, fq = lane >> 4;
    const int K = g.K, nt = K / BK;
    unsigned voffA[2], voffB[2];
#pragma unroll
    for (int i = 0; i < 2; ++i) { int R, C; stage_rc(tid * 16 + i * 8192, R, C); const int Rb = Epi::PERM ? ((R & ~31) + perm32(R & 31)) : R;
        voffA[i] = (unsigned)(R * K + C) * 2u; voffB[i] = (unsigned)(Rb * K + C) * 2u; }
    const size_t kstep = (size_t)(BK * 2);
    const size_t hstep = (size_t)HALF * K * 2;
    const size_t tstep = 2 * hstep;
    const unsigned ldsw = (unsigned)wid * 1024u;
    const int aoff = lds_byte(wr * 64 + fr, fq * 8), boff = lds_byte(wc * 32 + fr, fq * 8);
#define PG8_SA(b, h) (((b) * 2 + (h)) * HTB)
#define PG8_SB(b, h) ((4 + (b) * 2 + (h)) * HTB)
#define PG8_STAGE(bufoff, gbase, voff) do { _Pragma("unroll") for (int _i = 0; _i < 2; ++_i) \
        __builtin_amdgcn_global_load_lds((const unsigned*)((const char*)(gbase) + (voff)[_i]), (PG8_LAS unsigned*)(lds + (bufoff) + ldsw + _i * 8192), 16, 0, 0); } while (0)
#define PG8_LDA(dst, b, h) do { _Pragma("unroll") for (int m = 0; m < 4; ++m) _Pragma("unroll") for (int k = 0; k < 2; ++k) dst[m][k] = *(const PG8_LAS bf16x8*)(lds + PG8_SA(b, h) + aoff + m * 2048 + k * 1024); } while (0)
#define PG8_LDB(dst, b, h) do { _Pragma("unroll") for (int n = 0; n < 2; ++n) _Pragma("unroll") for (int k = 0; k < 2; ++k) dst[n][k] = *(const PG8_LAS bf16x8*)(lds + PG8_SB(b, h) + boff + n * 2048 + k * 1024); } while (0)
#define PG8_MMA(ai, bj, At, Bt) do { __builtin_amdgcn_s_setprio(1); _Pragma("unroll") for (int m = 0; m < 4; ++m) _Pragma("unroll") for (int n = 0; n < 2; ++n) _Pragma("unroll") for (int k = 0; k < 2; ++k) \
        acc[ai][bj][m][n] = __builtin_amdgcn_mfma_f32_16x16x32_bf16(Bt[n][k], At[m][k], acc[ai][bj][m][n], 0, 0, 0); __builtin_amdgcn_s_setprio(0); } while (0)
#define PG8_WAIT_V(n) asm volatile("s_waitcnt vmcnt(" #n ")" ::: "memory")
#define PG8_WAIT_L(n) asm volatile("s_waitcnt lgkmcnt(" #n ")" ::: "memory")
#define PG8_BAR __builtin_amdgcn_s_barrier()
#define PG8_SCHED __builtin_amdgcn_sched_barrier(0)
    Unit cur, nxt; int ui = 0;
    if (!S.next(0, cur)) return;
    f32x4 acc[2][2][4][2];
#pragma unroll
    for (int a = 0; a < 2; ++a)
#pragma unroll
        for (int b = 0; b < 2; ++b)
#pragma unroll
            for (int m = 0; m < 4; ++m)
#pragma unroll
                for (int n = 0; n < 2; ++n) acc[a][b][m][n] = (f32x4){0.f, 0.f, 0.f, 0.f};
    bf16x8 At[4][2], B0[2][2], B1[2][2];
    const char* cA = (const char*)g.A + (size_t)cur.pm * tstep; const char* cB = (const char*)g.Bt + S.bofs(cur) + (size_t)cur.pn * tstep;
    S.a_ready(cur);
    if constexpr (SP2) {
        PG8_STAGE(PG8_SB(0, 0), cB, voffB); PG8_STAGE(PG8_SB(0, 1), cB + hstep, voffB); PG8_STAGE(PG8_SA(0, 0), cA, voffA); PG8_STAGE(PG8_SA(0, 1), cA + hstep, voffA);
        if (wr == 1) PG8_BAR;
        PG8_WAIT_V(2); PG8_BAR;
        PG8_STAGE(PG8_SB(1, 0), cB + kstep, voffB); PG8_STAGE(PG8_SA(1, 0), cA + kstep, voffA); PG8_STAGE(PG8_SB(1, 1), cB + hstep + kstep, voffB);
        PG8_WAIT_V(6); PG8_BAR;
    } else {
        PG8_STAGE(PG8_SB(0, 0), cB, voffB); PG8_STAGE(PG8_SA(0, 0), cA, voffA); PG8_STAGE(PG8_SB(0, 1), cB + hstep, voffB); PG8_STAGE(PG8_SA(0, 1), cA + hstep, voffA);
        if (wr == 1) PG8_BAR;
        PG8_WAIT_V(4); PG8_BAR;
        PG8_STAGE(PG8_SB(1, 0), cB + kstep, voffB); PG8_STAGE(PG8_SA(1, 0), cA + kstep, voffA); PG8_STAGE(PG8_SB(1, 1), cB + hstep + kstep, voffB);
        PG8_WAIT_V(6); PG8_BAR;
    }
    for (;;) {
        const bool has_next = S.next(ui + 1, nxt);
        const char* nA = has_next ? (const char*)g.A + (size_t)nxt.pm * tstep : cA; const char* nB = has_next ? (const char*)g.Bt + S.bofs(nxt) + (size_t)nxt.pn * tstep : cB;
        for (int t = 0; t < nt; t += 2) {
            const bool last = (t == nt - 2);
            const char* a1 = cA + (size_t)(t + 1) * kstep;
            const char* a2 = last ? nA : cA + (size_t)(t + 2) * kstep; const char* b2 = last ? nB : cB + (size_t)(t + 2) * kstep;
            const char* a3 = a2 + kstep; const char* b3 = b2 + kstep;
            if (last && has_next) S.a_ready(nxt);
            if constexpr (SP2) {
            PG8_LDB(B0, 0, 0); PG8_LDB(B1, 0, 1); PG8_SCHED; PG8_LDA(At, 0, 0); PG8_STAGE(PG8_SA(1, 1), a1 + hstep, voffA);
            PG8_WAIT_V(8); PG8_WAIT_L(0); PG8_BAR; PG8_MMA(0, 0, At, B0); PG8_MMA(0, 1, At, B1); PG8_BAR; PG8_SCHED;
            PG8_LDA(At, 0, 1); PG8_STAGE(PG8_SB(0, 0), b2, voffB); PG8_STAGE(PG8_SB(0, 1), b2 + hstep, voffB); PG8_STAGE(PG8_SA(0, 0), a2, voffA);
            PG8_WAIT_V(8); PG8_WAIT_L(0); PG8_BAR; PG8_MMA(1, 0, At, B0); PG8_MMA(1, 1, At, B1); PG8_BAR; PG8_SCHED;
            PG8_LDB(B0, 1, 0); PG8_LDB(B1, 1, 1); PG8_SCHED; PG8_LDA(At, 1, 0); PG8_STAGE(PG8_SA(0, 1), a2 + hstep, voffA);
            PG8_WAIT_V(8); PG8_WAIT_L(0); PG8_BAR; PG8_MMA(0, 0, At, B0); PG8_MMA(0, 1, At, B1); PG8_BAR; PG8_SCHED;
            PG8_LDA(At, 1, 1); PG8_STAGE(PG8_SB(1, 0), b3, voffB); PG8_STAGE(PG8_SB(1, 1), b3 + hstep, voffB); PG8_STAGE(PG8_SA(1, 0), a3, voffA);
            PG8_WAIT_V(8); PG8_WAIT_L(0); PG8_BAR; PG8_MMA(1, 0, At, B0); PG8_MMA(1, 1, At, B1); PG8_BAR; PG8_SCHED;
            } else {
            PG8_LDB(B0, 0, 0); PG8_SCHED; PG8_LDA(At, 0, 0); PG8_STAGE(PG8_SA(1, 1), a1 + hstep, voffA);
            PG8_WAIT_L(8); PG8_BAR; PG8_WAIT_L(0); PG8_MMA(0, 0, At, B0); PG8_BAR; PG8_SCHED;
            PG8_LDB(B1, 0, 1); PG8_STAGE(PG8_SB(0, 0), b2, voffB);
            PG8_BAR; PG8_WAIT_L(0); PG8_MMA(0, 1, At, B1); PG8_BAR;
            PG8_LDA(At, 0, 1); PG8_STAGE(PG8_SA(0, 0), a2, voffA);
            PG8_BAR; PG8_WAIT_L(0); PG8_MMA(1, 0, At, B0); PG8_BAR; PG8_SCHED;
            PG8_STAGE(PG8_SB(0, 1), b2 + hstep, voffB);
            PG8_WAIT_V(6); PG8_BAR; PG8_MMA(1, 1, At, B1); PG8_BAR;
            PG8_LDB(B0, 1, 0); PG8_SCHED; PG8_LDA(At, 1, 0); PG8_STAGE(PG8_SA(0, 1), a2 + hstep, voffA);
            PG8_WAIT_L(8); PG8_BAR; PG8_WAIT_L(0); PG8_MMA(0, 0, At, B0); PG8_BAR; PG8_SCHED;
            PG8_LDB(B1, 1, 1); PG8_STAGE(PG8_SB(1, 0), b3, voffB);
            PG8_BAR; PG8_WAIT_L(0); PG8_MMA(0, 1, At, B1); PG8_BAR;
            PG8_LDA(At, 1, 1); PG8_STAGE(PG8_SA(1, 0), a3, voffA);
            PG8_BAR; PG8_WAIT_L(0); PG8_MMA(1, 0, At, B0); PG8_BAR; PG8_SCHED;
            PG8_STAGE(PG8_SB(1, 1), b3 + hstep, voffB);
            PG8_WAIT_V(6); PG8_BAR; PG8_MMA(1, 1, At, B1); PG8_BAR;
            }
        }
        if constexpr (ALIGN_EPI) { if (wr == 0) PG8_BAR; }
        if constexpr (!Epi::AFTER_DRAIN) { E(acc, cur, wr, wc, fr, fq); S.done(cur); }
        if (!has_next) break;
#pragma unroll
        for (int a = 0; a < 2; ++a)
#pragma unroll
            for (int b = 0; b < 2; ++b)
#pragma unroll
                for (int m = 0; m < 4; ++m)
#pragma unroll
                    for (int n = 0; n < 2; ++n) acc[a][b][m][n] = (f32x4){0.f, 0.f, 0.f, 0.f};
        cur = nxt; cA = nA; cB = nB; ++ui;
        if constexpr (ALIGN_EPI) { if (wr == 1) PG8_BAR; }
    }
    PG8_WAIT_V(0);
    if constexpr (!ALIGN_EPI) { if (wr == 0) PG8_BAR; }
    PG8_BAR;
    if constexpr (Epi::AFTER_DRAIN) { E.fused(acc, cur, wr, wc, fr, fq, lds, wid, lane); S.done(cur); }
#undef PG8_SA
#undef PG8_SB
#undef PG8_STAGE
#undef PG8_LDA
#undef PG8_LDB
#undef PG8_MMA
#undef PG8_WAIT_V
#undef PG8_WAIT_L
#undef PG8_BAR
#undef PG8_SCHED
}
}
namespace attn_body {
using bf16=__hip_bfloat16;
using bf16x8=__attribute__((ext_vector_type(8)))short;
using s16x4=__attribute__((ext_vector_type(4)))short;
using f32x16=__attribute__((ext_vector_type(16)))float;
using u32x4=__attribute__((ext_vector_type(4)))unsigned;
constexpr int SEQ=8192,D=64;
constexpr int NW=8,QBLK=32,QB=QBLK*NW,KVBLK=64,NQB=SEQ/QB;
constexpr int ATTN_UNIT_ROWS=QB;
__device__ __forceinline__ int crow(int r,int hi){return (r&3)+8*(r>>2)+4*hi;}
#define SBAR() __builtin_amdgcn_sched_barrier(0)
__device__ __forceinline__ void cmask(f32x16&p0,f32x16&p1,int jb,int qrel,int hi){
  const float NEG=-INFINITY; int kb=64*jb+4*hi;
  #pragma unroll
  for(int r=0;r<16;++r){int kv=kb+(r&3)+8*(r>>2); if(kv>qrel)p0[r]=NEG; if(kv+32>qrel)p1[r]=NEG;}
}

constexpr int NSLOT=3, SLOTB=8192;
constexpr int LDS_K=0, LDS_V=NSLOT*SLOTB, LDS_WS=2*NSLOT*SLOTB, LDS_OST=LDS_WS+NW*64*4, LDS_BYTES=LDS_OST+NW*4096;
constexpr float C2=0.125f*1.4426950408889634f;
__device__ __forceinline__ void glds16(const void*gsrc,unsigned lds_dst){unsigned keep;
  asm volatile("s_mov_b32 %0, m0\n\ts_mov_b32 m0, %2\n\ts_nop 0\n\tglobal_load_lds_dwordx4 %1, off\n\ts_mov_b32 m0, %0":"=&s"(keep):"v"(gsrc),"s"(lds_dst):"memory");}
__device__ __forceinline__ float max3f(float a,float b,float c){float r;asm("v_max3_f32 %0, %1, %2, %3":"=v"(r):"v"(a),"v"(b),"v"(c));return r;}
__device__ __forceinline__ float max2f(float a,float b){float r;asm("v_max_f32_e32 %0, %1, %2":"=v"(r):"v"(a),"v"(b));return r;}
__device__ __forceinline__ float fadd_s(float a,float b){float r;asm("v_add_f32_e32 %0, %1, %2":"=v"(r):"v"(a),"v"(b));return r;}
__device__ __forceinline__ float fsub_s(float a,float b){float r;asm("v_sub_f32_e32 %0, %1, %2":"=v"(r):"v"(a),"v"(b));return r;}
typedef float f32x2_t __attribute__((ext_vector_type(2))); typedef __bf16 bf16x2_t __attribute__((ext_vector_type(2)));
__device__ __forceinline__ unsigned cvtpk_s(float lo,float hi){f32x2_t v={lo,hi};bf16x2_t b=__builtin_convertvector(v,bf16x2_t);return __builtin_bit_cast(unsigned,b);}
#define WAIT_BAR(N) asm volatile("s_waitcnt vmcnt(" #N ") lgkmcnt(0)\n\ts_barrier":::"memory")

__device__ __forceinline__ void qkt(f32x16&p0,f32x16&p1,const char*Kslot,const bf16x8*qr,const f32x16&negm,int r32,int hi){
  const char*kb=Kslot+hi*1024+r32*16;
  #pragma unroll
  for(int d0=0;d0<4;++d0){
    const bf16x8 b0=*reinterpret_cast<const bf16x8*>(kb+d0*2048);
    const bf16x8 b1=*reinterpret_cast<const bf16x8*>(kb+d0*2048+512);
    if(d0==0){p0=__builtin_amdgcn_mfma_f32_32x32x16_bf16(b0,qr[0],negm,0,0,0);p1=__builtin_amdgcn_mfma_f32_32x32x16_bf16(b1,qr[0],negm,0,0,0);}
    else{p0=__builtin_amdgcn_mfma_f32_32x32x16_bf16(b0,qr[d0],p0,0,0,0);p1=__builtin_amdgcn_mfma_f32_32x32x16_bf16(b1,qr[d0],p1,0,0,0);}}
}
typedef __attribute__((address_space(3))) const char* lds_cptr;
typedef short v4i16_t __attribute__((ext_vector_type(4)));
__device__ __forceinline__ void kload8(bf16x8*kf,lds_cptr kp){
  kf[0]=*(const __attribute__((address_space(3))) bf16x8*)(kp);      kf[1]=*(const __attribute__((address_space(3))) bf16x8*)(kp+512);
  kf[2]=*(const __attribute__((address_space(3))) bf16x8*)(kp+2048); kf[3]=*(const __attribute__((address_space(3))) bf16x8*)(kp+2560);
  kf[4]=*(const __attribute__((address_space(3))) bf16x8*)(kp+4096); kf[5]=*(const __attribute__((address_space(3))) bf16x8*)(kp+4608);
  kf[6]=*(const __attribute__((address_space(3))) bf16x8*)(kp+6144); kf[7]=*(const __attribute__((address_space(3))) bf16x8*)(kp+6656);
}
__device__ __forceinline__ void kload2(bf16x8*kf,lds_cptr kp,int j){ kf[2*j]=*(const __attribute__((address_space(3))) bf16x8*)(kp+j*2048); kf[2*j+1]=*(const __attribute__((address_space(3))) bf16x8*)(kp+j*2048+512); }
__device__ __forceinline__ s16x4 vtr(lds_cptr p){ return __builtin_bit_cast(s16x4,__builtin_amdgcn_ds_read_tr16_b64_v4i16((__attribute__((address_space(3))) v4i16_t*)p)); }
__device__ __forceinline__ float rowmax(const f32x16&p0,const f32x16&p1){
  float a=max3f(p0[0],p0[1],p1[0]),b=max3f(p0[2],p0[3],p1[1]);a=max3f(a,p1[2],p1[3]);
  #pragma unroll
  for(int r=4;r<16;r+=4){a=max3f(a,p0[r],p0[r+1]);b=max3f(b,p0[r+2],p0[r+3]);a=max3f(a,p1[r],p1[r+1]);b=max3f(b,p1[r+2],p1[r+3]);}
  const float m=max2f(a,b);
  auto rr=__builtin_amdgcn_permlane32_swap(__float_as_uint(m),__float_as_uint(m),false,false);
  return max2f(__uint_as_float(rr[0]),__uint_as_float(rr[1]));
}
__device__ __forceinline__ void pv(f32x16*o,int vb,bf16x8 pa0,bf16x8 pa1,bf16x8 pa2,bf16x8 pa3){
  #pragma unroll
  for(int d0=0;d0<2;++d0){s16x4 lo[4],hi[4];
    #pragma unroll
    for(int ks=0;ks<4;++ks){
      asm volatile("ds_read_b64_tr_b16 %0,%1 offset:%c2":"=&v"(lo[ks]):"v"(vb),"i"(d0*4096+ks*1024):"memory");
      asm volatile("ds_read_b64_tr_b16 %0,%1 offset:%c2":"=&v"(hi[ks]):"v"(vb),"i"(d0*4096+ks*1024+512):"memory");}
    asm volatile("s_waitcnt lgkmcnt(0)":::"memory");SBAR();
    #define PK(k) (bf16x8){lo[k][0],lo[k][1],lo[k][2],lo[k][3],hi[k][0],hi[k][1],hi[k][2],hi[k][3]}
    o[d0]=__builtin_amdgcn_mfma_f32_32x32x16_bf16(pa0,PK(0),o[d0],0,0,0);
    o[d0]=__builtin_amdgcn_mfma_f32_32x32x16_bf16(pa1,PK(1),o[d0],0,0,0);
    o[d0]=__builtin_amdgcn_mfma_f32_32x32x16_bf16(pa2,PK(2),o[d0],0,0,0);
    o[d0]=__builtin_amdgcn_mfma_f32_32x32x16_bf16(pa3,PK(3),o[d0],0,0,0);
    #undef PK
  }
}

#ifndef ATTN_STORE16
#define ATTN_STORE16(p,v) (*(u32x4*)(p)=(v))
#endif
template<int THRL> __device__ __forceinline__ void attn_unit(const bf16*Qu,int QP,const bf16*__restrict__ Kh,int KP,const bf16*__restrict__ Vh,int VP,bf16*Ou,int OP,char*shm){
  int tid_=threadIdx.x; asm volatile("":"+v"(tid_)); const int tid=tid_,lane=tid&63,r32=lane&31,hi=lane>>5; const int wid=__builtin_amdgcn_readfirstlane(tid>>6);
  const bf16*Qw=Qu+(long)(wid*QBLK)*QP;
  const unsigned lds0=(unsigned)(uintptr_t)shm;
  float*wsf=(float*)(shm+LDS_WS)+wid*64;
  const bf16*ksrc=Kh+(long)lane*KP+wid*8;
  const bf16*vsrc=Vh+(long)(16*(wid&3)+(lane>>2))*VP+(wid>>2)*32+(lane&3)*8;
  const unsigned kdst=lds0+LDS_K+wid*1024, vdst=lds0+LDS_V+wid*1024;
  #define DMA_K(t,slot) glds16(ksrc+(long)(t)*KVBLK*KP,(unsigned)__builtin_amdgcn_readfirstlane(kdst+(slot)))
  #define DMA_V(t,slot) glds16(vsrc+(long)(t)*KVBLK*VP,(unsigned)__builtin_amdgcn_readfirstlane(vdst+(slot)))
  const int vb0=(int)(lds0+LDS_V)+((lane>>4)&1)*32+(lane&3)*8+(4*hi+((lane&15)>>2))*64;
  const char*Kbase=shm+LDS_K; bf16x8 kf[8];
  const lds_cptr shm3=(lds_cptr)shm; const lds_cptr kp0=shm3+LDS_K+hi*1024+r32*16; const lds_cptr vp0=shm3+LDS_V+((lane>>4)&1)*32+(lane&3)*8+(4*hi+((lane&15)>>2))*64;
  constexpr int NT=SEQ/KVBLK;
  DMA_K(0,0);DMA_V(0,0);DMA_K(1,SLOTB);
  bf16x8 qr[4];
  #pragma unroll
  for(int d0=0;d0<4;++d0)qr[d0]=*reinterpret_cast<const bf16x8*>(&Qw[(long)r32*QP+d0*16+hi*8]);
  float mhat=0.f,l_reg=0.f;f32x16 o[2];o[0]=f32x16{};o[1]=f32x16{};f32x16 negm=f32x16{};asm volatile("":"+v"(negm));
  #define CMASK(P0,P1,t) do{}while(0)
  bool resc=false;
  #define START(P0,P1) do{ const float rm=rowmax(P0,P1); resc=false; \
    { const float dl=rm; mhat=fadd_s(mhat,dl); \
      _Pragma("unroll") for(int r=0;r<16;++r){P0[r]=fsub_s(P0[r],dl);P1[r]=fsub_s(P1[r],dl);} \
      _Pragma("unroll") for(int r=0;r<16;++r)negm[r]=-mhat; asm volatile("":"+v"(negm)); } \
    _Pragma("unroll") for(int r=0;r<16;++r)P0[r]=__builtin_amdgcn_exp2f(P0[r]); }while(0)
  #define RESC() do{ if(resc){ asm volatile("s_waitcnt lgkmcnt(0)":::"memory"); \
      _Pragma("unroll") for(int d_=0;d_<2;++d_) _Pragma("unroll") for(int r=0;r<16;++r)o[d_][r]*=wsf[crow(r,hi)]; } }while(0)
  f32x16 pA0,pA1,pB0,pB1;
  int sl_prev=0,sl_cur=0,sl_next=SLOTB;
  #define ROT() do{sl_prev=sl_cur;sl_cur=sl_next;sl_next=(sl_next==(NSLOT-1)*SLOTB)?0:sl_next+SLOTB;}while(0)
  DMA_K(2,2*SLOTB);
  WAIT_BAR(3);
  qkt(pA0,pA1,Kbase,qr,negm,r32,hi);asm volatile("s_nop 15\n\ts_nop 7":"+v"(pA0),"+v"(pA1));CMASK(pA0,pA1,0);
  START(pA0,pA1);
  _Pragma("unroll") for(int r=0;r<16;++r)pA1[r]=__builtin_amdgcn_exp2f(pA1[r]);
  WAIT_BAR(0);
  DMA_K(3,0);DMA_V(1,SLOTB);
  ROT();
  kload8(kf,kp0+sl_cur);
  WAIT_BAR(2);
  s16x4 vlo[8],vhi[8]; u32x4 pw0,pw1,pw2,pw3;
  #define PKW(P,B) cvtpk_s(P[B],P[B+1])
  #define PAF(k) __builtin_bit_cast(bf16x8,pw##k)
  #define VFR(i) (bf16x8){vlo[i][0],vlo[i][1],vlo[i][2],vlo[i][3],vhi[i][0],vhi[i][1],vhi[i][2],vhi[i][3]}
  #define PIN(x) asm volatile("":"+v"(x))
  #define MX3(a,b,c) __builtin_fmaxf(__builtin_fmaxf((a),(b)),(c))
  #define GAPA(MF,A0,A1,A2,A3,W0,W1,PW) do{ MF; sacc+=A0; sacc+=A1; sacc+=A2; sacc+=A3; PIN(sacc); W0; W1; PIN(PW); SBAR(); }while(0)
  #define EX(v) __builtin_amdgcn_exp2f(v)
  #define GAPB(MF,X,B) do{ MF; X[B]=EX(X[B]); X[B+1]=EX(X[B+1]); X[B+2]=EX(X[B+2]); X[B+3]=EX(X[B+3]); PIN(X); SBAR(); }while(0)
  #define VRD(i) do{ vlo[i]=vtr(vp_+(((i)>>2)*4096+((i)&3)*1024)); vhi[i]=vtr(vp_+(((i)>>2)*4096+((i)&3)*1024+512)); }while(0)
  #define KRD(G,j) do{ if(G){ kload2(kf,kp0+sl_next,j); SBAR(); } }while(0)
  #define STEP(C0,C1,P0,P1,t,GK,GV,GL) do{ SBAR(); \
    const lds_cptr vp_=vp0+sl_prev; \
    VRD(0); SBAR(); float sacc=(P0[0]+P0[1]); \
    GAPA(C0=__builtin_amdgcn_mfma_f32_32x32x16_bf16(kf[0],qr[0],negm,0,0,0), P0[2],P0[3],P0[4],P0[5],     pw0[0]=PKW(P0,0), pw0[1]=PKW(P0,2), pw0); \
    VRD(4); SBAR(); GAPA(C1=__builtin_amdgcn_mfma_f32_32x32x16_bf16(kf[1],qr[0],negm,0,0,0), P0[6],P0[7],P0[8],P0[9],     pw0[2]=PKW(P0,4), pw0[3]=PKW(P0,6), pw0); \
    VRD(1); SBAR(); GAPA(C0=__builtin_amdgcn_mfma_f32_32x32x16_bf16(kf[2],qr[1],C0,0,0,0),   P0[10],P0[11],P0[12],P0[13], pw1[0]=PKW(P0,8), pw1[1]=PKW(P0,10), pw1); \
    VRD(5); SBAR(); GAPA(C1=__builtin_amdgcn_mfma_f32_32x32x16_bf16(kf[3],qr[1],C1,0,0,0),   P0[14],P0[15],P1[0],P1[1],   pw1[2]=PKW(P0,12),pw1[3]=PKW(P0,14), pw1); \
    VRD(2); SBAR(); GAPA(C0=__builtin_amdgcn_mfma_f32_32x32x16_bf16(kf[4],qr[2],C0,0,0,0),   P1[2],P1[3],P1[4],P1[5],     pw2[0]=PKW(P1,0), pw2[1]=PKW(P1,2), pw2); \
    VRD(6); SBAR(); GAPA(C1=__builtin_amdgcn_mfma_f32_32x32x16_bf16(kf[5],qr[2],C1,0,0,0),   P1[6],P1[7],P1[8],P1[9],     pw2[2]=PKW(P1,4), pw2[3]=PKW(P1,6), pw2); \
    VRD(3); SBAR(); GAPA(C0=__builtin_amdgcn_mfma_f32_32x32x16_bf16(kf[6],qr[3],C0,0,0,0),   P1[10],P1[11],P1[12],P1[13], pw3[0]=PKW(P1,8), pw3[1]=PKW(P1,10), pw3); \
    VRD(7); SBAR(); GAPA(C1=__builtin_amdgcn_mfma_f32_32x32x16_bf16(kf[7],qr[3],C1,0,0,0),   P1[14],P1[15],0.f,0.f,       pw3[2]=PKW(P1,12),pw3[3]=PKW(P1,14), pw3); \
    l_reg+=sacc; \
    if(GK){DMA_K((t)+3,sl_cur);} if(GV){DMA_V((t)+1,sl_next);} \
    CMASK(C0,C1,t); \
    { float a=MX3(C0[0],C0[1],C1[0]),b=MX3(C0[2],C0[3],C1[1]); a=MX3(a,C1[2],C1[3]); \
      _Pragma("unroll") for(int r=4;r<16;r+=4){a=MX3(a,C0[r],C0[r+1]);b=MX3(b,C0[r+2],C0[r+3]);a=MX3(a,C1[r],C1[r+1]);b=MX3(b,C1[r+2],C1[r+3]);} \
      float rm=__builtin_fmaxf(a,b); { auto rr=__builtin_amdgcn_permlane32_swap(__float_as_uint(rm),__float_as_uint(rm),false,false); rm=__builtin_fmaxf(__uint_as_float(rr[0]),__uint_as_float(rr[1])); } \
      resc=false; \
      if(__builtin_expect(__any(rm>(float)THRL),0)){ const float dl=__builtin_fmaxf(rm,0.f); mhat+=dl; \
        _Pragma("unroll") for(int r=0;r<16;++r){C0[r]-=dl;C1[r]-=dl;} \
        _Pragma("unroll") for(int r=0;r<16;++r)negm[r]=-mhat; asm volatile("":"+v"(negm)); \
        const float f=__builtin_amdgcn_exp2f(-dl); l_reg*=f; if(hi==0)wsf[r32]=f; resc=true; } } \
    SBAR(); \
    GAPB(o[0]=__builtin_amdgcn_mfma_f32_32x32x16_bf16(PAF(0),VFR(0),o[0],0,0,0), C0,0); \
    GAPB(o[1]=__builtin_amdgcn_mfma_f32_32x32x16_bf16(PAF(0),VFR(4),o[1],0,0,0), C0,4); \
    KRD(GL,0); GAPB(o[0]=__builtin_amdgcn_mfma_f32_32x32x16_bf16(PAF(1),VFR(1),o[0],0,0,0), C0,8); \
    KRD(GL,1); GAPB(o[1]=__builtin_amdgcn_mfma_f32_32x32x16_bf16(PAF(1),VFR(5),o[1],0,0,0), C0,12); \
    KRD(GL,2); GAPB(o[0]=__builtin_amdgcn_mfma_f32_32x32x16_bf16(PAF(2),VFR(2),o[0],0,0,0), C1,0); \
    KRD(GL,3); GAPB(o[1]=__builtin_amdgcn_mfma_f32_32x32x16_bf16(PAF(2),VFR(6),o[1],0,0,0), C1,4); \
    GAPB(o[0]=__builtin_amdgcn_mfma_f32_32x32x16_bf16(PAF(3),VFR(3),o[0],0,0,0), C1,8); \
    GAPB(o[1]=__builtin_amdgcn_mfma_f32_32x32x16_bf16(PAF(3),VFR(7),o[1],0,0,0), C1,12); \
    }while(0)
  int t=1;
  for(;t+5<NT;t+=2){
    STEP(pB0,pB1,pA0,pA1,t,true,true,true);     WAIT_BAR(2); RESC(); ROT();
    STEP(pA0,pA1,pB0,pB1,t+1,true,true,true);   WAIT_BAR(2); RESC(); ROT();
  }
  #define ENDW(tt) do{ if((tt)+3<NT){WAIT_BAR(2);} else if((tt)+2<NT){WAIT_BAR(1);} else {WAIT_BAR(0);} }while(0)
  for(;t+1<NT;t+=2){
    STEP(pB0,pB1,pA0,pA1,t,(t+3<NT),(t+1<NT),(t+1<NT));       ENDW(t);   RESC(); ROT();
    STEP(pA0,pA1,pB0,pB1,t+1,(t+4<NT),(t+2<NT),(t+2<NT));     ENDW(t+1); RESC(); ROT();
  }
  STEP(pB0,pB1,pA0,pA1,NT-1,false,false,false); RESC();
  { float sacc=pB0[0]+pB0[1]; _Pragma("unroll") for(int r=2;r<16;++r)sacc+=pB0[r]; _Pragma("unroll") for(int r=0;r<16;++r)sacc+=pB1[r]; l_reg+=sacc;
    pw0=(u32x4){PKW(pB0,0),PKW(pB0,2),PKW(pB0,4),PKW(pB0,6)};pw1=(u32x4){PKW(pB0,8),PKW(pB0,10),PKW(pB0,12),PKW(pB0,14)};pw2=(u32x4){PKW(pB1,0),PKW(pB1,2),PKW(pB1,4),PKW(pB1,6)};pw3=(u32x4){PKW(pB1,8),PKW(pB1,10),PKW(pB1,12),PKW(pB1,14)};
    SBAR(); pv(o,vb0+sl_cur,PAF(0),PAF(1),PAF(2),PAF(3)); }
  #undef PKW
  #undef PAF
  #undef VFR
  #undef PIN
  #undef MX3
  #undef GAPA
  #undef GAPB
  #undef EX
  #undef VRD
  #undef KRD
  #undef STEP
  #undef ENDW
  {auto rr=__builtin_amdgcn_permlane32_swap(__float_as_uint(l_reg),__float_as_uint(l_reg),false,false);l_reg=__uint_as_float(rr[0])+__uint_as_float(rr[1]);}
  if(hi==0)wsf[32+r32]=l_reg;asm volatile("s_waitcnt lgkmcnt(0)":::"memory");
  float rli[16];
  #pragma unroll
  for(int r=0;r<16;++r)rli[r]=__builtin_amdgcn_rcpf(wsf[32+crow(r,hi)]);
  bf16*Ow=Ou+(long)(wid*QBLK)*OP;
  { bf16*stg=(bf16*)(shm+LDS_OST)+wid*2048;
    #pragma unroll
    for(int r=0;r<16;++r){const int orow=crow(r,hi);
      #pragma unroll
      for(int d0=0;d0<2;++d0)stg[orow*64+d0*32+r32]=__float2bfloat16(o[d0][r]*rli[r]);}
    asm volatile("s_waitcnt lgkmcnt(0)":::"memory");
    #pragma unroll
    for(int i=0;i<4;++i){const int row=i*8+(lane>>3),ch=lane&7; const u32x4 v=*(const u32x4*)(stg+row*64+ch*8); ATTN_STORE16(Ow+(long)row*OP+ch*8,v);} }
  asm volatile("s_waitcnt lgkmcnt(0)\n\ts_barrier":::"memory");
  #undef DMA_K
  #undef DMA_V
  #undef CMASK
  #undef START
  #undef RESC
  #undef ROT
}
constexpr int ATTN_LDS_BYTES=LDS_BYTES;
#undef SBAR
#undef WAIT_BAR
}
constexpr int NWAVES = 8;
constexpr int NTOK = 65536, SEQL = 8192, DM = 1024, INW = 2304, DFF = 3584, NEXP = 8, NLAYER = 2;
constexpr float EPS = 1e-6f;
constexpr size_t MiB = 1u << 20;
constexpr size_t WS_CTL = 0, CTL_ZERO_BYTES = 64 * 1024;
constexpr size_t WS_WIN = 1 * MiB;
constexpr size_t WS_WOUT = 10 * MiB;
constexpr size_t WS_WGU_D = 14 * MiB;
constexpr size_t WS_WDN_D = 28 * MiB;
constexpr size_t WS_WGU_M = 35 * MiB;
constexpr size_t WS_WDN_M = 147 * MiB;
constexpr size_t WS_HN = 203 * MiB;
constexpr size_t WS_QA = 331 * MiB, WS_QB = 395 * MiB, WS_KA = 459 * MiB, WS_VA = 475 * MiB, WS_KB = 491 * MiB, WS_VB = 555 * MiB;
constexpr size_t WS_OA = 619 * MiB, WS_OB = 683 * MiB;
constexpr size_t WS_AO = 331 * MiB;
constexpr size_t WS_MIX = 491 * MiB;
constexpr size_t WS_XS = 331 * MiB;
constexpr size_t WS_ACT = 595 * MiB;
constexpr size_t WS_F = 819 * MiB;
constexpr size_t WS_TOK = 947 * MiB;
constexpr size_t WS_WGB = 948 * MiB;
constexpr size_t WS_END = 949 * MiB;
constexpr int CHUNK_TILES = 128;
constexpr int CW_TMO = 0, CW_CODE = 1, CW_BAR = 4096, CW_CNT = 8192;
constexpr int RING_OFF = 0, RING_BYTES = 131072;
constexpr int LDSCTL_OFF = RING_BYTES, MISC_OFF = LDSCTL_OFF + 320;
constexpr int LDS_BYTES = 147456;
#define GAS __attribute__((address_space(1)))
#define LAS __attribute__((address_space(3)))
typedef unsigned short bf16;
typedef unsigned v4u __attribute__((ext_vector_type(4)));
typedef float f32x4 __attribute__((ext_vector_type(4)));
typedef short bf16x8 __attribute__((ext_vector_type(8)));
typedef GAS unsigned gu32;
typedef GAS unsigned long long gu64;
#define RLX_AGENT __ATOMIC_RELAXED, __HIP_MEMORY_SCOPE_AGENT
#define LDS_WAIT() asm volatile("s_waitcnt lgkmcnt(0)" ::: "memory")
#define VM_WAIT() asm volatile("s_waitcnt vmcnt(0)" ::: "memory")
__device__ __forceinline__ unsigned long long rt() { return __builtin_amdgcn_s_memrealtime(); }
__device__ __forceinline__ unsigned f2bf(float f) { unsigned u = __builtin_bit_cast(unsigned, f); return (u + 0x7fffu + ((u >> 16) & 1u)) >> 16; }
__device__ __forceinline__ unsigned pk2(float lo, float hi) { return f2bf(lo) | (f2bf(hi) << 16); }

#define XB_TMO      128
#define XB_XCNT(j)  (256  + 64 * (j))
#define XB_XSUB(j)  (1280 + 64 * (j))
#define XB_XGEN(j)  (2304 + 64 * (j))
#define XB_TOP      3328
#define XB_TOPGEN   3392
#define XCD_BAR_WORDS 3456
#define XB_SPIN_CAP (1u << 18)

__device__ __forceinline__ unsigned xb_ld(unsigned* p)              { return __hip_atomic_load(p, __ATOMIC_RELAXED, __HIP_MEMORY_SCOPE_AGENT); }
__device__ __forceinline__ unsigned xb_add(unsigned* p, unsigned v) { return __hip_atomic_fetch_add(p, v, __ATOMIC_RELAXED, __HIP_MEMORY_SCOPE_AGENT); }
__device__ __forceinline__ unsigned xb_xcc_id() { return (unsigned)__builtin_amdgcn_s_getreg((3 << 11) | 20) & 0xFu; }
#define XB_SPIN(cond, bar) do { unsigned _sp = 0; while (cond) { __builtin_amdgcn_s_sleep(1); \
    if ((++_sp & 255u) == 0u) { if (xb_ld(&(bar)[XB_TMO])) break; if (_sp > XB_SPIN_CAP) { atomicAdd(&(bar)[XB_TMO], 1u); break; } } } } while (0)

struct XcdBarrier {
    unsigned* bar; unsigned x;
    volatile LAS unsigned* st;
};

__device__ __forceinline__ XcdBarrier xcd_barrier_post(unsigned* bar, volatile LAS unsigned* st) {
    XcdBarrier b; b.bar = bar; b.x = xb_xcc_id(); b.st = st;
    if (threadIdx.x == 0) (void)xb_add(&bar[XB_XCNT(b.x)], 1u);
    return b;
}
__device__ __forceinline__ void xcd_barrier_complete(unsigned* bar, unsigned x, unsigned& nloc, unsigned& nx) {
    const unsigned G = gridDim.x * gridDim.y * gridDim.z;
    unsigned sum, cnt, mine, sp = 0u;
    for (;;) {
        sum = 0u; cnt = 0u; mine = 0u;
#pragma unroll
        for (unsigned j = 0; j < 16; ++j) { const unsigned c = xb_ld(&bar[XB_XCNT(j)]); sum += c; cnt += (c > 0u) ? 1u : 0u; mine = (j == x) ? c : mine; }
        if (sum == G) break;
        __builtin_amdgcn_s_sleep(1);
        if ((++sp & 255u) == 0u) { if (xb_ld(&bar[XB_TMO])) break; if (sp > XB_SPIN_CAP) { atomicAdd(&bar[XB_TMO], 1u); break; } }
    }
    nloc = mine > 0u ? mine : 1u; nx = cnt > 0u ? cnt : 1u;
}

__device__ __forceinline__ void xcd_barrier(const XcdBarrier& b) {
    asm volatile("s_waitcnt vmcnt(0)" ::: "memory");
    __syncthreads();
    if (threadIdx.x == 0) {
        unsigned* bar = b.bar;
        __builtin_amdgcn_s_waitcnt(0);
        unsigned nloc = b.st[0], nx = b.st[1];
        if (nloc == 0u) { xcd_barrier_complete(bar, b.x, nloc, nx); b.st[0] = nloc; b.st[1] = nx; }
        const unsigned old = xb_add(&bar[XB_XSUB(b.x)], 1u);
        const unsigned gen = old / nloc;
        if (old + 1u == (gen + 1u) * nloc) {
            __builtin_amdgcn_fence(__ATOMIC_RELEASE, "agent");
            asm volatile("s_waitcnt vmcnt(0)" ::: "memory");
            const unsigned og = xb_add(&bar[XB_TOP], 1u);
            const unsigned tg = og / nx;
            if (og + 1u == (tg + 1u) * nx) xb_add(&bar[XB_TOPGEN], 1u);
            else XB_SPIN(xb_ld(&bar[XB_TOPGEN]) == tg, bar);
            __builtin_amdgcn_fence(__ATOMIC_ACQUIRE, "agent");
            xb_add(&bar[XB_XGEN(b.x)], 1u);
            asm volatile("s_waitcnt vmcnt(0)" ::: "memory");
        } else {
            XB_SPIN(xb_ld(&bar[XB_XGEN(b.x)]) == gen, bar);
            __builtin_amdgcn_fence(__ATOMIC_ACQUIRE, "agent");
            asm volatile("s_waitcnt vmcnt(0)" ::: "memory");
        }
    }
    __syncthreads();
}
typedef unsigned u32x2 __attribute__((ext_vector_type(2)));
__device__ __forceinline__ float wave_sum(float v) {
#pragma unroll
    for (int o = 1; o < 64; o <<= 1) v += __shfl_xor(v, o);
    return v;
}
__device__ __forceinline__ unsigned cvtpk(float lo, float hi) { return pg8::cvt_pk_bf16(lo, hi); }
__device__ __forceinline__ f32x4 unpack4(u32x2 w) { return (f32x4){__uint_as_float(w.x << 16), __uint_as_float(w.x & 0xffff0000u), __uint_as_float(w.y << 16), __uint_as_float(w.y & 0xffff0000u)}; }
__device__ __forceinline__ u32x2 pack4(f32x4 v) { u32x2 r; r.x = cvtpk(v[0], v[1]); r.y = cvtpk(v[2], v[3]); return r; }
__device__ __forceinline__ float sumsq4(f32x4 v) { return (v[0] * v[0] + v[1] * v[1]) + (v[2] * v[2] + v[3] * v[3]); }
__device__ __forceinline__ void ld_row_f32(const float* row, int lane, f32x4 (&v)[4]) {
#pragma unroll
    for (int j = 0; j < 4; ++j) v[j] = *(const GAS f32x4*)(row + 4 * lane + 256 * j);
}
__device__ __forceinline__ void st_row_f32(float* row, int lane, const f32x4 (&v)[4]) {
#pragma unroll
    for (int j = 0; j < 4; ++j) *(GAS f32x4*)(row + 4 * lane + 256 * j) = v[j];
}
__device__ __forceinline__ void ld_row_bf16(const bf16* row, int lane, f32x4 (&v)[4]) {
#pragma unroll
    for (int j = 0; j < 4; ++j) v[j] = unpack4(*(const GAS u32x2*)(row + 4 * lane + 256 * j));
}
__device__ __forceinline__ void st_row_bf16(bf16* row, int lane, const f32x4 (&v)[4]) {
#pragma unroll
    for (int j = 0; j < 4; ++j) *(GAS u32x2*)(row + 4 * lane + 256 * j) = pack4(v[j]);
}
__device__ __forceinline__ float rms_scale(const f32x4 (&v)[4]) {
    const float s = wave_sum((sumsq4(v[0]) + sumsq4(v[1])) + (sumsq4(v[2]) + sumsq4(v[3])));
    return 1.0f / sqrtf(s * (1.0f / DM) + EPS);
}

__device__ __forceinline__ int tau_in(int c) {
    int tile, wc, d, isv;
    if (c < 512) { const int hq = c >> 6; tile = hq >> 2; wc = hq & 3; isv = 0; }
    else if (c < 640) { tile = 2; wc = (c - 512) >> 6; isv = 0; }
    else if (c < 768) { tile = 2; wc = 2 + ((c - 640) >> 6); isv = 1; }
    else if (c < 1280) { const int j = (c - 768) >> 6; tile = 3 + (j >> 2); wc = j & 3; isv = 0; }
    else if (c < 1792) { const int j = (c - 1280) >> 6; tile = 5 + (j >> 2); wc = j & 3; isv = 0; }
    else { const int j = (c - 1792) >> 6; tile = 7 + (j >> 2); wc = j & 3; isv = 1; }
    d = c & 63;
    const int slot = isv ? (128 * ((d >> 3) & 1) + 32 * wc + 16 * ((d >> 2) & 1) + 4 * (d >> 4) + (d & 3)) : (128 * (d >> 5) + 32 * wc + (d & 31));
    return 256 * tile + slot;
}
__device__ __forceinline__ void conv_item(const float* W, int K, int N, bf16* WT, int mode, LAS float* scr, int item, int lane) {
    const int nblk = N / 32, kb = item / nblk, nb = item % nblk, k0 = 64 * kb, n0 = 32 * nb;
#pragma unroll 8
    for (int i = 0; i < 32; ++i) { const int kk = 2 * i + (lane >> 5); scr[kk * 33 + (lane & 31)] = W[(size_t)(k0 + kk) * N + n0 + (lane & 31)]; }
    LDS_WAIT(); asm volatile("" ::: "memory");
    const int c = lane & 7;
#pragma unroll
    for (int j = 0; j < 4; ++j) { const int n = (lane >> 3) + 8 * j; const LAS float* s = scr + (8 * c) * 33 + n; const int sn = n0 + n;
        const int dr = mode == 0 ? sn : mode == 1 ? tau_in(sn) : (256 * (sn >> 7) + (sn & 127) + (mode == 3 ? 128 : 0));
        v4u o; o.x = cvtpk(s[0 * 33], s[1 * 33]); o.y = cvtpk(s[2 * 33], s[3 * 33]); o.z = cvtpk(s[4 * 33], s[5 * 33]); o.w = cvtpk(s[6 * 33], s[7 * 33]);
        *(GAS v4u*)(WT + (size_t)dr * K + k0 + 8 * c) = o; }
    LDS_WAIT(); asm volatile("" ::: "memory");
}
struct Args { const float* in[19]; float* out; unsigned char* ws; int ph_lo, ph_hi; };
typedef const __attribute__((address_space(4))) Args* KArgs;
__device__ __forceinline__ KArgs kargs() { KArgs p = (KArgs)__builtin_amdgcn_kernarg_segment_ptr(); asm volatile("" : "+s"(p)); return p; }
__device__ __forceinline__ void phase_prologue(KArgs A, LAS unsigned char* L, int gw, int NGW, int wave, int lane) {
    unsigned char* ws = A->ws;
    LAS float* scr = (LAS float*)(L + RING_OFF + wave * 16384);
    constexpr int I_IN = (DM / 64) * (INW / 32), I_OUT = (DM / 64) * (DM / 32), I_FF = (DM / 64) * (DFF / 32);
    static_assert((DFF / 64) * (DM / 32) == I_FF, "item counts");
    constexpr int NITEMS = 2 * I_IN + 2 * I_OUT + 27 * I_FF;
    for (int it = gw; it < NITEMS; it += NGW) {
        int r = it;
        if (r < 2 * I_IN) { const int l = r / I_IN; conv_item(A->in[1] + (size_t)l * DM * INW, DM, INW, (bf16*)(ws + WS_WIN) + (size_t)l * INW * DM, 1, scr, r % I_IN, lane); continue; } r -= 2 * I_IN;
        if (r < 2 * I_OUT) { const int l = r / I_OUT; conv_item(A->in[2] + (size_t)l * DM * DM, DM, DM, (bf16*)(ws + WS_WOUT) + (size_t)l * DM * DM, 0, scr, r % I_OUT, lane); continue; } r -= 2 * I_OUT;
        const int mtx = r / I_FF, sub = r % I_FF;
        if (mtx == 0) conv_item(A->in[12], DM, DFF, (bf16*)(ws + WS_WGU_D), 2, scr, sub, lane);
        else if (mtx == 1) conv_item(A->in[13], DM, DFF, (bf16*)(ws + WS_WGU_D), 3, scr, sub, lane);
        else if (mtx == 2) conv_item(A->in[14], DFF, DM, (bf16*)(ws + WS_WDN_D), 0, scr, sub, lane);
        else if (mtx < 11) { const int e = mtx - 3; conv_item(A->in[16] + (size_t)e * DM * DFF, DM, DFF, (bf16*)(ws + WS_WGU_M) + (size_t)e * 2 * DFF * DM, 2, scr, sub, lane); }
        else if (mtx < 19) { const int e = mtx - 11; conv_item(A->in[17] + (size_t)e * DM * DFF, DM, DFF, (bf16*)(ws + WS_WGU_M) + (size_t)e * 2 * DFF * DM, 3, scr, sub, lane); }
        else { const int e = mtx - 19; conv_item(A->in[18] + (size_t)e * DFF * DM, DFF, DM, (bf16*)(ws + WS_WDN_M) + (size_t)e * DM * DFF, 0, scr, sub, lane); }
    }
    const float* x = A->in[0]; const float* g = A->in[3]; bf16* HN = (bf16*)(ws + WS_HN);
    f32x4 gv[4];
#pragma unroll
    for (int j = 0; j < 4; ++j) gv[j] = *(const GAS f32x4*)(g + 4 * lane + 256 * j);
    for (int m = gw; m < NTOK; m += NGW) { f32x4 v[4]; ld_row_f32(x + (size_t)m * DM, lane, v); const float r = rms_scale(v);
#pragma unroll
        for (int j = 0; j < 4; ++j) v[j] = v[j] * r * gv[j];
        st_row_bf16(HN + (size_t)m * DM, lane, v); }
}
__device__ __forceinline__ void unpack8(v4u w, float (&f)[8]) {
    f[0] = __uint_as_float(w.x << 16); f[1] = __uint_as_float(w.x & 0xffff0000u); f[2] = __uint_as_float(w.y << 16); f[3] = __uint_as_float(w.y & 0xffff0000u);
    f[4] = __uint_as_float(w.z << 16); f[5] = __uint_as_float(w.z & 0xffff0000u); f[6] = __uint_as_float(w.w << 16); f[7] = __uint_as_float(w.w & 0xffff0000u);
}
__device__ __forceinline__ v4u pack8(const float (&f)[8]) { v4u w; w.x = cvtpk(f[0], f[1]); w.y = cvtpk(f[2], f[3]); w.z = cvtpk(f[4], f[5]); w.w = cvtpk(f[6], f[7]); return w; }
__device__ __forceinline__ void phase_t2(const bf16* OA, const bf16* OB, bf16* AO, const float* g_out_a, const float* g_subln, const float* lp, float lam_init, int gw, int NGW, int lane) {
    const float sa = wave_sum(lp[lane] * lp[64 + lane]), sb = wave_sum(lp[128 + lane] * lp[192 + lane]);
    const float lam = expf(sa) - expf(sb) + lam_init;
    float ga[8], gb[8];
#pragma unroll
    for (int i = 0; i < 8; ++i) { ga[i] = g_out_a[8 * lane + i]; gb[i] = g_subln[(8 * lane + i) & 127] * (1.0f - lam_init); }
    for (int row = gw; row < NTOK; row += NGW) {
        const v4u wa = *(const GAS v4u*)(OA + (size_t)row * 512 + 8 * lane), w0 = *(const GAS v4u*)(OB + (size_t)row * 1024 + 8 * lane), w1 = *(const GAS v4u*)(OB + (size_t)row * 1024 + 512 + 8 * lane);
        float a[8], b0[8], b1[8]; unpack8(wa, a); unpack8(w0, b0); unpack8(w1, b1);
        float ssa = 0.f, ssb = 0.f;
#pragma unroll
        for (int i = 0; i < 8; ++i) { ssa += a[i] * a[i]; b0[i] = b0[i] - lam * b1[i]; ssb += b0[i] * b0[i]; }
        ssa = wave_sum(ssa);
        ssb += __shfl_xor(ssb, 1); ssb += __shfl_xor(ssb, 2); ssb += __shfl_xor(ssb, 4); ssb += __shfl_xor(ssb, 8);
        const float ra = 1.0f / sqrtf(ssa * (1.0f / 512.0f) + EPS), rb = 1.0f / sqrtf(ssb * (1.0f / 128.0f) + EPS);
#pragma unroll
        for (int i = 0; i < 8; ++i) { a[i] = a[i] * ra * ga[i]; b0[i] = b0[i] * rb * gb[i]; }
        *(GAS v4u*)(AO + (size_t)row * 1024 + 8 * lane) = pack8(a); *(GAS v4u*)(AO + (size_t)row * 1024 + 512 + 8 * lane) = pack8(b0);
    }
}
template <bool ROUTE>
__device__ __forceinline__ void phase_t3(const float* hsrc, float* hdst, const bf16* MIX, bf16* HN, const float* gpost, const float* gpre, const float* wrt, v4u* TOK, unsigned* WGB, gu32* cnt,
                                         LAS unsigned* lcnt, int vcu, int G, int wave, int lane, int tid) {
    f32x4 gp[4], gf[4];
#pragma unroll
    for (int j = 0; j < 4; ++j) { gp[j] = *(const GAS f32x4*)(gpost + 4 * lane + 256 * j); gf[j] = *(const GAS f32x4*)(gpre + 4 * lane + 256 * j); }
    f32x4 wr[ROUTE ? 4 : 1][4][2];
    if (ROUTE) {
#pragma unroll
        for (int j = 0; j < 4; ++j)
#pragma unroll
            for (int i = 0; i < 4; ++i) { const float* p = wrt + (size_t)(4 * lane + 256 * j + i) * 8; wr[ROUTE ? j : 0][i][0] = *(const GAS f32x4*)p; wr[ROUTE ? j : 0][i][1] = *(const GAS f32x4*)(p + 4); }
    }
    for (int blk = vcu; blk < NTOK / 256; blk += G) {
        if (ROUTE) { if (tid < 8) lcnt[tid] = 0u; __syncthreads(); }
        for (int i = 0; i < 32; ++i) {
            const int row = blk * 256 + i * 8 + wave;
            f32x4 hv[4], mv[4]; ld_row_f32(hsrc + (size_t)row * DM, lane, hv); ld_row_bf16(MIX + (size_t)row * DM, lane, mv);
            const float r = rms_scale(mv);
#pragma unroll
            for (int j = 0; j < 4; ++j) hv[j] = hv[j] + mv[j] * r * gp[j];
            st_row_f32(hdst + (size_t)row * DM, lane, hv);
            const float r2 = rms_scale(hv);
#pragma unroll
            for (int j = 0; j < 4; ++j) mv[j] = hv[j] * r2 * gf[j];
            st_row_bf16(HN + (size_t)row * DM, lane, mv);
            if (ROUTE) {
                float lg[8];
#pragma unroll
                for (int e = 0; e < 8; ++e) lg[e] = 0.f;
#pragma unroll
                for (int j = 0; j < 4; ++j)
#pragma unroll
                    for (int k = 0; k < 4; ++k) { const float xv = mv[j][k];
#pragma unroll
                        for (int e = 0; e < 4; ++e) { lg[e] += xv * wr[ROUTE ? j : 0][k][0][e]; lg[4 + e] += xv * wr[ROUTE ? j : 0][k][1][e]; } }
#pragma unroll
                for (int e = 0; e < 8; ++e) lg[e] = wave_sum(lg[e]);
                int e0 = 0; float l0 = lg[0];
#pragma unroll
                for (int e = 1; e < 8; ++e) if (lg[e] > l0) { l0 = lg[e]; e0 = e; }
                int e1 = -1; float l1 = -INFINITY;
#pragma unroll
                for (int e = 0; e < 8; ++e) if (e != e0 && lg[e] > l1) { l1 = lg[e]; e1 = e; }
                if (e1 < 0) e1 = (e0 + 1) & 7;
                const float w0 = 1.0f / (1.0f + expf(l1 - l0));
                if (lane == 0) { const unsigned r0 = __hip_atomic_fetch_add(lcnt + e0, 1u, __ATOMIC_RELAXED, __HIP_MEMORY_SCOPE_WORKGROUP), r1 = __hip_atomic_fetch_add(lcnt + e1, 1u, __ATOMIC_RELAXED, __HIP_MEMORY_SCOPE_WORKGROUP);
                    v4u tk; tk.x = (unsigned)e0 | ((unsigned)e1 << 8); tk.y = r0; tk.z = r1; tk.w = __float_as_uint(w0); *(GAS v4u*)(TOK + row) = tk; }
            }
        }
        if (ROUTE) { __syncthreads(); if (tid < 8) { const unsigned c = lcnt[tid]; const unsigned base = __hip_atomic_fetch_add(cnt + tid, c, __ATOMIC_RELAXED, __HIP_MEMORY_SCOPE_AGENT); WGB[blk * 8 + tid] = base; } __syncthreads(); }
    }
}
__device__ __forceinline__ void load_layout(gu32* cnt, int (&cn)[8], int (&ps)[8], int (&pe)[8]) {
    int acc = 0;
#pragma unroll
    for (int e = 0; e < 8; ++e) { const int c = __builtin_amdgcn_readfirstlane((int)__hip_atomic_load(cnt + e, RLX_AGENT)); cn[e] = c; ps[e] = acc; acc += (c + 511) & ~511; pe[e] = acc; }
}
__device__ __forceinline__ void phase_gather(const bf16* HN, bf16* XS, const v4u* TOK, const unsigned* WGB, gu32* cnt, LAS int* psl, int gw, int NGW, int lane, int tid) {
    int cn[8], ps[8], pe[8]; load_layout(cnt, cn, ps, pe);
    if (tid == 0) {
#pragma unroll
        for (int e = 0; e < 8; ++e) psl[e] = ps[e]; }
    __syncthreads();
    for (int row = gw; row < NTOK; row += NGW) {
        const v4u tk = *(const GAS v4u*)(TOK + row); const int e0 = tk.x & 255, e1 = (tk.x >> 8) & 255;
        const size_t d0 = (size_t)(psl[e0] + (int)WGB[(row >> 8) * 8 + e0] + (int)tk.y), d1 = (size_t)(psl[e1] + (int)WGB[(row >> 8) * 8 + e1] + (int)tk.z);
        const v4u v0 = *(const GAS v4u*)(HN + (size_t)row * DM + 8 * lane), v1 = *(const GAS v4u*)(HN + (size_t)row * DM + 512 + 8 * lane);
        *(GAS v4u*)(XS + d0 * DM + 8 * lane) = v0; *(GAS v4u*)(XS + d0 * DM + 512 + 8 * lane) = v1;
        *(GAS v4u*)(XS + d1 * DM + 8 * lane) = v0; *(GAS v4u*)(XS + d1 * DM + 512 + 8 * lane) = v1;
    }
    const v4u z = (v4u){0u, 0u, 0u, 0u};
#pragma unroll
    for (int e = 0; e < 8; ++e)
        for (int r = ps[e] + cn[e] + gw; r < pe[e]; r += NGW) { *(GAS v4u*)(XS + (size_t)r * DM + 8 * lane) = z; *(GAS v4u*)(XS + (size_t)r * DM + 512 + 8 * lane) = z; }
}
template <bool MOE, bool NEXT>
__device__ __forceinline__ void phase_t4(float* h, const bf16* F, const v4u* TOK, const unsigned* WGB, gu32* cnt, LAS int* psl, const float* gpost, const float* gnext, bf16* HN, int gw, int NGW, int lane, int tid) {
    if (MOE) { int cn[8], ps[8], pe[8]; load_layout(cnt, cn, ps, pe);
        if (tid == 0) {
#pragma unroll
            for (int e = 0; e < 8; ++e) psl[e] = ps[e]; }
        __syncthreads(); }
    f32x4 gp[4], gn[4];
#pragma unroll
    for (int j = 0; j < 4; ++j) { gp[j] = *(const GAS f32x4*)(gpost + 4 * lane + 256 * j); gn[j] = NEXT ? *(const GAS f32x4*)(gnext + 4 * lane + 256 * j) : (f32x4){0.f, 0.f, 0.f, 0.f}; }
    for (int row = gw; row < NTOK; row += NGW) {
        f32x4 fv[4], hv[4];
        if (MOE) { const v4u tk = *(const GAS v4u*)(TOK + row); const int e0 = tk.x & 255, e1 = (tk.x >> 8) & 255;
            const size_t d0 = (size_t)(psl[e0] + (int)WGB[(row >> 8) * 8 + e0] + (int)tk.y), d1 = (size_t)(psl[e1] + (int)WGB[(row >> 8) * 8 + e1] + (int)tk.z);
            const float w0 = __uint_as_float(tk.w), w1 = 1.0f - w0; f32x4 f1[4]; ld_row_bf16(F + d0 * DM, lane, fv); ld_row_bf16(F + d1 * DM, lane, f1);
#pragma unroll
            for (int j = 0; j < 4; ++j) fv[j] = fv[j] * w0 + f1[j] * w1;
        } else ld_row_bf16(F + (size_t)row * DM, lane, fv);
        ld_row_f32(h + (size_t)row * DM, lane, hv);
        const float r = rms_scale(fv);
#pragma unroll
        for (int j = 0; j < 4; ++j) hv[j] = hv[j] + fv[j] * r * gp[j];
        st_row_f32(h + (size_t)row * DM, lane, hv);
        if (NEXT) { const float r2 = rms_scale(hv);
#pragma unroll
            for (int j = 0; j < 4; ++j) fv[j] = hv[j] * r2 * gn[j];
            st_row_bf16(HN + (size_t)row * DM, lane, fv); }
    }
}
#ifndef MK_PER_PHASE
#define MK_PER_PHASE 0
#endif
#ifndef MK_PH_HI
#define MK_PH_HI 1000
#endif
constexpr int N_PHASES = 28;
constexpr int TE_OFF = LDSCTL_OFF + 1024;
__device__ __forceinline__ int fill_tile_experts(gu32* cnt, LAS int* te, int tid) {
    int cn[8], ps[8], pe[8]; load_layout(cnt, cn, ps, pe);
    for (int i = tid; i < 528; i += NWAVES * 64) { const int row = i * 256; int e = 0;
#pragma unroll
        for (int j = 0; j < 7; ++j) e += (row >= pe[j]) ? 1 : 0;
        te[i] = e; }
    __syncthreads();
    return pe[7] / 256;
}
__global__ void __launch_bounds__(NWAVES * 64, 2) fwd_kernel(Args args_unused) {
    extern __shared__ __attribute__((aligned(16))) unsigned char lds[];
    LAS unsigned char* L = (LAS unsigned char*)lds;
    const int tid0 = threadIdx.x;
    const int G = gridDim.x, bx = blockIdx.x;
    const int vcu = (G % 8 == 0) ? (bx % 8) * (G / 8) + bx / 8 : bx;
    for (int u = tid0; u < (LDS_BYTES - LDSCTL_OFF) / 4; u += NWAVES * 64) ((LAS unsigned*)(L + LDSCTL_OFF))[u] = 0u;
    __syncthreads();
    XcdBarrier bar;
    int lo, hi;
    { KArgs A = kargs(); lo = A->ph_lo; hi = A->ph_hi; bar = xcd_barrier_post((unsigned*)(A->ws + WS_CTL) + CW_BAR, (volatile LAS unsigned*)(L + MISC_OFF) + 8); }
    int ph = 0;
#define IN() (lo <= ph && ph < hi)
#define SEAM() do { if (lo <= ph && ph + 1 < hi) xcd_barrier(bar); ++ph; } while (0)
#define TIDO() int tid = threadIdx.x; asm volatile("" : "+v"(tid))
#define LANE (tid & 63)
#define WAVE (__builtin_amdgcn_readfirstlane(tid >> 6))
#define GW (vcu * NWAVES + WAVE)
#define NGW (G * NWAVES)
#define LCNT ((LAS unsigned*)(L + LDSCTL_OFF))
#define PSL ((LAS int*)(L + LDSCTL_OFF + 64))
#define TE ((LAS int*)(L + TE_OFF))

    if (IN()) { TIDO(); phase_prologue(kargs(), L, GW, NGW, WAVE, LANE); }
    SEAM();
    for (int layer = 0; layer < NLAYER; ++layer) {
        const bool moe = (layer & 1) != 0;
        if (IN()) {
            KArgs A = kargs(); unsigned char* ws = A->ws;
            pg8::Gemm g{(const bf16*)(ws + WS_HN), (const bf16*)(ws + WS_WIN) + (size_t)layer * INW * DM, NTOK, INW, DM};
            pg8::StaticOrder S; S.init(NTOK / 256, INW / 256, G, bx, 0);
            pg8::EpiInProj E{ws, WS_QA, WS_KA, WS_VA, WS_QB, WS_KB, WS_VB, A->in[7] + 64 * layer, A->in[8] + 64 * layer, attn_body::C2};
            pg8::gemm_phase<pg8::EpiInProj, pg8::StaticOrder, true, true>(L + RING_OFF, g, S, E);
        }
        SEAM();
        if (IN()) {
            for (int i = 0;; ++i) {
                int b, st, qb;
                if (G == 256) { if (i >= 24) break; const int grp = vcu >> 3; b = grp >> 2; st = 4 * (i >> 2) + (grp & 3); qb = (vcu & 7) + 8 * (i & 3); }
                else { const int Lu = i * G + vcu; if (Lu >= 6144) break; qb = Lu & 31; const int sm = Lu >> 5; b = sm / 24; st = sm % 24; }
                unsigned char* ws = kargs()->ws;
                typedef attn_body::bf16 abf;
                const abf *Q, *K, *V; abf* O; int QP, KP, VP, OP;
                if (st < 8) { const int hq = st, kh = hq >> 2; Q = (const abf*)(ws + WS_QA) + 64 * hq; QP = 512; K = (const abf*)(ws + WS_KA) + 64 * kh; KP = 128; V = (const abf*)(ws + WS_VA) + 64 * kh; VP = 128; O = (abf*)(ws + WS_OA) + 64 * hq; OP = 512; }
                else { const int sb = st - 8, h = sb >> 2, m = (sb >> 1) & 1, vh = sb & 1, j = 2 * h + m;
                    Q = (const abf*)(ws + WS_QB) + 64 * j; QP = 512; K = (const abf*)(ws + WS_KB) + 64 * j; KP = 512; V = (const abf*)(ws + WS_VB) + 128 * h + 64 * vh; VP = 512; O = (abf*)(ws + WS_OB) + 512 * m + 128 * h + 64 * vh; OP = 1024; }
                const long rb = (long)b * SEQL;
                attn_body::attn_unit<8>(Q + (rb + 256 * qb) * QP, QP, K + rb * KP, KP, V + rb * VP, VP, O + (rb + 256 * qb) * OP, OP, (char*)lds + RING_OFF);
            }
        }
        SEAM();
        if (IN()) { TIDO(); KArgs A = kargs(); unsigned char* ws = A->ws; const float lam_init = 0.8f - 0.6f * expf(-0.3f * (float)layer);
            phase_t2((const bf16*)(ws + WS_OA), (const bf16*)(ws + WS_OB), (bf16*)(ws + WS_AO), A->in[9] + 512 * layer, A->in[11] + 128 * layer, A->in[10] + 256 * layer, lam_init, GW, NGW, LANE); }
        SEAM();
        if (IN()) {
            unsigned char* ws = kargs()->ws;
            pg8::Gemm g{(const bf16*)(ws + WS_AO), (const bf16*)(ws + WS_WOUT) + (size_t)layer * DM * DM, NTOK, DM, DM};
            pg8::StaticOrder S; S.init(NTOK / 256, DM / 256, G, bx, 0);
            pg8::EpiBf16 E{(bf16*)(ws + WS_MIX), DM};
            pg8::gemm_phase<pg8::EpiBf16, pg8::StaticOrder, true, true>(L + RING_OFF, g, S, E);
        }
        SEAM();
        if (IN()) {
            TIDO(); KArgs A = kargs(); unsigned char* ws = A->ws;
            const float* hsrc = layer == 0 ? A->in[0] : A->out;
            if (moe) phase_t3<true>(hsrc, A->out, (const bf16*)(ws + WS_MIX), (bf16*)(ws + WS_HN), A->in[4] + DM * layer, A->in[5] + DM * layer, A->in[15], (v4u*)(ws + WS_TOK), (unsigned*)(ws + WS_WGB), (gu32*)(ws + WS_CTL) + CW_CNT, LCNT, vcu, G, WAVE, LANE, tid);
            else phase_t3<false>(hsrc, A->out, (const bf16*)(ws + WS_MIX), (bf16*)(ws + WS_HN), A->in[4] + DM * layer, A->in[5] + DM * layer, A->in[15], (v4u*)(ws + WS_TOK), (unsigned*)(ws + WS_WGB), (gu32*)(ws + WS_CTL) + CW_CNT, LCNT, vcu, G, WAVE, LANE, tid);
        }
        SEAM();
        if (moe) { if (IN()) { TIDO(); unsigned char* ws = kargs()->ws; phase_gather((const bf16*)(ws + WS_HN), (bf16*)(ws + WS_XS), (const v4u*)(ws + WS_TOK), (const unsigned*)(ws + WS_WGB), (gu32*)(ws + WS_CTL) + CW_CNT, PSL, GW, NGW, LANE, tid); } SEAM(); }
        {
            const int nchunks = moe ? 5 : 2;
            for (int c = 0; c < nchunks; ++c) {
                const int pm0 = c * CHUNK_TILES;
                if (IN()) {
                    TIDO(); unsigned char* ws = kargs()->ws;
                    int n_used = NTOK / 256; if (moe) n_used = fill_tile_experts((gu32*)(ws + WS_CTL) + CW_CNT, TE, tid);
                    int nt = n_used - pm0; nt = nt > CHUNK_TILES ? CHUNK_TILES : nt;
                    if (nt > 0) {
                        pg8::Gemm g{moe ? (const bf16*)(ws + WS_XS) : (const bf16*)(ws + WS_HN), moe ? (const bf16*)(ws + WS_WGU_M) : (const bf16*)(ws + WS_WGU_D), 0, 2 * DFF, DM};
                        pg8::StaticOrder S; S.init(nt, 2 * DFF / 256, G, bx, pm0);
                        if (moe) { S.estride = (unsigned)(2 * DFF * DM * 2); S.te = TE; }
                        pg8::EpiSwiGLU E{(bf16*)(ws + WS_ACT) - (size_t)pm0 * 256 * DFF, DFF};
                        pg8::gemm_phase<pg8::EpiSwiGLU, pg8::StaticOrder, true, true>(L + RING_OFF, g, S, E);
                    }
                }
                SEAM();
                if (IN()) {
                    TIDO(); unsigned char* ws = kargs()->ws;
                    int n_used = NTOK / 256; if (moe) n_used = fill_tile_experts((gu32*)(ws + WS_CTL) + CW_CNT, TE, tid);
                    int nt = n_used - pm0; nt = nt > CHUNK_TILES ? CHUNK_TILES : nt;
                    if (nt > 0) {
                        pg8::Gemm g{(const bf16*)(ws + WS_ACT) - (size_t)pm0 * 256 * DFF, moe ? (const bf16*)(ws + WS_WDN_M) : (const bf16*)(ws + WS_WDN_D), 0, DM, DFF};
                        pg8::StaticOrder S; S.init(nt, DM / 256, G, bx, pm0);
                        if (moe) { S.estride = (unsigned)(DM * DFF * 2); S.te = TE; }
                        pg8::EpiBf16 E{moe ? (bf16*)(ws + WS_XS) : (bf16*)(ws + WS_F), DM};
                        pg8::gemm_phase<pg8::EpiBf16, pg8::StaticOrder, true, true>(L + RING_OFF, g, S, E);
                    }
                }
                SEAM();
            }
        }
        if (IN()) {
            TIDO(); KArgs A = kargs(); unsigned char* ws = A->ws;
            if (moe) phase_t4<true, false>(A->out, (const bf16*)(ws + WS_XS), (const v4u*)(ws + WS_TOK), (const unsigned*)(ws + WS_WGB), (gu32*)(ws + WS_CTL) + CW_CNT, PSL, A->in[6] + DM * layer, nullptr, (bf16*)(ws + WS_HN), GW, NGW, LANE, tid);
            else phase_t4<false, true>(A->out, (const bf16*)(ws + WS_F), (const v4u*)(ws + WS_TOK), (const unsigned*)(ws + WS_WGB), (gu32*)(ws + WS_CTL) + CW_CNT, PSL, A->in[6] + DM * layer, A->in[3] + DM * (layer + 1), (bf16*)(ws + WS_HN), GW, NGW, LANE, tid);
        }
        if (layer + 1 < NLAYER) SEAM();
    }
#undef IN
#undef SEAM
}

extern "C" void kernel_launch(void* const* d_in, const int* in_sizes, int n_in, void* d_out, int out_size, void* d_ws, size_t ws_size, hipStream_t stream) {
    static int grid = 0;
    if (grid == 0) {
        if (n_in != 19 || in_sizes[0] != NTOK * DM || out_size != NTOK * DM || ws_size < WS_END) {
            fprintf(stderr, "kernel_launch: built for 19 inputs, x/out of %d floats, >= %zu bytes of workspace; got n_in %d, in0 %d, out %d, ws %zu; nothing launched\n", NTOK * DM, (size_t)WS_END, n_in, n_in > 0 ? in_sizes[0] : -1, out_size, ws_size);
            grid = -1; return; }
        int dev = 0, cus = 0, per_cu = 0;
        if (hipGetDevice(&dev) != hipSuccess || hipDeviceGetAttribute(&cus, hipDeviceAttributeMultiprocessorCount, dev) != hipSuccess) { fprintf(stderr, "kernel_launch: device query failed\n"); grid = -1; return; }
        if (hipFuncSetAttribute((const void*)fwd_kernel, hipFuncAttributeMaxDynamicSharedMemorySize, LDS_BYTES) != hipSuccess) { fprintf(stderr, "kernel_launch: hipFuncSetAttribute failed\n"); grid = -1; return; }
        if (hipOccupancyMaxActiveBlocksPerMultiprocessor(&per_cu, (const void*)fwd_kernel, NWAVES * 64, LDS_BYTES) != hipSuccess || per_cu < 1)
            fprintf(stderr, "kernel_launch: note: occupancy query reports %d workgroups per CU\n", per_cu);
        (void)hipGetLastError();
        grid = cus;
    }
    if (grid < 0) return;
    if (hipMemsetAsync((char*)d_ws + WS_CTL, 0, CTL_ZERO_BYTES, stream) != hipSuccess) { fprintf(stderr, "kernel_launch: memset failed\n"); return; }
    Args a{};
    for (int i = 0; i < 19; ++i) a.in[i] = (const float*)d_in[i];
    a.out = (float*)d_out; a.ws = (unsigned char*)d_ws;
    const int ph_end = MK_PH_HI < N_PHASES ? MK_PH_HI : N_PHASES;
#if MK_PER_PHASE
    for (int p = 0; p < ph_end; ++p) { a.ph_lo = p; a.ph_hi = p + 1; hipLaunchKernelGGL(fwd_kernel, dim3(grid), dim3(NWAVES * 64), LDS_BYTES, stream, a); }
#else
    a.ph_lo = 0; a.ph_hi = ph_end;
    hipLaunchKernelGGL(fwd_kernel, dim3(grid), dim3(NWAVES * 64), LDS_BYTES, stream, a);
#endif
    const hipError_t le = hipPeekAtLastError();
    if (le != hipSuccess) fprintf(stderr, "kernel_launch: launch failed: %s\n", hipGetErrorName(le));
}
```

```cpp
#include <hip/hip_runtime.h>
#include <hip/hip_bf16.h>
#include <cstdio>
#include <cstdint>
#include <cmath>
namespace pg8 {
#define PG8_LAS __attribute__((address_space(3)))
typedef unsigned short bf16_t;
typedef short bf16x8 __attribute__((ext_vector_type(8)));
typedef float f32x4 __attribute__((ext_vector_type(4)));
typedef unsigned u32x4 __attribute__((ext_vector_type(4)));
typedef int i32x4 __attribute__((ext_vector_type(4)));
typedef int i32x8 __attribute__((ext_vector_type(8)));
constexpr int BM = 256, BK = 64, HALF = 128, HTB = HALF * BK * 2  , STAGE_BYTES = 8 * HTB, NXCD = 8, WGM = 8;

__host__ __device__ __forceinline__ int lds_byte(int r, int c) { const int st = (r >> 4) * 2 + (c >> 5), rr = r & 15, cc = c & 31, ob = rr * 64 + cc * 2; return st * 1024 + (ob ^ (((ob >> 9) & 1) << 5)); }
__host__ __device__ __forceinline__ void stage_rc(int b, int& R, int& C) { const int st = b / 1024, sb = b % 1024, swz = sb ^ (((sb >> 9) & 1) << 5); R = (st >> 1) * 16 + swz / 64; C = (st & 1) * 32 + (swz % 64) / 2; }
__host__ __device__ __forceinline__ int perm32(int rho) { const int n = rho >> 4, i = rho & 15; return 8 * (i >> 2) + 4 * n + (i & 3); }

struct Unit { int pm, pn; };
struct Gemm { const bf16_t* A; const bf16_t* Bt; int M, N, K; };

struct StaticOrder {
    int nM, nN, nwg, G, c, pm0; const PG8_LAS int* te; unsigned estride;
    __device__ void init(int nM_, int nN_, int G_, int c_, int pm0_) { nM = nM_; nN = nN_; nwg = nM * nN; G = G_; c = c_; pm0 = pm0_; estride = 0; te = nullptr; }
    __device__ bool next(int i, Unit& u) const {
        const long L = (long)i * G + c; if (L >= nwg) return false;
        int wgid = (int)L; { const int q = nwg / NXCD, r = nwg % NXCD, xcd = wgid % NXCD, off = wgid / NXCD; wgid = (xcd < r ? xcd * (q + 1) : r * (q + 1) + (xcd - r) * q) + off; }
        const int nig = WGM * nN, gid = wgid / nig, fm = gid * WGM, gsz = (nM - fm) < WGM ? (nM - fm) : WGM;
        u.pm = pm0 + fm + ((wgid % nig) % gsz); u.pn = (wgid % nig) / gsz; return true;
    }
    __device__ __forceinline__ size_t bofs(const Unit& u) const { if (estride == 0) return 0; const int e = __builtin_amdgcn_readfirstlane(te[u.pm]); return (size_t)e * estride; }
    __device__ __forceinline__ void a_ready(const Unit&) const {}
    __device__ __forceinline__ void done(const Unit&) const {}
};

__device__ __forceinline__ unsigned cvt_pk_bf16(float lo, float hi) { unsigned r; asm volatile("v_cvt_pk_bf16_f32 %0, %1, %2" : "=v"(r) : "v"(lo), "v"(hi)); return r; }

struct EpiBf16 {
    static constexpr bool PERM = true, AFTER_DRAIN = false;
    bf16_t* O; int ldc;
    __device__ __forceinline__ void operator()(const f32x4 (&acc)[2][2][4][2], const Unit& u, int wr, int wc, int fr, int fq) const {
        const int row0 = u.pm * BM + wr * 64 + fr; const int col0 = u.pn * BM + wc * 32 + 8 * fq;
#pragma unroll
        for (int ai = 0; ai < 2; ++ai)
#pragma unroll
            for (int m = 0; m < 4; ++m) { bf16_t* rowp = O + (size_t)(row0 + ai * HALF + m * 16) * ldc + col0;
#pragma unroll
                for (int bj = 0; bj < 2; ++bj) { const f32x4 v0 = acc[ai][bj][m][0], v1 = acc[ai][bj][m][1];
                    u32x4 w; w.x = cvt_pk_bf16(v0[0], v0[1]); w.y = cvt_pk_bf16(v0[2], v0[3]); w.z = cvt_pk_bf16(v1[0], v1[1]); w.w = cvt_pk_bf16(v1[2], v1[3]);
                    *(u32x4*)(rowp + bj * HALF) = w; } }
    }
};
__device__ __forceinline__ unsigned cvt4_fp8(float a, float b, float c, float d) {
    a = __builtin_amdgcn_fmed3f(a, -448.f, 448.f); b = __builtin_amdgcn_fmed3f(b, -448.f, 448.f); c = __builtin_amdgcn_fmed3f(c, -448.f, 448.f); d = __builtin_amdgcn_fmed3f(d, -448.f, 448.f);
    int w = 0; w = __builtin_amdgcn_cvt_pk_fp8_f32(a, b, w, false); w = __builtin_amdgcn_cvt_pk_fp8_f32(c, d, w, true); return (unsigned)w; }
struct EpiBf16S {
    static constexpr bool PERM = true, AFTER_DRAIN = false;
    bf16_t* O; int ldc; float s;
    __device__ __forceinline__ void operator()(const f32x4 (&acc)[2][2][4][2], const Unit& u, int wr, int wc, int fr, int fq) const {
        const int row0 = u.pm * BM + wr * 64 + fr; const int col0 = u.pn * BM + wc * 32 + 8 * fq;
#pragma unroll
        for (int ai = 0; ai < 2; ++ai)
#pragma unroll
            for (int m = 0; m < 4; ++m) { bf16_t* rowp = O + (size_t)(row0 + ai * HALF + m * 16) * ldc + col0;
#pragma unroll
                for (int bj = 0; bj < 2; ++bj) { const f32x4 v0 = acc[ai][bj][m][0] * s, v1 = acc[ai][bj][m][1] * s;
                    u32x4 w; w.x = cvt_pk_bf16(v0[0], v0[1]); w.y = cvt_pk_bf16(v0[2], v0[3]); w.z = cvt_pk_bf16(v1[0], v1[1]); w.w = cvt_pk_bf16(v1[2], v1[3]);
                    *(u32x4*)(rowp + bj * HALF) = w; } }
    }
};
struct EpiBf16I8 {
    static constexpr bool PERM = true, AFTER_DRAIN = false;
    bf16_t* O; int ldc; const float* sa; const float* sw;
    __device__ __forceinline__ void operator()(const f32x4 (&acc)[2][2][4][2], const Unit& u, int wr, int wc, int fr, int fq) const {
        const int row0 = u.pm * BM + wr * 64 + fr; const int col0 = u.pn * BM + wc * 32 + 8 * fq;
        f32x4 sv[2][2];
#pragma unroll
        for (int bj = 0; bj < 2; ++bj)
#pragma unroll
            for (int n = 0; n < 2; ++n) sv[bj][n] = *(const f32x4*)(sw + col0 + bj * HALF + 4 * n);
#pragma unroll
        for (int ai = 0; ai < 2; ++ai)
#pragma unroll
            for (int m = 0; m < 4; ++m) { const int row = row0 + ai * HALF + m * 16; bf16_t* rowp = O + (size_t)row * ldc + col0; const float a = sa[row];
#pragma unroll
                for (int bj = 0; bj < 2; ++bj) { const f32x4 v0 = __builtin_convertvector(__builtin_bit_cast(i32x4, acc[ai][bj][m][0]), f32x4) * (sv[bj][0] * a), v1 = __builtin_convertvector(__builtin_bit_cast(i32x4, acc[ai][bj][m][1]), f32x4) * (sv[bj][1] * a);
                    u32x4 w; w.x = cvt_pk_bf16(v0[0], v0[1]); w.y = cvt_pk_bf16(v0[2], v0[3]); w.z = cvt_pk_bf16(v1[0], v1[1]); w.w = cvt_pk_bf16(v1[2], v1[3]);
                    *(u32x4*)(rowp + bj * HALF) = w; } }
    }
};
__device__ __forceinline__ float silu_mul(float g, float u) { const float e = __builtin_amdgcn_exp2f(-1.4426950408889634f * g); return g * __builtin_amdgcn_rcpf(1.0f + e) * u; }
struct EpiSwiGLU {
    static constexpr bool PERM = true, AFTER_DRAIN = false;
    bf16_t* O; int ldc;
    __device__ __forceinline__ void operator()(const f32x4 (&acc)[2][2][4][2], const Unit& u, int wr, int wc, int fr, int fq) const {
        const int row0 = u.pm * BM + wr * 64 + fr; const int col0 = u.pn * HALF + wc * 32 + 8 * fq;
#pragma unroll
        for (int ai = 0; ai < 2; ++ai)
#pragma unroll
            for (int m = 0; m < 4; ++m) { bf16_t* rowp = O + (size_t)(row0 + ai * HALF + m * 16) * ldc + col0;
                const f32x4 g0 = acc[ai][0][m][0], g1 = acc[ai][0][m][1], u0 = acc[ai][1][m][0], u1 = acc[ai][1][m][1];
                u32x4 w; w.x = cvt_pk_bf16(silu_mul(g0[0], u0[0]), silu_mul(g0[1], u0[1])); w.y = cvt_pk_bf16(silu_mul(g0[2], u0[2]), silu_mul(g0[3], u0[3]));
                w.z = cvt_pk_bf16(silu_mul(g1[0], u1[0]), silu_mul(g1[1], u1[1])); w.w = cvt_pk_bf16(silu_mul(g1[2], u1[2]), silu_mul(g1[3], u1[3]));
                *(u32x4*)rowp = w; }
    }
};
struct EpiSwiGLUI8 {
    static constexpr bool PERM = true, AFTER_DRAIN = false;
    bf16_t* O; int ldc; const float* sa; const float* sw;
    __device__ __forceinline__ void operator()(const f32x4 (&acc)[2][2][4][2], const Unit& u, int wr, int wc, int fr, int fq) const {
        const int row0 = u.pm * BM + wr * 64 + fr; const int col0 = u.pn * HALF + wc * 32 + 8 * fq; const int brow0 = u.pn * BM + wc * 32 + 8 * fq;
        const f32x4 sg0 = *(const f32x4*)(sw + brow0), sg1 = *(const f32x4*)(sw + brow0 + 4), su0 = *(const f32x4*)(sw + brow0 + HALF), su1 = *(const f32x4*)(sw + brow0 + HALF + 4);
#pragma unroll
        for (int ai = 0; ai < 2; ++ai)
#pragma unroll
            for (int m = 0; m < 4; ++m) { const int row = row0 + ai * HALF + m * 16; bf16_t* rowp = O + (size_t)row * ldc + col0; const float a = sa[row];
                const i32x4 ig0 = __builtin_bit_cast(i32x4, acc[ai][0][m][0]), ig1 = __builtin_bit_cast(i32x4, acc[ai][0][m][1]), iu0 = __builtin_bit_cast(i32x4, acc[ai][1][m][0]), iu1 = __builtin_bit_cast(i32x4, acc[ai][1][m][1]);
                f32x4 g0, g1, u0, u1;
#pragma unroll
                for (int e = 0; e < 4; ++e) { g0[e] = (float)ig0[e] * (a * sg0[e]); g1[e] = (float)ig1[e] * (a * sg1[e]); u0[e] = (float)iu0[e] * (a * su0[e]); u1[e] = (float)iu1[e] * (a * su1[e]); }
                u32x4 w; w.x = cvt_pk_bf16(silu_mul(g0[0], u0[0]), silu_mul(g0[1], u0[1])); w.y = cvt_pk_bf16(silu_mul(g0[2], u0[2]), silu_mul(g0[3], u0[3]));
                w.z = cvt_pk_bf16(silu_mul(g1[0], u1[0]), silu_mul(g1[1], u1[1])); w.w = cvt_pk_bf16(silu_mul(g1[2], u1[2]), silu_mul(g1[3], u1[3]));
                *(u32x4*)rowp = w; }
    }
};
struct EpiSwiGLU8 {
    static constexpr bool PERM = true, AFTER_DRAIN = false;
    unsigned char* O; int ldc; float sin, sout;
    __device__ __forceinline__ void operator()(const f32x4 (&acc)[2][2][4][2], const Unit& u, int wr, int wc, int fr, int fq) const {
        typedef unsigned u32x2 __attribute__((ext_vector_type(2)));
        const int row0 = u.pm * BM + wr * 64 + fr; const int col0 = u.pn * HALF + wc * 32 + 8 * fq;
#pragma unroll
        for (int ai = 0; ai < 2; ++ai)
#pragma unroll
            for (int m = 0; m < 4; ++m) { unsigned char* rowp = O + (size_t)(row0 + ai * HALF + m * 16) * ldc + col0;
                const f32x4 g0 = acc[ai][0][m][0] * sin, g1 = acc[ai][0][m][1] * sin, u0 = acc[ai][1][m][0] * (sin * sout), u1 = acc[ai][1][m][1] * (sin * sout);
                u32x2 w; w.x = cvt4_fp8(silu_mul(g0[0], u0[0]), silu_mul(g0[1], u0[1]), silu_mul(g0[2], u0[2]), silu_mul(g0[3], u0[3]));
                w.y = cvt4_fp8(silu_mul(g1[0], u1[0]), silu_mul(g1[1], u1[1]), silu_mul(g1[2], u1[2]), silu_mul(g1[3], u1[3]));
                *(u32x2*)rowp = w; }
    }
};
template <bool I8> struct EpiInProjT {
    static constexpr bool PERM = false, AFTER_DRAIN = false;
    unsigned char* ws; size_t oQA, oKA, oVA, oQB, oKB, oVB; const float* gq; const float* gk; float qscale; const float* sa; const float* sw;
    __device__ __forceinline__ void operator()(const f32x4 (&acc)[2][2][4][2], const Unit& u, int wr, int wc, int fr_, int fq_) const {
        int fr = fr_, fq = fq_; asm volatile("" : "+v"(fr), "+v"(fq));
        const int pn = u.pn; int kind, pitch, col0; bf16_t* base;
        if (pn < 2) { kind = 0; base = (bf16_t*)(ws + oQA); pitch = 512; col0 = 64 * (4 * pn + wc); }
        else if (pn == 2) { if (wc < 2) { kind = 1; base = (bf16_t*)(ws + oKA); pitch = 128; col0 = 64 * wc; } else { kind = 2; base = (bf16_t*)(ws + oVA); pitch = 128; col0 = 64 * (wc - 2); } }
        else if (pn < 5) { kind = 3; base = (bf16_t*)(ws + oQB); pitch = 512; col0 = 64 * (4 * (pn - 3) + wc); }
        else if (pn < 7) { kind = 4; base = (bf16_t*)(ws + oKB); pitch = 512; col0 = 64 * (4 * (pn - 5) + wc); }
        else { kind = 2; base = (bf16_t*)(ws + oVB); pitch = 512; col0 = 64 * (4 * (pn - 7) + wc); }
        const int row0 = u.pm * BM + wr * 64 + fr;
        bf16_t* outp = base + (size_t)row0 * pitch + col0 + 16 * fq;
        const float* swp = I8 ? sw + u.pn * BM + 32 * wc + 4 * fq : nullptr;
#define IP_ACC(ai, bj, m, n, sar) (I8 ? __builtin_convertvector(__builtin_bit_cast(i32x4, acc[ai][bj][m][n]), f32x4) * (*(const f32x4*)(swp + 128 * (bj) + 16 * (n)) * (sar)) : acc[ai][bj][m][n])
        const float L2T = 13.287712379549449f;
        if (kind == 2) {
#pragma unroll
            for (int ai = 0; ai < 2; ++ai)
#pragma unroll
                for (int m = 0; m < 4; ++m) { bf16_t* rp = outp + (size_t)(ai * HALF + m * 16) * pitch; const float sar = I8 ? sa[row0 + ai * HALF + m * 16] : 1.f;
#pragma unroll
                    for (int bj = 0; bj < 2; ++bj) { const f32x4 v0 = IP_ACC(ai, bj, m, 0, sar), v1 = IP_ACC(ai, bj, m, 1, sar);
                        u32x4 w; w.x = cvt_pk_bf16(v0[0], v0[1]); w.y = cvt_pk_bf16(v0[2], v0[3]); w.z = cvt_pk_bf16(v1[0], v1[1]); w.w = cvt_pk_bf16(v1[2], v1[3]);
                        *(u32x4*)(rp + 8 * bj) = w; } }
        } else if (kind <= 1) {
            const float* g = kind == 0 ? gq : gk; const float sc = kind == 0 ? qscale : 1.0f;
            float inv[4];
#pragma unroll
            for (int e = 0; e < 4; ++e) inv[e] = __builtin_amdgcn_exp2f(-(float)(4 * fq + e) * (L2T / 16.0f)) * 0.15915494309189535f;
#pragma unroll
            for (int ai = 0; ai < 2; ++ai)
#pragma unroll
                for (int m = 0; m < 4; ++m) { const int row = row0 + ai * HALF + m * 16; const int t = row & 8191; const float pr = (float)(t >> 6), pc = (float)(t & 63);
                    f32x4 v[2][2]; float ss = 0.f; const float sar = I8 ? sa[row] : 1.f;
#pragma unroll
                    for (int bj = 0; bj < 2; ++bj)
#pragma unroll
                        for (int n = 0; n < 2; ++n) { v[bj][n] = IP_ACC(ai, bj, m, n, sar); ss += (v[bj][n][0] * v[bj][n][0] + v[bj][n][1] * v[bj][n][1]) + (v[bj][n][2] * v[bj][n][2] + v[bj][n][3] * v[bj][n][3]); }
                    ss += __shfl_xor(ss, 16); ss += __shfl_xor(ss, 32);
                    const float rinv = __builtin_amdgcn_rsqf(ss * (1.0f / 64.0f) + 1e-6f) * sc;
#pragma unroll
                    for (int bj = 0; bj < 2; ++bj) { const float pos = bj == 0 ? pr : pc; const f32x4 gv0 = *(const f32x4*)(g + 32 * bj + 4 * fq), gv1 = *(const f32x4*)(g + 32 * bj + 16 + 4 * fq);
#pragma unroll
                        for (int e = 0; e < 4; ++e) { float rev = pos * inv[e]; rev = rev - __builtin_floorf(rev);
                            const float sn = __builtin_amdgcn_sinf(rev), cs = __builtin_amdgcn_cosf(rev);
                            float x1 = v[bj][0][e] * rinv * gv0[e], x2 = v[bj][1][e] * rinv * gv1[e]; asm volatile("" : "+v"(x1), "+v"(x2));
                            v[bj][0][e] = x1 * cs - x2 * sn; v[bj][1][e] = x2 * cs + x1 * sn; } }
                    bf16_t* rp = outp + (size_t)(ai * HALF + m * 16) * pitch;
#pragma unroll
                    for (int bj = 0; bj < 2; ++bj) { const f32x4 v0 = v[bj][0], v1 = v[bj][1];
                        u32x4 w; w.x = cvt_pk_bf16(v0[0], v0[1]); w.y = cvt_pk_bf16(v0[2], v0[3]); w.z = cvt_pk_bf16(v1[0], v1[1]); w.w = cvt_pk_bf16(v1[2], v1[3]);
                        *(u32x4*)(rp + 8 * bj) = w; } }
        } else {
            const float sc = kind == 3 ? qscale : 1.0f;
            float inv[2][4];
#pragma unroll
            for (int n = 0; n < 2; ++n)
#pragma unroll
                for (int e = 0; e < 4; ++e) inv[n][e] = __builtin_amdgcn_exp2f(-(float)(16 * n + 4 * fq + e) * (L2T / 32.0f)) * 0.15915494309189535f;
#pragma unroll
            for (int ai = 0; ai < 2; ++ai)
#pragma unroll
                for (int m = 0; m < 4; ++m) { const int row = row0 + ai * HALF + m * 16; const float pos = (float)(row & 8191);
                    f32x4 v[2][2]; const float sar = I8 ? sa[row] : 1.f;
#pragma unroll
                    for (int n = 0; n < 2; ++n) { const f32x4 a1_ = IP_ACC(ai, 0, m, n, sar), a2_ = IP_ACC(ai, 1, m, n, sar);
#pragma unroll
                        for (int e = 0; e < 4; ++e) { float rev = pos * inv[n][e]; rev = rev - __builtin_floorf(rev);
                            const float sn = __builtin_amdgcn_sinf(rev) * sc, cs = __builtin_amdgcn_cosf(rev) * sc;
                            float x1 = a1_[e], x2 = a2_[e]; asm volatile("" : "+v"(x1), "+v"(x2));
                            v[0][n][e] = x1 * cs - x2 * sn; v[1][n][e] = x2 * cs + x1 * sn; } }
                    bf16_t* rp = outp + (size_t)(ai * HALF + m * 16) * pitch;
#pragma unroll
                    for (int bj = 0; bj < 2; ++bj) { const f32x4 v0 = v[bj][0], v1 = v[bj][1];
                        u32x4 w; w.x = cvt_pk_bf16(v0[0], v0[1]); w.y = cvt_pk_bf16(v0[2], v0[3]); w.z = cvt_pk_bf16(v1[0], v1[1]); w.w = cvt_pk_bf16(v1[2], v1[3]);
                        *(u32x4*)(rp + 8 * bj) = w; } }
        }
    }
#undef IP_ACC
};
typedef EpiInProjT<false> EpiInProj;
typedef EpiInProjT<true> EpiInProjI8;


template <class Epi, class Sched, bool ALIGN_EPI = false, bool SP2 = false, bool F8 = false, bool I8 = false>
__device__ __forceinline__ void gemm_phase(PG8_LAS unsigned char* lds, const Gemm g, const Sched& S, const Epi& E, int wave_in) {
    int tid_; asm volatile("v_mbcnt_lo_u32_b32 %0, -1, 0\n\tv_mbcnt_hi_u32_b32 %0, -1, %0" : "=v"(tid_)); tid_ += wave_in * 64;
    const int tid = tid_, wid = __builtin_amdgcn_readfirstlane(tid >> 6), lane = tid & 63, wr = wid >> 2, wc = wid & 3, fr = lane & 15, fq = lane >> 4;
    const int K = g.K, nt = K / BK;
    unsigned voffA, voffB;
    { int R, C; stage_rc(tid * 16, R, C); const int Rb = Epi::PERM ? ((R & ~31) + perm32(R & 31)) : R; voffA = (unsigned)(R * K + C) * 2u; voffB = (unsigned)(Rb * K + C) * 2u; }
    const size_t qstep = (size_t)64 * K * 2;
    const size_t kstep = (size_t)(BK * 2);
    const size_t hstep = (size_t)HALF * K * 2;
    const size_t tstep = 2 * hstep;
    const unsigned ldsw = (unsigned)wid * 1024u;
    const int aoff = F8 ? lds_byte(wr * 64 + fr, fq * 16) : lds_byte(wr * 64 + fr, fq * 8), boff = F8 ? lds_byte(wc * 32 + fr, fq * 16) : lds_byte(wc * 32 + fr, fq * 8);
#define PG8_SA(b, h) (((b) * 2 + (h)) * HTB)
#define PG8_SB(b, h) ((4 + (b) * 2 + (h)) * HTB)
#define PG8_STAGE(bufoff, gbase, voff) do { _Pragma("unroll") for (int _i = 0; _i < 2; ++_i) \
        __builtin_amdgcn_global_load_lds((const unsigned*)((const char*)(gbase) + _i * qstep + (voff)), (PG8_LAS unsigned*)(lds + (bufoff) + ldsw + _i * 8192), 16, 0, 0); } while (0)
#define PG8_LDF(off) (*(const PG8_LAS bf16x8*)(lds + (off)))
#define PG8_LDA(dst, b, h) do { if constexpr (!F8) { _Pragma("unroll") for (int m = 0; m < 4; ++m) _Pragma("unroll") for (int k = 0; k < 2; ++k) dst[m][k] = PG8_LDF(PG8_SA(b, h) + aoff + m * 2048 + k * 1024); } \
        else { _Pragma("unroll") for (int m = 0; m < 4; ++m) dst##8[m] = *(const PG8_LAS i32x8*)(lds + PG8_SA(b, h) + aoff + m * 2048); } } while (0)
#define PG8_LDB(dst, b, h) do { if constexpr (!F8) { _Pragma("unroll") for (int n = 0; n < 2; ++n) _Pragma("unroll") for (int k = 0; k < 2; ++k) dst[n][k] = PG8_LDF(PG8_SB(b, h) + boff + n * 2048 + k * 1024); } \
        else { _Pragma("unroll") for (int n = 0; n < 2; ++n) dst##8[n] = *(const PG8_LAS i32x8*)(lds + PG8_SB(b, h) + boff + n * 2048); } } while (0)
#define PG8_MMA(ai, bj, At, Bt) do { __builtin_amdgcn_s_setprio(1); if constexpr (!F8) { _Pragma("unroll") for (int m = 0; m < 4; ++m) _Pragma("unroll") for (int n = 0; n < 2; ++n) _Pragma("unroll") for (int k = 0; k < 2; ++k) \
        { if constexpr (I8) acc[ai][bj][m][n] = __builtin_bit_cast(f32x4, __builtin_amdgcn_mfma_i32_16x16x64_i8(__builtin_bit_cast(i32x4, Bt[n][k]), __builtin_bit_cast(i32x4, At[m][k]), __builtin_bit_cast(i32x4, acc[ai][bj][m][n]), 0, 0, 0)); \
          else acc[ai][bj][m][n] = __builtin_amdgcn_mfma_f32_16x16x32_bf16(Bt[n][k], At[m][k], acc[ai][bj][m][n], 0, 0, 0); } } else { \
        _Pragma("unroll") for (int m = 0; m < 4; ++m) _Pragma("unroll") for (int n = 0; n < 2; ++n) \
        asm volatile("v_mfma_scale_f32_16x16x128_f8f6f4 %0, %1, %2, %0, %3, %3 op_sel_hi:[0,0,0]" : "+v"(acc[ai][bj][m][n]) : "v"(Bt##8[n]), "v"(At##8[m]), "v"(f8scale)); } \
        __builtin_amdgcn_s_setprio(0); } while (0)
#define PG8_CAT(x, y) __builtin_shufflevector(__builtin_bit_cast(i32x4, x), __builtin_bit_cast(i32x4, y), 0, 1, 2, 3, 4, 5, 6, 7)
#define PG8_WAIT_V(n) asm volatile("s_waitcnt vmcnt(" #n ")" ::: "memory")
#define PG8_WAIT_L(n) asm volatile("s_waitcnt lgkmcnt(" #n ")" ::: "memory")
#define PG8_BAR __builtin_amdgcn_s_barrier()
#define PG8_SCHED __builtin_amdgcn_sched_barrier(0)
    Unit cur, nxt; int ui = 0;
    if (!S.next(0, cur)) return;
    f32x4 acc[2][2][4][2];
#pragma unroll
    for (int a = 0; a < 2; ++a)
#pragma unroll
        for (int b = 0; b < 2; ++b)
#pragma unroll
            for (int m = 0; m < 4; ++m)
#pragma unroll
                for (int n = 0; n < 2; ++n) acc[a][b][m][n] = (f32x4){0.f, 0.f, 0.f, 0.f};
    const int f8scale = 0x7f7f7f7f;
    bf16x8 At[4][2], B0[2][2], B1[2][2]; i32x8 At8[4], B08[2], B18[2];
    const char* cA = (const char*)g.A + (size_t)cur.pm * tstep; const char* cB = (const char*)g.Bt + S.bofs(cur) + (size_t)cur.pn * tstep;
    S.a_ready(cur);
    if constexpr (SP2) {
        PG8_STAGE(PG8_SB(0, 0), cB, voffB); PG8_STAGE(PG8_SB(0, 1), cB + hstep, voffB); PG8_STAGE(PG8_SA(0, 0), cA, voffA); PG8_STAGE(PG8_SA(0, 1), cA + hstep, voffA);
        if (wr == 1) PG8_BAR;
        PG8_WAIT_V(2); PG8_BAR;
        PG8_STAGE(PG8_SB(1, 0), cB + kstep, voffB); PG8_STAGE(PG8_SA(1, 0), cA + kstep, voffA); PG8_STAGE(PG8_SB(1, 1), cB + hstep + kstep, voffB);
        PG8_WAIT_V(6); PG8_BAR;
    } else {
        PG8_STAGE(PG8_SB(0, 0), cB, voffB); PG8_STAGE(PG8_SA(0, 0), cA, voffA); PG8_STAGE(PG8_SB(0, 1), cB + hstep, voffB); PG8_STAGE(PG8_SA(0, 1), cA + hstep, voffA);
        if (wr == 1) PG8_BAR;
        PG8_WAIT_V(4); PG8_BAR;
        PG8_STAGE(PG8_SB(1, 0), cB + kstep, voffB); PG8_STAGE(PG8_SA(1, 0), cA + kstep, voffA); PG8_STAGE(PG8_SB(1, 1), cB + hstep + kstep, voffB);
        PG8_WAIT_V(6); PG8_BAR;
    }
    for (;;) {
        const bool has_next = S.next(ui + 1, nxt);
        const char* nA = has_next ? (const char*)g.A + (size_t)nxt.pm * tstep : cA; const char* nB = has_next ? (const char*)g.Bt + S.bofs(nxt) + (size_t)nxt.pn * tstep : cB;
#pragma nounroll
        for (int t = 0; t < nt; t += 2) {
            const bool last = (t == nt - 2);
            const char* a1 = cA + (size_t)(t + 1) * kstep;
            const char* a2 = last ? nA : cA + (size_t)(t + 2) * kstep; const char* b2 = last ? nB : cB + (size_t)(t + 2) * kstep;
            const char* a3 = a2 + kstep; const char* b3 = b2 + kstep;
            if (last && has_next) S.a_ready(nxt);
            if constexpr (SP2) {
            PG8_LDB(B0, 0, 0); PG8_LDB(B1, 0, 1); PG8_SCHED; PG8_LDA(At, 0, 0); PG8_STAGE(PG8_SA(1, 1), a1 + hstep, voffA);
            PG8_WAIT_V(8); PG8_WAIT_L(0); PG8_BAR; PG8_MMA(0, 0, At, B0); PG8_MMA(0, 1, At, B1); PG8_BAR; PG8_SCHED;
            PG8_LDA(At, 0, 1); PG8_STAGE(PG8_SB(0, 0), b2, voffB); PG8_STAGE(PG8_SB(0, 1), b2 + hstep, voffB); PG8_STAGE(PG8_SA(0, 0), a2, voffA);
            PG8_WAIT_V(8); PG8_WAIT_L(0); PG8_BAR; PG8_MMA(1, 0, At, B0); PG8_MMA(1, 1, At, B1); PG8_BAR; PG8_SCHED;
            PG8_LDB(B0, 1, 0); PG8_LDB(B1, 1, 1); PG8_SCHED; PG8_LDA(At, 1, 0); PG8_STAGE(PG8_SA(0, 1), a2 + hstep, voffA);
            PG8_WAIT_V(8); PG8_WAIT_L(0); PG8_BAR; PG8_MMA(0, 0, At, B0); PG8_MMA(0, 1, At, B1); PG8_BAR; PG8_SCHED;
            PG8_LDA(At, 1, 1); PG8_STAGE(PG8_SB(1, 0), b3, voffB); PG8_STAGE(PG8_SB(1, 1), b3 + hstep, voffB); PG8_STAGE(PG8_SA(1, 0), a3, voffA);
            PG8_WAIT_V(8); PG8_WAIT_L(0); PG8_BAR; PG8_MMA(1, 0, At, B0); PG8_MMA(1, 1, At, B1); PG8_BAR; PG8_SCHED;
            } else {
            PG8_LDB(B0, 0, 0); PG8_SCHED; PG8_LDA(At, 0, 0); PG8_STAGE(PG8_SA(1, 1), a1 + hstep, voffA);
            PG8_WAIT_L(8); PG8_BAR; PG8_WAIT_L(0); PG8_MMA(0, 0, At, B0); PG8_BAR; PG8_SCHED;
            PG8_LDB(B1, 0, 1); PG8_STAGE(PG8_SB(0, 0), b2, voffB);
            PG8_BAR; PG8_WAIT_L(0); PG8_MMA(0, 1, At, B1); PG8_BAR;
            PG8_LDA(At, 0, 1); PG8_STAGE(PG8_SA(0, 0), a2, voffA);
            PG8_BAR; PG8_WAIT_L(0); PG8_MMA(1, 0, At, B0); PG8_BAR; PG8_SCHED;
            PG8_STAGE(PG8_SB(0, 1), b2 + hstep, voffB);
            PG8_WAIT_V(6); PG8_BAR; PG8_MMA(1, 1, At, B1); PG8_BAR;
            PG8_LDB(B0, 1, 0); PG8_SCHED; PG8_LDA(At, 1, 0); PG8_STAGE(PG8_SA(0, 1), a2 + hstep, voffA);
            PG8_WAIT_L(8); PG8_BAR; PG8_WAIT_L(0); PG8_MMA(0, 0, At, B0); PG8_BAR; PG8_SCHED;
            PG8_LDB(B1, 1, 1); PG8_STAGE(PG8_SB(1, 0), b3, voffB);
            PG8_BAR; PG8_WAIT_L(0); PG8_MMA(0, 1, At, B1); PG8_BAR;
            PG8_LDA(At, 1, 1); PG8_STAGE(PG8_SA(1, 0), a3, voffA);
            PG8_BAR; PG8_WAIT_L(0); PG8_MMA(1, 0, At, B0); PG8_BAR; PG8_SCHED;
            PG8_STAGE(PG8_SB(1, 1), b3 + hstep, voffB);
            PG8_WAIT_V(6); PG8_BAR; PG8_MMA(1, 1, At, B1); PG8_BAR;
            }
        }
        if constexpr (F8) { asm volatile("s_nop 15\n\ts_nop 15\n\ts_nop 15\n\ts_nop 15" ::: "memory");
            _Pragma("unroll") for (int m = 0; m < 4; ++m) asm volatile("" :: "v"(At8[m]));
            _Pragma("unroll") for (int n = 0; n < 2; ++n) asm volatile("" :: "v"(B08[n]), "v"(B18[n])); }
        if constexpr (ALIGN_EPI) { if (wr == 0) PG8_BAR; }
        if constexpr (!Epi::AFTER_DRAIN) { E(acc, cur, wr, wc, fr, fq); S.done(cur); }
        if (!has_next) break;
#pragma unroll
        for (int a = 0; a < 2; ++a)
#pragma unroll
            for (int b = 0; b < 2; ++b)
#pragma unroll
                for (int m = 0; m < 4; ++m)
#pragma unroll
                    for (int n = 0; n < 2; ++n) acc[a][b][m][n] = (f32x4){0.f, 0.f, 0.f, 0.f};
        cur = nxt; cA = nA; cB = nB; ++ui;
        if constexpr (ALIGN_EPI) { if (wr == 1) PG8_BAR; }
    }
    PG8_WAIT_V(0);
    if constexpr (!ALIGN_EPI) { if (wr == 0) PG8_BAR; }
    PG8_BAR;
    if constexpr (Epi::AFTER_DRAIN) { E.fused(acc, cur, wr, wc, fr, fq, lds, wid, lane); S.done(cur); }
#undef PG8_SA
#undef PG8_SB
#undef PG8_STAGE
#undef PG8_LDA
#undef PG8_LDF
#undef PG8_LDB
#undef PG8_MMA
#undef PG8_CAT
#undef PG8_WAIT_V
#undef PG8_WAIT_L
#undef PG8_BAR
#undef PG8_SCHED
}
}
namespace attn_body {
using bf16=__hip_bfloat16;
using bf16x8=__attribute__((ext_vector_type(8)))short;
using s16x4=__attribute__((ext_vector_type(4)))short;
using f32x16=__attribute__((ext_vector_type(16)))float;
using u32x4=__attribute__((ext_vector_type(4)))unsigned;
constexpr int SEQ=8192,D=64;
constexpr int NW=8,QBLK=32,QB=QBLK*NW,KVBLK=64,NQB=SEQ/QB;
constexpr int ATTN_UNIT_ROWS=QB;
__device__ __forceinline__ int crow(int r,int hi){return (r&3)+8*(r>>2)+4*hi;}
#define SBAR() __builtin_amdgcn_sched_barrier(0)
__device__ __forceinline__ void cmask(f32x16&p0,f32x16&p1,int jb,int qrel,int hi){
  const float NEG=-INFINITY; int kb=64*jb+4*hi;
  #pragma unroll
  for(int r=0;r<16;++r){int kv=kb+(r&3)+8*(r>>2); if(kv>qrel)p0[r]=NEG; if(kv+32>qrel)p1[r]=NEG;}
}

constexpr int NSLOT=3, SLOTB=8192;
constexpr int LDS_K=0, LDS_V=NSLOT*SLOTB, LDS_WS=LDS_V+NSLOT*2*SLOTB, LDS_OST=LDS_WS+NW*64*4, LDS_BYTES=LDS_OST+NW*4096;
constexpr float C2=0.125f*1.4426950408889634f;
__device__ __forceinline__ void glds16(const void*gsrc,unsigned lds_dst){unsigned keep;
  asm volatile("s_mov_b32 %0, m0\n\ts_mov_b32 m0, %2\n\ts_nop 0\n\tglobal_load_lds_dwordx4 %1, off\n\ts_mov_b32 m0, %0":"=&s"(keep):"v"(gsrc),"s"(lds_dst):"memory");}
__device__ __forceinline__ float max3f(float a,float b,float c){float r;asm("v_max3_f32 %0, %1, %2, %3":"=v"(r):"v"(a),"v"(b),"v"(c));return r;}
__device__ __forceinline__ float max2f(float a,float b){float r;asm("v_max_f32_e32 %0, %1, %2":"=v"(r):"v"(a),"v"(b));return r;}
__device__ __forceinline__ float fadd_s(float a,float b){float r;asm("v_add_f32_e32 %0, %1, %2":"=v"(r):"v"(a),"v"(b));return r;}
__device__ __forceinline__ float fsub_s(float a,float b){float r;asm("v_sub_f32_e32 %0, %1, %2":"=v"(r):"v"(a),"v"(b));return r;}
typedef float f32x2_t __attribute__((ext_vector_type(2))); typedef __bf16 bf16x2_t __attribute__((ext_vector_type(2)));
__device__ __forceinline__ unsigned cvtpk_s(float lo,float hi){f32x2_t v={lo,hi};bf16x2_t b=__builtin_convertvector(v,bf16x2_t);return __builtin_bit_cast(unsigned,b);}
#define WAIT_BAR(N) asm volatile("s_waitcnt vmcnt(" #N ") lgkmcnt(0)\n\ts_barrier":::"memory")

__device__ __forceinline__ void qkt(f32x16&p0,f32x16&p1,const char*Kslot,const bf16x8*qr,const f32x16&negm,int r32,int hi){
  const char*kb=Kslot+hi*1024+r32*16;
  #pragma unroll
  for(int d0=0;d0<4;++d0){
    const bf16x8 b0=*reinterpret_cast<const bf16x8*>(kb+d0*2048);
    const bf16x8 b1=*reinterpret_cast<const bf16x8*>(kb+d0*2048+512);
    if(d0==0){p0=__builtin_amdgcn_mfma_f32_32x32x16_bf16(b0,qr[0],negm,0,0,0);p1=__builtin_amdgcn_mfma_f32_32x32x16_bf16(b1,qr[0],negm,0,0,0);}
    else{p0=__builtin_amdgcn_mfma_f32_32x32x16_bf16(b0,qr[d0],p0,0,0,0);p1=__builtin_amdgcn_mfma_f32_32x32x16_bf16(b1,qr[d0],p1,0,0,0);}}
}
typedef __attribute__((address_space(3))) const char* lds_cptr;
typedef short v4i16_t __attribute__((ext_vector_type(4)));
__device__ __forceinline__ void kload8(bf16x8*kf,lds_cptr kp){
  kf[0]=*(const __attribute__((address_space(3))) bf16x8*)(kp);      kf[1]=*(const __attribute__((address_space(3))) bf16x8*)(kp+512);
  kf[2]=*(const __attribute__((address_space(3))) bf16x8*)(kp+2048); kf[3]=*(const __attribute__((address_space(3))) bf16x8*)(kp+2560);
  kf[4]=*(const __attribute__((address_space(3))) bf16x8*)(kp+4096); kf[5]=*(const __attribute__((address_space(3))) bf16x8*)(kp+4608);
  kf[6]=*(const __attribute__((address_space(3))) bf16x8*)(kp+6144); kf[7]=*(const __attribute__((address_space(3))) bf16x8*)(kp+6656);
}
__device__ __forceinline__ void kload2(bf16x8*kf,lds_cptr kp,int j){ kf[2*j]=*(const __attribute__((address_space(3))) bf16x8*)(kp+j*2048); kf[2*j+1]=*(const __attribute__((address_space(3))) bf16x8*)(kp+j*2048+512); }
__device__ __forceinline__ s16x4 vtr(lds_cptr p){ return __builtin_bit_cast(s16x4,__builtin_amdgcn_ds_read_tr16_b64_v4i16((__attribute__((address_space(3))) v4i16_t*)p)); }
__device__ __forceinline__ float rowmax(const f32x16&p0,const f32x16&p1){
  float a=max3f(p0[0],p0[1],p1[0]),b=max3f(p0[2],p0[3],p1[1]);a=max3f(a,p1[2],p1[3]);
  #pragma unroll
  for(int r=4;r<16;r+=4){a=max3f(a,p0[r],p0[r+1]);b=max3f(b,p0[r+2],p0[r+3]);a=max3f(a,p1[r],p1[r+1]);b=max3f(b,p1[r+2],p1[r+3]);}
  const float m=max2f(a,b);
  auto rr=__builtin_amdgcn_permlane32_swap(__float_as_uint(m),__float_as_uint(m),false,false);
  return max2f(__uint_as_float(rr[0]),__uint_as_float(rr[1]));
}
template<int NOB> __device__ __forceinline__ void pv(f32x16*o,int vb,bf16x8 pa0,bf16x8 pa1,bf16x8 pa2,bf16x8 pa3){
  #pragma unroll
  for(int d0=0;d0<NOB;++d0){s16x4 lo[4],hi[4];
    #pragma unroll
    for(int ks=0;ks<4;++ks){
      asm volatile("ds_read_b64_tr_b16 %0,%1 offset:%c2":"=&v"(lo[ks]):"v"(vb),"i"(d0*4096+ks*1024):"memory");
      asm volatile("ds_read_b64_tr_b16 %0,%1 offset:%c2":"=&v"(hi[ks]):"v"(vb),"i"(d0*4096+ks*1024+512):"memory");}
    asm volatile("s_waitcnt lgkmcnt(0)":::"memory");SBAR();
    #define PK(k) (bf16x8){lo[k][0],lo[k][1],lo[k][2],lo[k][3],hi[k][0],hi[k][1],hi[k][2],hi[k][3]}
    o[d0]=__builtin_amdgcn_mfma_f32_32x32x16_bf16(pa0,PK(0),o[d0],0,0,0);
    o[d0]=__builtin_amdgcn_mfma_f32_32x32x16_bf16(pa1,PK(1),o[d0],0,0,0);
    o[d0]=__builtin_amdgcn_mfma_f32_32x32x16_bf16(pa2,PK(2),o[d0],0,0,0);
    o[d0]=__builtin_amdgcn_mfma_f32_32x32x16_bf16(pa3,PK(3),o[d0],0,0,0);
    #undef PK
  }
}

#ifndef ATTN_STORE16
#define ATTN_STORE16(p,v) (*(u32x4*)(p)=(v))
#endif
template<int THRL,int DV> __device__ __forceinline__ void attn_unit(const bf16*Qu,int QP,const bf16*__restrict__ Kh,int KP,const bf16*__restrict__ Vh,int VP,bf16*Ou,int OP,char*shm,int wave_in){
  int tid_; asm volatile("v_mbcnt_lo_u32_b32 %0, -1, 0\n\tv_mbcnt_hi_u32_b32 %0, -1, %0":"=v"(tid_)); tid_+=wave_in*64; const int tid=tid_,lane=tid&63,r32=lane&31,hi=lane>>5; const int wid=__builtin_amdgcn_readfirstlane(tid>>6);
  const bf16*Qw=Qu+(long)(wid*QBLK)*QP;
  constexpr int VS=DV/64, NOB=DV/32;
  const unsigned lds0=(unsigned)(uintptr_t)shm;
  float*wsf=(float*)(shm+LDS_WS)+wid*64;
  const bf16*ksrc=Kh+(long)lane*KP+wid*8;
  const bf16*vsrc=Vh+(long)(16*(wid&3)+(lane>>2))*VP+(wid>>2)*32+(lane&3)*8;
  const unsigned kdst=lds0+LDS_K+wid*1024, vdst=lds0+LDS_V+wid*1024;
  #define DMA_K(t,slot) glds16(ksrc+(long)(t)*KVBLK*KP,(unsigned)__builtin_amdgcn_readfirstlane(kdst+(slot)))
  #define DMA_V(t,slot) do{ glds16(vsrc+(long)(t)*KVBLK*VP,(unsigned)__builtin_amdgcn_readfirstlane(vdst+VS*(slot))); if constexpr(VS==2) glds16(vsrc+(long)(t)*KVBLK*VP+64,(unsigned)__builtin_amdgcn_readfirstlane(vdst+VS*(slot)+8192)); }while(0)
  const int vb0=(int)(lds0+LDS_V)+((lane>>4)&1)*32+(lane&3)*8+(4*hi+((lane&15)>>2))*64;
  const char*Kbase=shm+LDS_K; bf16x8 kf[8];
  const lds_cptr shm3=(lds_cptr)shm; const lds_cptr kp0=shm3+LDS_K+hi*1024+r32*16; const lds_cptr vp0=shm3+LDS_V+((lane>>4)&1)*32+(lane&3)*8+(4*hi+((lane&15)>>2))*64;
  constexpr int NT=SEQ/KVBLK;
  DMA_K(0,0);DMA_V(0,0);DMA_K(1,SLOTB);
  bf16x8 qr[4];
  #pragma unroll
  for(int d0=0;d0<4;++d0)qr[d0]=*reinterpret_cast<const bf16x8*>(&Qw[(long)r32*QP+d0*16+hi*8]);
  float mhat=0.f,l_reg=0.f;f32x16 o[NOB];
  #pragma unroll
  for(int d_=0;d_<NOB;++d_)o[d_]=f32x16{};
  f32x16 negm=f32x16{};asm volatile("":"+v"(negm));
  #define CMASK(P0,P1,t) do{}while(0)
  bool resc=false;
  #define START(P0,P1) do{ const float rm=rowmax(P0,P1); resc=false; \
    { const float dl=rm; mhat=fadd_s(mhat,dl); \
      _Pragma("unroll") for(int r=0;r<16;++r){P0[r]=fsub_s(P0[r],dl);P1[r]=fsub_s(P1[r],dl);} \
      _Pragma("unroll") for(int r=0;r<16;++r)negm[r]=-mhat; asm volatile("":"+v"(negm)); } \
    _Pragma("unroll") for(int r=0;r<16;++r)P0[r]=__builtin_amdgcn_exp2f(P0[r]); }while(0)
  #define RESC() do{ if(resc){ asm volatile("s_waitcnt lgkmcnt(0)":::"memory"); \
      _Pragma("unroll") for(int d_=0;d_<NOB;++d_) _Pragma("unroll") for(int r=0;r<16;++r)o[d_][r]*=wsf[crow(r,hi)]; } }while(0)
  f32x16 pA0,pA1,pB0,pB1;
  int sl_prev=0,sl_cur=0,sl_next=SLOTB;
  #define ROT() do{sl_prev=sl_cur;sl_cur=sl_next;sl_next=(sl_next==(NSLOT-1)*SLOTB)?0:sl_next+SLOTB;}while(0)
  #define WBV(N,N2) do{ if constexpr(VS==2){WAIT_BAR(N2);} else {WAIT_BAR(N);} }while(0)
  DMA_K(2,2*SLOTB);
  WAIT_BAR(3);
  qkt(pA0,pA1,Kbase,qr,negm,r32,hi);asm volatile("s_nop 15\n\ts_nop 7":"+v"(pA0),"+v"(pA1));CMASK(pA0,pA1,0);
  START(pA0,pA1);
  _Pragma("unroll") for(int r=0;r<16;++r)pA1[r]=__builtin_amdgcn_exp2f(pA1[r]);
  WAIT_BAR(0);
  DMA_K(3,0);DMA_V(1,SLOTB);
  ROT();
  kload8(kf,kp0+sl_cur);
  WBV(2,3);
  s16x4 vlo[8],vhi[8]; u32x4 pw0,pw1,pw2,pw3;
  #define PKW(P,B) cvtpk_s(P[B],P[B+1])
  #define PAF(k) __builtin_bit_cast(bf16x8,pw##k)
  #define VFR(i) (bf16x8){vlo[i][0],vlo[i][1],vlo[i][2],vlo[i][3],vhi[i][0],vhi[i][1],vhi[i][2],vhi[i][3]}
  #define PIN(x) asm volatile("":"+v"(x))
  #define MX3(a,b,c) __builtin_fmaxf(__builtin_fmaxf((a),(b)),(c))
  #define GAPA(MF,A0,A1,A2,A3,W0,W1,PW) do{ MF; sacc+=A0; sacc+=A1; sacc+=A2; sacc+=A3; PIN(sacc); W0; W1; PIN(PW); SBAR(); }while(0)
  #define EX(v) __builtin_amdgcn_exp2f(v)
  #define GAPB(MF,X,B) do{ MF; X[B]=EX(X[B]); X[B+1]=EX(X[B+1]); X[B+2]=EX(X[B+2]); X[B+3]=EX(X[B+3]); PIN(X); SBAR(); }while(0)
  #define GAPB2(MF,RD,X,B) do{ MF; RD; X[B]=EX(X[B]); X[B+1]=EX(X[B+1]); PIN(X); SBAR(); }while(0)
  #define VRD2(i) do{ vlo[i]=vtr(vp_+(8192+((i)>>2)*4096+((i)&3)*1024)); vhi[i]=vtr(vp_+(8192+((i)>>2)*4096+((i)&3)*1024+512)); }while(0)
  #define VRD(i) do{ vlo[i]=vtr(vp_+(((i)>>2)*4096+((i)&3)*1024)); vhi[i]=vtr(vp_+(((i)>>2)*4096+((i)&3)*1024+512)); }while(0)
  #define KRD(G,j) do{ if(G){ kload2(kf,kp0+sl_next,j); SBAR(); } }while(0)
  #define STEP(C0,C1,P0,P1,t,GK,GV,GL) do{ SBAR(); \
    const lds_cptr vp_=vp0+VS*sl_prev; \
    VRD(0); SBAR(); float sacc=(P0[0]+P0[1]); \
    GAPA(C0=__builtin_amdgcn_mfma_f32_32x32x16_bf16(kf[0],qr[0],negm,0,0,0), P0[2],P0[3],P0[4],P0[5],     pw0[0]=PKW(P0,0), pw0[1]=PKW(P0,2), pw0); \
    VRD(4); SBAR(); GAPA(C1=__builtin_amdgcn_mfma_f32_32x32x16_bf16(kf[1],qr[0],negm,0,0,0), P0[6],P0[7],P0[8],P0[9],     pw0[2]=PKW(P0,4), pw0[3]=PKW(P0,6), pw0); \
    VRD(1); SBAR(); GAPA(C0=__builtin_amdgcn_mfma_f32_32x32x16_bf16(kf[2],qr[1],C0,0,0,0),   P0[10],P0[11],P0[12],P0[13], pw1[0]=PKW(P0,8), pw1[1]=PKW(P0,10), pw1); \
    VRD(5); SBAR(); GAPA(C1=__builtin_amdgcn_mfma_f32_32x32x16_bf16(kf[3],qr[1],C1,0,0,0),   P0[14],P0[15],P1[0],P1[1],   pw1[2]=PKW(P0,12),pw1[3]=PKW(P0,14), pw1); \
    VRD(2); SBAR(); GAPA(C0=__builtin_amdgcn_mfma_f32_32x32x16_bf16(kf[4],qr[2],C0,0,0,0),   P1[2],P1[3],P1[4],P1[5],     pw2[0]=PKW(P1,0), pw2[1]=PKW(P1,2), pw2); \
    VRD(6); SBAR(); GAPA(C1=__builtin_amdgcn_mfma_f32_32x32x16_bf16(kf[5],qr[2],C1,0,0,0),   P1[6],P1[7],P1[8],P1[9],     pw2[2]=PKW(P1,4), pw2[3]=PKW(P1,6), pw2); \
    VRD(3); SBAR(); GAPA(C0=__builtin_amdgcn_mfma_f32_32x32x16_bf16(kf[6],qr[3],C0,0,0,0),   P1[10],P1[11],P1[12],P1[13], pw3[0]=PKW(P1,8), pw3[1]=PKW(P1,10), pw3); \
    VRD(7); SBAR(); GAPA(C1=__builtin_amdgcn_mfma_f32_32x32x16_bf16(kf[7],qr[3],C1,0,0,0),   P1[14],P1[15],0.f,0.f,       pw3[2]=PKW(P1,12),pw3[3]=PKW(P1,14), pw3); \
    l_reg+=sacc; \
    if(GK){DMA_K((t)+3,sl_cur);} if(GV){DMA_V((t)+1,sl_next);} \
    CMASK(C0,C1,t); \
    { float a=MX3(C0[0],C0[1],C1[0]),b=MX3(C0[2],C0[3],C1[1]); a=MX3(a,C1[2],C1[3]); \
      _Pragma("unroll") for(int r=4;r<16;r+=4){a=MX3(a,C0[r],C0[r+1]);b=MX3(b,C0[r+2],C0[r+3]);a=MX3(a,C1[r],C1[r+1]);b=MX3(b,C1[r+2],C1[r+3]);} \
      float rm=__builtin_fmaxf(a,b); { auto rr=__builtin_amdgcn_permlane32_swap(__float_as_uint(rm),__float_as_uint(rm),false,false); rm=__builtin_fmaxf(__uint_as_float(rr[0]),__uint_as_float(rr[1])); } \
      resc=false; \
      if(__builtin_expect(__any(rm>(float)THRL),0)){ const float dl=__builtin_fmaxf(rm,0.f); mhat+=dl; \
        _Pragma("unroll") for(int r=0;r<16;++r){C0[r]-=dl;C1[r]-=dl;} \
        _Pragma("unroll") for(int r=0;r<16;++r)negm[r]=-mhat; asm volatile("":"+v"(negm)); \
        const float f=__builtin_amdgcn_exp2f(-dl); l_reg*=f; if(hi==0)wsf[r32]=f; resc=true; } } \
    SBAR(); \
    if constexpr(VS==1){ \
    GAPB(o[0]=__builtin_amdgcn_mfma_f32_32x32x16_bf16(PAF(0),VFR(0),o[0],0,0,0), C0,0); \
    GAPB(o[1]=__builtin_amdgcn_mfma_f32_32x32x16_bf16(PAF(0),VFR(4),o[1],0,0,0), C0,4); \
    KRD(GL,0); GAPB(o[0]=__builtin_amdgcn_mfma_f32_32x32x16_bf16(PAF(1),VFR(1),o[0],0,0,0), C0,8); \
    KRD(GL,1); GAPB(o[1]=__builtin_amdgcn_mfma_f32_32x32x16_bf16(PAF(1),VFR(5),o[1],0,0,0), C0,12); \
    KRD(GL,2); GAPB(o[0]=__builtin_amdgcn_mfma_f32_32x32x16_bf16(PAF(2),VFR(2),o[0],0,0,0), C1,0); \
    KRD(GL,3); GAPB(o[1]=__builtin_amdgcn_mfma_f32_32x32x16_bf16(PAF(2),VFR(6),o[1],0,0,0), C1,4); \
    GAPB(o[0]=__builtin_amdgcn_mfma_f32_32x32x16_bf16(PAF(3),VFR(3),o[0],0,0,0), C1,8); \
    GAPB(o[1]=__builtin_amdgcn_mfma_f32_32x32x16_bf16(PAF(3),VFR(7),o[1],0,0,0), C1,12); \
    } else { \
    GAPB2(o[0]=__builtin_amdgcn_mfma_f32_32x32x16_bf16(PAF(0),VFR(0),o[0],0,0,0), VRD2(0), C0,0); \
    GAPB2(o[1]=__builtin_amdgcn_mfma_f32_32x32x16_bf16(PAF(0),VFR(4),o[1],0,0,0), VRD2(4), C0,2); \
    GAPB2(o[0]=__builtin_amdgcn_mfma_f32_32x32x16_bf16(PAF(1),VFR(1),o[0],0,0,0), VRD2(1), C0,4); \
    GAPB2(o[1]=__builtin_amdgcn_mfma_f32_32x32x16_bf16(PAF(1),VFR(5),o[1],0,0,0), VRD2(5), C0,6); \
    GAPB2(o[0]=__builtin_amdgcn_mfma_f32_32x32x16_bf16(PAF(2),VFR(2),o[0],0,0,0), VRD2(2), C0,8); \
    GAPB2(o[1]=__builtin_amdgcn_mfma_f32_32x32x16_bf16(PAF(2),VFR(6),o[1],0,0,0), VRD2(6), C0,10); \
    GAPB2(o[0]=__builtin_amdgcn_mfma_f32_32x32x16_bf16(PAF(3),VFR(3),o[0],0,0,0), VRD2(3), C0,12); \
    GAPB2(o[1]=__builtin_amdgcn_mfma_f32_32x32x16_bf16(PAF(3),VFR(7),o[1],0,0,0), VRD2(7), C0,14); \
    GAPB2(o[2]=__builtin_amdgcn_mfma_f32_32x32x16_bf16(PAF(0),VFR(0),o[2],0,0,0), (void)0, C1,0); \
    GAPB2(o[3]=__builtin_amdgcn_mfma_f32_32x32x16_bf16(PAF(0),VFR(4),o[3],0,0,0), (void)0, C1,2); \
    KRD(GL,0); GAPB2(o[2]=__builtin_amdgcn_mfma_f32_32x32x16_bf16(PAF(1),VFR(1),o[2],0,0,0), (void)0, C1,4); \
    KRD(GL,1); GAPB2(o[3]=__builtin_amdgcn_mfma_f32_32x32x16_bf16(PAF(1),VFR(5),o[3],0,0,0), (void)0, C1,6); \
    KRD(GL,2); GAPB2(o[2]=__builtin_amdgcn_mfma_f32_32x32x16_bf16(PAF(2),VFR(2),o[2],0,0,0), (void)0, C1,8); \
    KRD(GL,3); GAPB2(o[3]=__builtin_amdgcn_mfma_f32_32x32x16_bf16(PAF(2),VFR(6),o[3],0,0,0), (void)0, C1,10); \
    GAPB2(o[2]=__builtin_amdgcn_mfma_f32_32x32x16_bf16(PAF(3),VFR(3),o[2],0,0,0), (void)0, C1,12); \
    GAPB2(o[3]=__builtin_amdgcn_mfma_f32_32x32x16_bf16(PAF(3),VFR(7),o[3],0,0,0), (void)0, C1,14); \
    } \
    }while(0)
  int t=1;
  for(;t+5<NT;t+=2){
    STEP(pB0,pB1,pA0,pA1,t,true,true,true);     WBV(2,3); RESC(); ROT();
    STEP(pA0,pA1,pB0,pB1,t+1,true,true,true);   WBV(2,3); RESC(); ROT();
  }
  #define ENDW(tt) do{ if((tt)+3<NT){WBV(2,3);} else if((tt)+2<NT){WBV(1,2);} else {WAIT_BAR(0);} }while(0)
  for(;t+1<NT;t+=2){
    STEP(pB0,pB1,pA0,pA1,t,(t+3<NT),(t+1<NT),(t+1<NT));       ENDW(t);   RESC(); ROT();
    STEP(pA0,pA1,pB0,pB1,t+1,(t+4<NT),(t+2<NT),(t+2<NT));     ENDW(t+1); RESC(); ROT();
  }
  STEP(pB0,pB1,pA0,pA1,NT-1,false,false,false); RESC();
  { float sacc=pB0[0]+pB0[1]; _Pragma("unroll") for(int r=2;r<16;++r)sacc+=pB0[r]; _Pragma("unroll") for(int r=0;r<16;++r)sacc+=pB1[r]; l_reg+=sacc;
    pw0=(u32x4){PKW(pB0,0),PKW(pB0,2),PKW(pB0,4),PKW(pB0,6)};pw1=(u32x4){PKW(pB0,8),PKW(pB0,10),PKW(pB0,12),PKW(pB0,14)};pw2=(u32x4){PKW(pB1,0),PKW(pB1,2),PKW(pB1,4),PKW(pB1,6)};pw3=(u32x4){PKW(pB1,8),PKW(pB1,10),PKW(pB1,12),PKW(pB1,14)};
    SBAR(); pv<NOB>(o,vb0+VS*sl_cur,PAF(0),PAF(1),PAF(2),PAF(3)); }
  #undef PKW
  #undef PAF
  #undef VFR
  #undef PIN
  #undef MX3
  #undef GAPA
  #undef GAPB
  #undef GAPB2
  #undef VRD2
  #undef WBV
  #undef EX
  #undef VRD
  #undef KRD
  #undef STEP
  #undef ENDW
  {auto rr=__builtin_amdgcn_permlane32_swap(__float_as_uint(l_reg),__float_as_uint(l_reg),false,false);l_reg=__uint_as_float(rr[0])+__uint_as_float(rr[1]);}
  if(hi==0)wsf[32+r32]=l_reg;asm volatile("s_waitcnt lgkmcnt(0)":::"memory");
  float rli[16];
  #pragma unroll
  for(int r=0;r<16;++r)rli[r]=__builtin_amdgcn_rcpf(wsf[32+crow(r,hi)]);
  bf16*Ow=Ou+(long)(wid*QBLK)*OP;
  { bf16*stg=(bf16*)(shm+LDS_OST)+wid*2048;
    #pragma unroll
    for(int ps=0;ps<VS;++ps){
    #pragma unroll
    for(int r=0;r<16;++r){const int orow=crow(r,hi);
      #pragma unroll
      for(int d0=0;d0<2;++d0)stg[orow*64+d0*32+r32]=__float2bfloat16(o[2*ps+d0][r]*rli[r]);}
    asm volatile("s_waitcnt lgkmcnt(0)":::"memory");
    #pragma unroll
    for(int i=0;i<4;++i){const int row=i*8+(lane>>3),ch=lane&7; const u32x4 v=*(const u32x4*)(stg+row*64+ch*8); ATTN_STORE16(Ow+(long)row*OP+ps*64+ch*8,v);}
    asm volatile("s_waitcnt lgkmcnt(0)":::"memory"); } }
  asm volatile("s_waitcnt lgkmcnt(0)\n\ts_barrier":::"memory");
  #undef DMA_K
  #undef DMA_V
  #undef CMASK
  #undef START
  #undef RESC
  #undef ROT
}
constexpr float V8SCALE=8.f, P8BIAS=2.f;
template<int DV> __device__ __forceinline__ void attn_unit8(const bf16*Qu,int QP,const bf16*__restrict__ Kh,int KP,const unsigned char*__restrict__ Vt,bf16*Ou,int OP,char*shm,int wave_in){
  int tid_; asm volatile("v_mbcnt_lo_u32_b32 %0, -1, 0\n\tv_mbcnt_hi_u32_b32 %0, -1, %0":"=v"(tid_)); tid_+=wave_in*64; const int tid=tid_,lane=tid&63,r32=lane&31,hi=lane>>5; const int wid=__builtin_amdgcn_readfirstlane(tid>>6);
  const bf16*Qw=Qu+(long)(wid*QBLK)*QP;
  constexpr int VS=DV/64, NOB=DV/32;
  const unsigned lds0=(unsigned)(uintptr_t)shm;
  constexpr int NKS=4, L8_K=0, L8_V=NKS*SLOTB, L8_WS=L8_V+4*8192, L8_OST=L8_WS+NW*64*4;
  static_assert(L8_OST+NW*4096<=131072,"attn_unit8 LDS");
  float*wsf=(float*)(shm+L8_WS)+wid*64;
  const bf16*ksrc=Kh+(long)lane*KP+wid*8;
  const int vgrp=(DV==128)?(wid>>2):0;
  const unsigned char*vsrc=Vt+(64*vgrp+lane)*64+(wid&3)*16;
  const unsigned kdst=lds0+L8_K+wid*1024, vdst=lds0+L8_V+(wid&3)*(DV*16)+vgrp*1024;
  #define DMA_K(t,slot) glds16(ksrc+(long)(t)*KVBLK*KP,(unsigned)__builtin_amdgcn_readfirstlane(kdst+(slot)))
  #define VSL(t) ((((t))&3)*8192)
  #define DMA_V(t) glds16(vsrc+(long)(t)*(DV*64),(unsigned)__builtin_amdgcn_readfirstlane(vdst+VSL(t)))
  const char*Kbase=shm+L8_K; bf16x8 kf[8];
  const lds_cptr shm3=(lds_cptr)shm; const lds_cptr kp0=shm3+L8_K+hi*1024+r32*16; const lds_cptr vp0=shm3+L8_V+(2*hi)*(DV*16)+r32*16;
  constexpr int NT=SEQ/KVBLK;
  DMA_K(0,0);DMA_V(0);DMA_K(1,SLOTB);
  bf16x8 qr[4];
  #pragma unroll
  for(int d0=0;d0<4;++d0)qr[d0]=*reinterpret_cast<const bf16x8*>(&Qw[(long)r32*QP+d0*16+hi*8]);
  float mhat=0.f,l_reg=0.f;f32x16 o[NOB];
  #pragma unroll
  for(int d_=0;d_<NOB;++d_)o[d_]=f32x16{};
  f32x16 negm=f32x16{};asm volatile("":"+v"(negm));
  #define CMASK(P0,P1,t) do{}while(0)
  bool resc=false;
  #define START(P0,P1) do{ const float rm=rowmax(P0,P1); resc=false; \
    { const float dl=rm-P8BIAS; mhat=fadd_s(mhat,dl); \
      _Pragma("unroll") for(int r=0;r<16;++r){P0[r]=fsub_s(P0[r],dl);P1[r]=fsub_s(P1[r],dl);} \
      _Pragma("unroll") for(int r=0;r<16;++r)negm[r]=-mhat; asm volatile("":"+v"(negm)); } \
    _Pragma("unroll") for(int r=0;r<16;++r)P0[r]=__builtin_amdgcn_exp2f(P0[r]); }while(0)
  #define RESC() do{ if(resc){ asm volatile("s_nop 15\n\ts_nop 15\n\ts_nop 15\n\ts_nop 15\n\ts_nop 15\n\ts_nop 15\n\ts_waitcnt lgkmcnt(0)":::"memory"); \
      _Pragma("unroll") for(int d_=0;d_<NOB;++d_) _Pragma("unroll") for(int r=0;r<16;++r)o[d_][r]*=wsf[crow(r,hi)]; if constexpr(NOB==2){ _Pragma("unroll") for(int r=0;r<16;++r)osum[r]*=wsf[crow(r,hi)]; } } }while(0)
  f32x16 pA0,pA1,pB0,pB1;
  int sl_prev=0,sl_cur=0,sl_next=SLOTB;
  #define ROT() do{sl_prev=sl_cur;sl_cur=sl_next;sl_next=(sl_next==(NKS-1)*SLOTB)?0:sl_next+SLOTB;}while(0)
  #define WBV(N,N2) WAIT_BAR(N)
  DMA_K(2,2*SLOTB);DMA_K(3,3*SLOTB);
  WAIT_BAR(4);
  qkt(pA0,pA1,Kbase,qr,negm,r32,hi);asm volatile("s_nop 15\n\ts_nop 7":"+v"(pA0),"+v"(pA1));CMASK(pA0,pA1,0);
  START(pA0,pA1);
  _Pragma("unroll") for(int r=0;r<16;++r)pA1[r]=__builtin_amdgcn_exp2f(pA1[r]);
  WAIT_BAR(0);
  DMA_V(1);DMA_K(4,0);DMA_V(2);
  ROT();
  kload8(kf,kp0+sl_cur);
  WAIT_BAR(3);
  typedef int i32x8_t __attribute__((ext_vector_type(8))); i32x8_t v8[NOB]; i32x8_t p8={0,0,0,0,0,0,0,0}; const int one8=0x7f7f7f7f; f32x16 osum=f32x16{}; i32x8_t ones8={0x38383838,0x38383838,0x38383838,0x38383838,0x38383838,0x38383838,0x38383838,0x38383838}; if constexpr(NOB==2) asm volatile("":"+v"(ones8));
  #define PK8(g,P,B) do{ int w_=p8[g]; w_=__builtin_amdgcn_cvt_pk_fp8_f32(P[B],P[(B)+1],w_,false); w_=__builtin_amdgcn_cvt_pk_fp8_f32(P[(B)+2],P[(B)+3],w_,true); p8[g]=w_; }while(0)
  #define PS8() asm volatile("v_mfma_scale_f32_32x32x64_f8f6f4 %0, %1, %2, %0, %3, %3 op_sel_hi:[0,0,0]":"+v"(osum):"v"(p8),"v"(ones8),"v"(one8))
  #define PV8(db) asm volatile("v_mfma_scale_f32_32x32x64_f8f6f4 %0, %1, %2, %0, %3, %3 op_sel_hi:[0,0,0]":"+v"(o[db]):"v"(p8),"v"(v8[db]),"v"(one8))
  #define PIN(x) asm volatile("":"+v"(x))
  #define MX3(a,b,c) __builtin_fmaxf(__builtin_fmaxf((a),(b)),(c))
  #define GAPA(MF,A0,A1,A2,A3,W0) do{ MF; if constexpr(NOB==4){ sacc+=A0; sacc+=A1; sacc+=A2; sacc+=A3; PIN(sacc); } W0; PIN(p8); SBAR(); }while(0)
  #define EX(v) __builtin_amdgcn_exp2f(v)
  #define EXR(X,A_,B_) do{ _Pragma("unroll") for(int r_=(A_);r_<(B_);++r_)X[r_]=EX(X[r_]); }while(0)
  #define GAPB8(MF,X,B) do{ MF; _Pragma("unroll") for(int r_=0;r_<8;++r_)X[(B)+r_]=EX(X[(B)+r_]); PIN(X); SBAR(); }while(0)
  #define GAPB16(MF,X) do{ MF; _Pragma("unroll") for(int r_=0;r_<16;++r_)X[r_]=EX(X[r_]); PIN(X); SBAR(); }while(0)
  typedef int i32x4_t __attribute__((ext_vector_type(4)));
  #define VRD8(db) do{ const i32x4_t lo_=*(const __attribute__((address_space(3))) i32x4_t*)(vp_+(db)*512), hi_=*(const __attribute__((address_space(3))) i32x4_t*)(vp_+(db)*512+DV*16); v8[db]=__builtin_shufflevector(lo_,hi_,0,1,2,3,4,5,6,7); }while(0)
  #define KRD(G,j) do{ if(G){ kload2(kf,kp0+sl_next,j); SBAR(); } }while(0)
  #define STEP(C0,C1,P0,P1,t,GK,GV,GL) do{ SBAR(); \
    const lds_cptr vp_=vp0+VSL((t)-1); \
    VRD8(0); SBAR(); float sacc=(NOB==4)?(P0[0]+P0[1]):0.f; \
    GAPA(C0=__builtin_amdgcn_mfma_f32_32x32x16_bf16(kf[0],qr[0],negm,0,0,0), P0[2],P0[3],P0[4],P0[5],     PK8(0,P0,0)); \
    VRD8(1); SBAR(); GAPA(C1=__builtin_amdgcn_mfma_f32_32x32x16_bf16(kf[1],qr[0],negm,0,0,0), P0[6],P0[7],P0[8],P0[9],     PK8(1,P0,4)); \
    if constexpr(NOB==4){ VRD8(2); SBAR(); } GAPA(C0=__builtin_amdgcn_mfma_f32_32x32x16_bf16(kf[2],qr[1],C0,0,0,0),   P0[10],P0[11],P0[12],P0[13], PK8(2,P0,8)); \
    if constexpr(NOB==4){ VRD8(3); SBAR(); } GAPA(C1=__builtin_amdgcn_mfma_f32_32x32x16_bf16(kf[3],qr[1],C1,0,0,0),   P0[14],P0[15],P1[0],P1[1],   PK8(3,P0,12)); \
    GAPA(C0=__builtin_amdgcn_mfma_f32_32x32x16_bf16(kf[4],qr[2],C0,0,0,0),   P1[2],P1[3],P1[4],P1[5],     PK8(4,P1,0)); \
    GAPA(C1=__builtin_amdgcn_mfma_f32_32x32x16_bf16(kf[5],qr[2],C1,0,0,0),   P1[6],P1[7],P1[8],P1[9],     PK8(5,P1,4)); \
    GAPA(C0=__builtin_amdgcn_mfma_f32_32x32x16_bf16(kf[6],qr[3],C0,0,0,0),   P1[10],P1[11],P1[12],P1[13], PK8(6,P1,8)); \
    GAPA(C1=__builtin_amdgcn_mfma_f32_32x32x16_bf16(kf[7],qr[3],C1,0,0,0),   P1[14],P1[15],0.f,0.f,       PK8(7,P1,12)); \
    l_reg+=sacc; \
    if(GK){DMA_K((t)+4,sl_cur);} if(GV){DMA_V((t)+2);} \
    CMASK(C0,C1,t); \
    { float a=MX3(C0[0],C0[1],C1[0]),b=MX3(C0[2],C0[3],C1[1]); a=MX3(a,C1[2],C1[3]); \
      _Pragma("unroll") for(int r=4;r<16;r+=4){a=MX3(a,C0[r],C0[r+1]);b=MX3(b,C0[r+2],C0[r+3]);a=MX3(a,C1[r],C1[r+1]);b=MX3(b,C1[r+2],C1[r+3]);} \
      float rm=__builtin_fmaxf(a,b); { auto rr=__builtin_amdgcn_permlane32_swap(__float_as_uint(rm),__float_as_uint(rm),false,false); rm=__builtin_fmaxf(__uint_as_float(rr[0]),__uint_as_float(rr[1])); } \
      resc=false; \
      if(__builtin_expect(__any(rm>8.0f),0)){ const float dl=__builtin_fmaxf(rm-P8BIAS,0.f); mhat+=dl; \
        _Pragma("unroll") for(int r=0;r<16;++r){C0[r]-=dl;C1[r]-=dl;} \
        _Pragma("unroll") for(int r=0;r<16;++r)negm[r]=-mhat; asm volatile("":"+v"(negm)); \
        const float f=__builtin_amdgcn_exp2f(-dl); l_reg*=f; if(hi==0)wsf[r32]=f; resc=true; } } \
    SBAR(); \
    if constexpr(NOB==2){ \
    PS8(); EXR(C0,0,10); PIN(C0); SBAR(); KRD(GL,0); \
    PV8(0); EXR(C0,10,16); EXR(C1,0,5); PIN(C0); PIN(C1); SBAR(); KRD(GL,1); KRD(GL,2); \
    PV8(1); EXR(C1,5,16); PIN(C1); SBAR(); KRD(GL,3); \
    } else { \
    GAPB8(PV8(0), C0,0); KRD(GL,0); \
    GAPB8(PV8(1), C0,8); KRD(GL,1); \
    GAPB8(PV8(2), C1,0); KRD(GL,2); \
    GAPB8(PV8(3), C1,8); KRD(GL,3); \
    } \
    }while(0)
  int t=1;
  for(;t+5<NT;t+=2){
    STEP(pB0,pB1,pA0,pA1,t,true,true,true);     WAIT_BAR(4); RESC(); ROT();
    STEP(pA0,pA1,pB0,pB1,t+1,true,true,true);   WAIT_BAR(4); RESC(); ROT();
  }
  #define ENDW(tt) do{ if((tt)+4<NT){WAIT_BAR(4);} else {WAIT_BAR(0);} }while(0)
  for(;t+1<NT;t+=2){
    STEP(pB0,pB1,pA0,pA1,t,(t+4<NT),(t+2<NT),(t+1<NT));       ENDW(t);   RESC(); ROT();
    STEP(pA0,pA1,pB0,pB1,t+1,(t+5<NT),(t+3<NT),(t+2<NT));     ENDW(t+1); RESC(); ROT();
  }
  STEP(pB0,pB1,pA0,pA1,NT-1,false,false,false); RESC();
  { if constexpr(NOB==4){ float sacc=pB0[0]+pB0[1]; _Pragma("unroll") for(int r=2;r<16;++r)sacc+=pB0[r]; _Pragma("unroll") for(int r=0;r<16;++r)sacc+=pB1[r]; l_reg+=sacc; }
    PK8(0,pB0,0);PK8(1,pB0,4);PK8(2,pB0,8);PK8(3,pB0,12);PK8(4,pB1,0);PK8(5,pB1,4);PK8(6,pB1,8);PK8(7,pB1,12);
    SBAR(); { const lds_cptr vp_=vp0+VSL(NT-1);
      #pragma unroll
      for(int db=0;db<NOB;++db)VRD8(db);
      if constexpr(NOB==2) PS8();
      #pragma unroll
      for(int db=0;db<NOB;++db)PV8(db);
      asm volatile("s_nop 15\n\ts_nop 15\n\ts_nop 15\n\ts_nop 15\n\ts_nop 15\n\ts_nop 15\n\ts_nop 15\n\ts_nop 15\n\ts_nop 15\n\ts_nop 15":::"memory");
      #pragma unroll
      for(int db=0;db<NOB;++db) asm volatile("":"+v"(o[db]):"v"(v8[db]),"v"(p8));
      if constexpr(NOB==2) asm volatile("":"+v"(osum):"v"(ones8),"v"(p8)); } }
  #undef PK8
  #undef PV8
  #undef PS8
  #undef VRD8
  #undef PIN
  #undef MX3
  #undef GAPA
  #undef GAPB8
  #undef EXR
  #undef GAPB16
  #undef WBV
  #undef EX
  #undef KRD
  #undef STEP
  #undef ENDW
  float rli[16];
  if constexpr(NOB==2){
    #pragma unroll
    for(int r=0;r<16;++r)rli[r]=__builtin_amdgcn_rcpf(osum[r])*(1.0f/V8SCALE);
  } else {
    {auto rr=__builtin_amdgcn_permlane32_swap(__float_as_uint(l_reg),__float_as_uint(l_reg),false,false);l_reg=__uint_as_float(rr[0])+__uint_as_float(rr[1]);}
    if(hi==0)wsf[32+r32]=l_reg;asm volatile("s_waitcnt lgkmcnt(0)":::"memory");
    #pragma unroll
    for(int r=0;r<16;++r)rli[r]=__builtin_amdgcn_rcpf(wsf[32+crow(r,hi)])*(1.0f/V8SCALE);
  }
  bf16*Ow=Ou+(long)(wid*QBLK)*OP;
  { bf16*stg=(bf16*)(shm+L8_OST)+wid*2048;
    #pragma unroll
    for(int ps=0;ps<VS;++ps){
    #pragma unroll
    for(int r=0;r<16;++r){const int orow=crow(r,hi);
      #pragma unroll
      for(int d0=0;d0<2;++d0)stg[orow*64+d0*32+r32]=__float2bfloat16(o[2*ps+d0][r]*rli[r]);}
    asm volatile("s_waitcnt lgkmcnt(0)":::"memory");
    #pragma unroll
    for(int i=0;i<4;++i){const int row=i*8+(lane>>3),ch=lane&7; const u32x4 v=*(const u32x4*)(stg+row*64+ch*8); ATTN_STORE16(Ow+(long)row*OP+ps*64+ch*8,v);}
    asm volatile("s_waitcnt lgkmcnt(0)":::"memory"); } }
  asm volatile("s_waitcnt lgkmcnt(0)\n\ts_barrier":::"memory");
  #undef DMA_K
  #undef DMA_V
  #undef VSL
  #undef CMASK
  #undef START
  #undef RESC
  #undef ROT
}
constexpr int ATTN_LDS_BYTES=LDS_BYTES;
#undef SBAR
#undef WAIT_BAR
}
constexpr int NWAVES = 8;
constexpr int NTOK = 65536, SEQL = 8192, DM = 1024, INW = 2304, DFF = 3584, NEXP = 8, NLAYER = 2;
constexpr float EPS = 1e-6f;
constexpr size_t MiB = 1u << 20;
constexpr size_t WS_CTL = 0, CTL_ZERO_BYTES = 128 * 1024;
constexpr size_t WS_WIN = 1 * MiB;
constexpr size_t WS_WOUT = 10 * MiB;
constexpr size_t WS_WGU_D = 14 * MiB;
constexpr size_t WS_WDN_D = 28 * MiB;
constexpr size_t WS_WGU_M = 35 * MiB;
constexpr size_t WS_WDN_M = 91 * MiB;
constexpr size_t WS_HN = 203 * MiB;
constexpr size_t WS_QA = 331 * MiB, WS_QB = 395 * MiB, WS_KA = 459 * MiB, WS_VA = 475 * MiB, WS_KB = 491 * MiB, WS_VB = 555 * MiB;
constexpr size_t WS_OA = 619 * MiB, WS_OB = 683 * MiB;
constexpr size_t WS_AO = 331 * MiB;
constexpr size_t WS_MIX = 491 * MiB;
constexpr size_t WS_XS = 331 * MiB;
constexpr size_t WS_YS = 463 * MiB;
constexpr size_t WS_ACT8 = 727 * MiB;
constexpr float A8SCALE = 16.f, W8SCALE = 256.f, H8SCALE = 8.f;
constexpr size_t WS_ACT = 595 * MiB;
constexpr size_t WS_F = 819 * MiB;
constexpr size_t WS_VT8 = WS_F;
constexpr size_t WS_TOK = 947 * MiB;
constexpr size_t WS_WGB = 948 * MiB;
constexpr size_t WS_END = 949 * MiB;
#ifndef PROJ_I8
#define PROJ_I8 1
#endif
#define PROJ_I8_IN ((PROJ_I8 & 1) != 0)
#define PROJ_I8_OUT ((PROJ_I8 & 2) != 0)
#ifndef DENSE_I8
#define DENSE_I8 1
#endif
#ifndef DENSE_F8
#define DENSE_F8 0
#endif
constexpr int CHUNK_TILES = 128;
constexpr int CW_TMO = 0, CW_CODE = 1, CW_BAR = 4096, CW_CNT = 8192, CW_CMAX = 9000;
constexpr int CW_CMAX_IN = 16384, CW_CMAX_OUT = 21000;
constexpr size_t WS_SWIN = WS_WIN + 5 * MiB, WS_SWOUT = WS_WOUT + 3 * MiB;
constexpr size_t WS_SA2 = WS_AO + 64 * MiB;
constexpr size_t WS_SWGU = WS_WGU_D + 8 * MiB;
constexpr size_t WS_SA = WS_HN + 64 * MiB;
constexpr int RING_OFF = 0, RING_BYTES = 131072;
constexpr int LDSCTL_OFF = RING_BYTES, MISC_OFF = LDSCTL_OFF + 320;
constexpr int LDS_BYTES = 147456;
#define GAS __attribute__((address_space(1)))
#define LAS __attribute__((address_space(3)))
typedef unsigned short bf16;
typedef unsigned v4u __attribute__((ext_vector_type(4)));
typedef float f32x4 __attribute__((ext_vector_type(4)));
typedef short bf16x8 __attribute__((ext_vector_type(8)));
typedef GAS unsigned gu32;
typedef GAS unsigned long long gu64;
#define RLX_AGENT __ATOMIC_RELAXED, __HIP_MEMORY_SCOPE_AGENT
#define LDS_WAIT() asm volatile("s_waitcnt lgkmcnt(0)" ::: "memory")
#define VM_WAIT() asm volatile("s_waitcnt vmcnt(0)" ::: "memory")
__device__ __forceinline__ unsigned long long rt() { return __builtin_amdgcn_s_memrealtime(); }
__device__ __forceinline__ unsigned f2bf(float f) { unsigned u = __builtin_bit_cast(unsigned, f); return (u + 0x7fffu + ((u >> 16) & 1u)) >> 16; }
__device__ __forceinline__ unsigned pk2(float lo, float hi) { return f2bf(lo) | (f2bf(hi) << 16); }

#define XB_TMO      128
#define XB_XCNT(j)  (256  + 64 * (j))
#define XB_XSUB(j)  (1280 + 64 * (j))
#define XB_XGEN(j)  (2304 + 64 * (j))
#define XB_TOP      3328
#define XB_TOPGEN   3392
#define XCD_BAR_WORDS 3456
#define XB_SPIN_CAP (1u << 18)

__device__ __forceinline__ unsigned xb_ld(unsigned* p)              { return __hip_atomic_load(p, __ATOMIC_RELAXED, __HIP_MEMORY_SCOPE_AGENT); }
__device__ __forceinline__ unsigned xb_add(unsigned* p, unsigned v) { return __hip_atomic_fetch_add(p, v, __ATOMIC_RELAXED, __HIP_MEMORY_SCOPE_AGENT); }
__device__ __forceinline__ unsigned xb_xcc_id() { return (unsigned)__builtin_amdgcn_s_getreg((3 << 11) | 20) & 0xFu; }
#define XB_SPIN(cond, bar) do { unsigned _sp = 0; while (cond) { __builtin_amdgcn_s_sleep(1); \
    if ((++_sp & 255u) == 0u) { if (xb_ld(&(bar)[XB_TMO])) break; if (_sp > XB_SPIN_CAP) { atomicAdd(&(bar)[XB_TMO], 1u); break; } } } } while (0)

struct XcdBarrier {
    unsigned* bar; unsigned x;
    volatile LAS unsigned* st;
};

__device__ __forceinline__ XcdBarrier xcd_barrier_post(unsigned* bar, volatile LAS unsigned* st) {
    XcdBarrier b; b.bar = bar; b.x = xb_xcc_id(); b.st = st;
    if (threadIdx.x == 0) (void)xb_add(&bar[XB_XCNT(b.x)], 1u);
    return b;
}
__device__ __forceinline__ void xcd_barrier_complete(unsigned* bar, unsigned x, unsigned& nloc, unsigned& nx) {
    const unsigned G = gridDim.x * gridDim.y * gridDim.z;
    unsigned sum, cnt, mine, sp = 0u;
    for (;;) {
        sum = 0u; cnt = 0u; mine = 0u;
#pragma unroll
        for (unsigned j = 0; j < 16; ++j) { const unsigned c = xb_ld(&bar[XB_XCNT(j)]); sum += c; cnt += (c > 0u) ? 1u : 0u; mine = (j == x) ? c : mine; }
        if (sum == G) break;
        __builtin_amdgcn_s_sleep(1);
        if ((++sp & 255u) == 0u) { if (xb_ld(&bar[XB_TMO])) break; if (sp > XB_SPIN_CAP) { atomicAdd(&bar[XB_TMO], 1u); break; } }
    }
    nloc = mine > 0u ? mine : 1u; nx = cnt > 0u ? cnt : 1u;
}

__device__ __forceinline__ void xcd_barrier(const XcdBarrier& b) {
    asm volatile("s_waitcnt vmcnt(0)" ::: "memory");
    __syncthreads();
    if (threadIdx.x == 0) {
        unsigned* bar = b.bar;
        __builtin_amdgcn_s_waitcnt(0);
        unsigned nloc = b.st[0], nx = b.st[1];
        if (nloc == 0u) { xcd_barrier_complete(bar, b.x, nloc, nx); b.st[0] = nloc; b.st[1] = nx; }
        const unsigned old = xb_add(&bar[XB_XSUB(b.x)], 1u);
        const unsigned gen = old / nloc;
        if (old + 1u == (gen + 1u) * nloc) {
            __builtin_amdgcn_fence(__ATOMIC_RELEASE, "agent");
            asm volatile("s_waitcnt vmcnt(0)" ::: "memory");
            const unsigned og = xb_add(&bar[XB_TOP], 1u);
            const unsigned tg = og / nx;
            if (og + 1u == (tg + 1u) * nx) xb_add(&bar[XB_TOPGEN], 1u);
            else XB_SPIN(xb_ld(&bar[XB_TOPGEN]) == tg, bar);
            __builtin_amdgcn_fence(__ATOMIC_ACQUIRE, "agent");
            xb_add(&bar[XB_XGEN(b.x)], 1u);
            asm volatile("s_waitcnt vmcnt(0)" ::: "memory");
        } else {
            XB_SPIN(xb_ld(&bar[XB_XGEN(b.x)]) == gen, bar);
            __builtin_amdgcn_fence(__ATOMIC_ACQUIRE, "agent");
            asm volatile("s_waitcnt vmcnt(0)" ::: "memory");
        }
    }
    __syncthreads();
}
typedef unsigned u32x2 __attribute__((ext_vector_type(2)));
__device__ __forceinline__ float wave_sum(float v) {
#pragma unroll
    for (int o = 1; o < 64; o <<= 1) v += __shfl_xor(v, o);
    return v;
}
__device__ __forceinline__ unsigned cvtpk(float lo, float hi) { return pg8::cvt_pk_bf16(lo, hi); }
__device__ __forceinline__ f32x4 unpack4(u32x2 w) { return (f32x4){__uint_as_float(w.x << 16), __uint_as_float(w.x & 0xffff0000u), __uint_as_float(w.y << 16), __uint_as_float(w.y & 0xffff0000u)}; }
__device__ __forceinline__ u32x2 pack4(f32x4 v) { u32x2 r; r.x = cvtpk(v[0], v[1]); r.y = cvtpk(v[2], v[3]); return r; }
__device__ __forceinline__ float sumsq4(f32x4 v) { return (v[0] * v[0] + v[1] * v[1]) + (v[2] * v[2] + v[3] * v[3]); }
__device__ __forceinline__ void ld_row_f32(const float* row, int lane, f32x4 (&v)[4]) {
#pragma unroll
    for (int j = 0; j < 4; ++j) v[j] = *(const GAS f32x4*)(row + 4 * lane + 256 * j);
}
__device__ __forceinline__ void st_row_f32(float* row, int lane, const f32x4 (&v)[4]) {
#pragma unroll
    for (int j = 0; j < 4; ++j) *(GAS f32x4*)(row + 4 * lane + 256 * j) = v[j];
}
__device__ __forceinline__ void ld_row_bf16(const bf16* row, int lane, f32x4 (&v)[4]) {
#pragma unroll
    for (int j = 0; j < 4; ++j) v[j] = unpack4(*(const GAS u32x2*)(row + 4 * lane + 256 * j));
}
__device__ __forceinline__ void st_row_bf16(bf16* row, int lane, const f32x4 (&v)[4]) {
#pragma unroll
    for (int j = 0; j < 4; ++j) *(GAS u32x2*)(row + 4 * lane + 256 * j) = pack4(v[j]);
}
__device__ __forceinline__ float rms_scale(const f32x4 (&v)[4]) {
    const float s = wave_sum((sumsq4(v[0]) + sumsq4(v[1])) + (sumsq4(v[2]) + sumsq4(v[3])));
    return 1.0f / sqrtf(s * (1.0f / DM) + EPS);
}

__device__ __forceinline__ int tau_in(int c) {
    int tile, wc, d, isv;
    if (c < 512) { const int hq = c >> 6; tile = hq >> 2; wc = hq & 3; isv = 0; }
    else if (c < 640) { tile = 2; wc = (c - 512) >> 6; isv = 0; }
    else if (c < 768) { tile = 2; wc = 2 + ((c - 640) >> 6); isv = 1; }
    else if (c < 1280) { const int j = (c - 768) >> 6; tile = 3 + (j >> 2); wc = j & 3; isv = 0; }
    else if (c < 1792) { const int j = (c - 1280) >> 6; tile = 5 + (j >> 2); wc = j & 3; isv = 0; }
    else { const int j = (c - 1792) >> 6; tile = 7 + (j >> 2); wc = j & 3; isv = 1; }
    d = c & 63;
    const int slot = isv ? (128 * ((d >> 3) & 1) + 32 * wc + 16 * ((d >> 2) & 1) + 4 * (d >> 4) + (d & 3)) : (128 * (d >> 5) + 32 * wc + (d & 31));
    return 256 * tile + slot;
}
__device__ __forceinline__ void conv_item(const float* W, int K, int N, bf16* WT, int mode, LAS float* scr, int item, int lane) {
    const int nblk = N / 32, kb = item / nblk, nb = item % nblk, k0 = 64 * kb, n0 = 32 * nb;
#pragma unroll 8
    for (int i = 0; i < 32; ++i) { const int kk = 2 * i + (lane >> 5); scr[kk * 33 + (lane & 31)] = W[(size_t)(k0 + kk) * N + n0 + (lane & 31)]; }
    LDS_WAIT(); asm volatile("" ::: "memory");
    const int c = lane & 7;
#pragma unroll
    for (int j = 0; j < 4; ++j) { const int n = (lane >> 3) + 8 * j; const LAS float* s = scr + (8 * c) * 33 + n; const int sn = n0 + n;
        const int dr = mode == 0 ? sn : mode == 1 ? tau_in(sn) : (256 * (sn >> 7) + (sn & 127) + (mode == 3 ? 128 : 0));
        v4u o; o.x = cvtpk(s[0 * 33], s[1 * 33]); o.y = cvtpk(s[2 * 33], s[3 * 33]); o.z = cvtpk(s[4 * 33], s[5 * 33]); o.w = cvtpk(s[6 * 33], s[7 * 33]);
        *(GAS v4u*)(WT + (size_t)dr * K + k0 + 8 * c) = o; }
    LDS_WAIT(); asm volatile("" ::: "memory");
}
__device__ __forceinline__ void conv_item8(const float* W, int K, int N, unsigned char* WT, int mode, float scale, LAS float* scr, int item, int lane) {
    const int nblk = N / 32, kb = item / nblk, nb = item % nblk, k0 = 64 * kb, n0 = 32 * nb;
#pragma unroll 8
    for (int i = 0; i < 32; ++i) { const int kk = 2 * i + (lane >> 5); scr[kk * 33 + (lane & 31)] = W[(size_t)(k0 + kk) * N + n0 + (lane & 31)]; }
    LDS_WAIT(); asm volatile("" ::: "memory");
    const int c = lane & 7;
#pragma unroll
    for (int j = 0; j < 4; ++j) { const int n = (lane >> 3) + 8 * j; const LAS float* s = scr + (8 * c) * 33 + n; const int sn = n0 + n;
        const int dr = mode == 0 ? sn : (256 * (sn >> 7) + (sn & 127) + (mode == 3 ? 128 : 0));
        u32x2 o; o.x = pg8::cvt4_fp8(s[0 * 33] * scale, s[1 * 33] * scale, s[2 * 33] * scale, s[3 * 33] * scale); o.y = pg8::cvt4_fp8(s[4 * 33] * scale, s[5 * 33] * scale, s[6 * 33] * scale, s[7 * 33] * scale);
        *(GAS u32x2*)(WT + (size_t)dr * K + k0 + 8 * c) = o; }
    LDS_WAIT(); asm volatile("" ::: "memory");
}
struct ConvDesc { const float* W; unsigned char* dst; int K, N, mode, f8; };
__device__ __forceinline__ void conv_load(const ConvDesc& d, int sub, int lane, f32x4 (&v)[8]) {
    const int nblk = d.N / 32, kb = sub / nblk, nb = sub % nblk, k0 = 64 * kb, n0 = 32 * nb;
#pragma unroll
    for (int u = 0; u < 8; ++u) v[u] = *(const GAS f32x4*)(d.W + (size_t)(k0 + 8 * u + (lane >> 3)) * d.N + n0 + 4 * (lane & 7));
}
__device__ __forceinline__ void conv_store(const ConvDesc& d, int sub, int lane, const f32x4 (&v)[8], LAS float* scr) {
    const int nblk = d.N / 32, kb = sub / nblk, nb = sub % nblk, k0 = 64 * kb, n0 = 32 * nb;
#pragma unroll
    for (int u = 0; u < 8; ++u)
#pragma unroll
        for (int e = 0; e < 4; ++e) scr[(8 * u + (lane >> 3)) * 33 + 4 * (lane & 7) + e] = v[u][e];
    LDS_WAIT(); asm volatile("" ::: "memory");
    const int c = lane & 7;
#pragma unroll
    for (int j = 0; j < 4; ++j) { const int n = (lane >> 3) + 8 * j; const LAS float* s = scr + (8 * c) * 33 + n; const int sn = n0 + n;
        const int dr = d.mode == 0 ? sn : d.mode == 1 ? tau_in(sn) : (256 * (sn >> 7) + (sn & 127) + (d.mode == 3 ? 128 : 0));
        if (d.f8) { u32x2 o; o.x = pg8::cvt4_fp8(s[0 * 33] * W8SCALE, s[1 * 33] * W8SCALE, s[2 * 33] * W8SCALE, s[3 * 33] * W8SCALE); o.y = pg8::cvt4_fp8(s[4 * 33] * W8SCALE, s[5 * 33] * W8SCALE, s[6 * 33] * W8SCALE, s[7 * 33] * W8SCALE);
            *(GAS u32x2*)(d.dst + (size_t)dr * d.K + k0 + 8 * c) = o; }
        else { v4u o; o.x = cvtpk(s[0 * 33], s[1 * 33]); o.y = cvtpk(s[2 * 33], s[3 * 33]); o.z = cvtpk(s[4 * 33], s[5 * 33]); o.w = cvtpk(s[6 * 33], s[7 * 33]);
            *(GAS v4u*)((bf16*)d.dst + (size_t)dr * d.K + k0 + 8 * c) = o; } }
    LDS_WAIT(); asm volatile("" ::: "memory");
}
__device__ __forceinline__ void conv_colmax(const ConvDesc& d, int sub, int lane, const f32x4 (&v)[8], gu32* cmax) {
    const int nblk = d.N / 32, nb = sub % nblk, n0 = 32 * nb;
    f32x4 m = (f32x4){0.f, 0.f, 0.f, 0.f};
#pragma unroll
    for (int u = 0; u < 8; ++u)
#pragma unroll
        for (int e = 0; e < 4; ++e) m[e] = fmaxf(m[e], fabsf(v[u][e]));
#pragma unroll
    for (int e = 0; e < 4; ++e) { m[e] = fmaxf(m[e], __shfl_xor(m[e], 8)); m[e] = fmaxf(m[e], __shfl_xor(m[e], 16)); m[e] = fmaxf(m[e], __shfl_xor(m[e], 32)); }
    if (lane < 8) {
#pragma unroll
        for (int e = 0; e < 4; ++e) __hip_atomic_fetch_max(cmax + n0 + 4 * lane + e, __float_as_uint(m[e]), __ATOMIC_RELAXED, __HIP_MEMORY_SCOPE_AGENT); }
}
__device__ __forceinline__ unsigned pack4_i8(float a, float b, float c, float d) {
    const int ia = (int)__builtin_amdgcn_fmed3f(__builtin_rintf(a), -127.f, 127.f), ib = (int)__builtin_amdgcn_fmed3f(__builtin_rintf(b), -127.f, 127.f), ic = (int)__builtin_amdgcn_fmed3f(__builtin_rintf(c), -127.f, 127.f), id = (int)__builtin_amdgcn_fmed3f(__builtin_rintf(d), -127.f, 127.f);
    return (unsigned)(ia & 255) | ((unsigned)(ib & 255) << 8) | ((unsigned)(ic & 255) << 16) | ((unsigned)id << 24);
}
__device__ __forceinline__ void conv_store_i8(const ConvDesc& d, int sub, int lane, const f32x4 (&v)[8], LAS float* scr, gu32* cmax, float* swout) {
    const int nblk = d.N / 32, kb = sub / nblk, nb = sub % nblk, k0 = 64 * kb, n0 = 32 * nb;
#pragma unroll
    for (int u = 0; u < 8; ++u)
#pragma unroll
        for (int e = 0; e < 4; ++e) scr[(8 * u + (lane >> 3)) * 33 + 4 * (lane & 7) + e] = v[u][e];
    LDS_WAIT(); asm volatile("" ::: "memory");
    const int c = lane & 7;
#pragma unroll
    for (int j = 0; j < 4; ++j) { const int n = (lane >> 3) + 8 * j; const LAS float* s = scr + (8 * c) * 33 + n; const int sn = n0 + n;
        const int dr = d.mode == 0 ? sn : d.mode == 1 ? tau_in(sn) : (256 * (sn >> 7) + (sn & 127) + (d.mode == 3 ? 128 : 0));
        const float cm = __uint_as_float(__hip_atomic_load(cmax + sn, RLX_AGENT)); const float q = cm > 0.f ? 127.0f / cm : 0.f;
        u32x2 o; o.x = pack4_i8(s[0 * 33] * q, s[1 * 33] * q, s[2 * 33] * q, s[3 * 33] * q); o.y = pack4_i8(s[4 * 33] * q, s[5 * 33] * q, s[6 * 33] * q, s[7 * 33] * q);
        *(GAS u32x2*)(d.dst + (size_t)dr * d.K + k0 + 8 * c) = o;
        if (k0 == 0 && c == 0) swout[dr] = cm * (1.0f / 127.0f); }
    LDS_WAIT(); asm volatile("" ::: "memory");
}
__device__ __forceinline__ void st_row_i8(unsigned char* rowp, float* sap, int lane, const f32x4 (&v)[4]) {
    float am = 0.f;
#pragma unroll
    for (int j = 0; j < 4; ++j) am = fmaxf(fmaxf(fmaxf(am, fabsf(v[j][0])), fmaxf(fabsf(v[j][1]), fabsf(v[j][2]))), fabsf(v[j][3]));
#pragma unroll
    for (int o = 1; o < 64; o <<= 1) am = fmaxf(am, __shfl_xor(am, o));
    const float q = am > 0.f ? 127.0f / am : 0.f;
#pragma unroll
    for (int j = 0; j < 4; ++j) *(GAS unsigned*)(rowp + 4 * lane + 256 * j) = pack4_i8(v[j][0] * q, v[j][1] * q, v[j][2] * q, v[j][3] * q);
    if (lane == 0) *sap = am * (1.0f / 127.0f);
}
struct Args { const float* in[19]; float* out; unsigned char* ws; int ph_lo, ph_hi; };
typedef const __attribute__((address_space(4))) Args* KArgs;
__device__ __forceinline__ KArgs kargs() { KArgs p = (KArgs)__builtin_amdgcn_kernarg_segment_ptr(); asm volatile("" : "+s"(p)); return p; }
__device__ __forceinline__ void phase_prologue(KArgs A, LAS unsigned char* L, int gw, int NGW, int wave, int lane) {
    unsigned char* ws = A->ws;
    LAS float* scr = (LAS float*)(L + RING_OFF + wave * 16384);
    constexpr int I_IN = (DM / 64) * (INW / 32), I_OUT = (DM / 64) * (DM / 32), I_FF = (DM / 64) * (DFF / 32);
    static_assert((DFF / 64) * (DM / 32) == I_FF, "item counts");
    constexpr int NITEMS = 2 * I_IN + 2 * I_OUT + 27 * I_FF;
    auto desc = [&](int it, ConvDesc& d, int& sub) {
        int r = it;
        if (r < 2 * I_IN) { const int l = r / I_IN; d = ConvDesc{A->in[1] + (size_t)l * DM * INW, ws + WS_WIN + (size_t)l * INW * DM * 2, DM, INW, 1, PROJ_I8_IN ? 3 : 0}; sub = r % I_IN; return; } r -= 2 * I_IN;
        if (r < 2 * I_OUT) { const int l = r / I_OUT; d = ConvDesc{A->in[2] + (size_t)l * DM * DM, ws + WS_WOUT + (size_t)l * DM * DM * 2, DM, DM, 0, PROJ_I8_OUT ? 3 : 0}; sub = r % I_OUT; return; } r -= 2 * I_OUT;
        const int mtx = r / I_FF; sub = r % I_FF;
        if (mtx == 0) d = ConvDesc{A->in[12], ws + WS_WGU_D, DM, DFF, 2, DENSE_I8 ? 3 : DENSE_F8};
        else if (mtx == 1) d = ConvDesc{A->in[13], ws + WS_WGU_D, DM, DFF, 3, DENSE_I8 ? 3 : DENSE_F8};
        else if (mtx == 2) d = ConvDesc{A->in[14], ws + WS_WDN_D, DFF, DM, 0, DENSE_F8};
        else if (mtx < 11) { const int e = mtx - 3; d = ConvDesc{A->in[16] + (size_t)e * DM * DFF, ws + WS_WGU_M + (size_t)e * 2 * DFF * DM, DM, DFF, 2, 1}; }
        else if (mtx < 19) { const int e = mtx - 11; d = ConvDesc{A->in[17] + (size_t)e * DM * DFF, ws + WS_WGU_M + (size_t)e * 2 * DFF * DM, DM, DFF, 3, 1}; }
        else { const int e = mtx - 19; d = ConvDesc{A->in[18] + (size_t)e * DFF * DM, ws + WS_WDN_M + (size_t)e * DM * DFF, DFF, DM, 0, 1}; }
    };
    {
        ConvDesc dA{}, dB{}; int sA = 0, sB = 0; f32x4 vA[8], vB[8];
        int it = gw;
        if (it < NITEMS) { desc(it, dA, sA); if (dA.f8 != 3) conv_load(dA, sA, lane, vA); }
        for (; it < NITEMS; it += 2 * NGW) {
            const bool hasB = it + NGW < NITEMS;
            if (hasB) { desc(it + NGW, dB, sB); if (dB.f8 != 3) conv_load(dB, sB, lane, vB); }
            if (dA.f8 != 3) conv_store(dA, sA, lane, vA, scr);
            if (it + 2 * NGW < NITEMS) { desc(it + 2 * NGW, dA, sA); if (dA.f8 != 3) conv_load(dA, sA, lane, vA); }
            if (hasB && dB.f8 != 3) conv_store(dB, sB, lane, vB, scr);
        }
    }
    if (PROJ_I8) {
        for (int it = gw; it < 2 * I_IN + 2 * I_OUT; it += NGW) { f32x4 v[8];
            if (it < 2 * I_IN) { if (!PROJ_I8_IN) continue; const int l = it / I_IN, sub = it % I_IN; ConvDesc d{A->in[1] + (size_t)l * DM * INW, nullptr, DM, INW, 1, 0}; conv_load(d, sub, lane, v); conv_colmax(d, sub, lane, v, (gu32*)(ws + WS_CTL) + CW_CMAX_IN + l * INW); }
            else { if (!PROJ_I8_OUT) continue; const int r = it - 2 * I_IN, l = r / I_OUT, sub = r % I_OUT; ConvDesc d{A->in[2] + (size_t)l * DM * DM, nullptr, DM, DM, 0, 0}; conv_load(d, sub, lane, v); conv_colmax(d, sub, lane, v, (gu32*)(ws + WS_CTL) + CW_CMAX_OUT + l * DM); } }
    }
    if (DENSE_I8) {
        for (int it = gw; it < 2 * I_FF; it += NGW) { const int mtx = it / I_FF, sub = it % I_FF; ConvDesc d{A->in[12 + mtx], nullptr, DM, DFF, 2 + mtx, 0}; f32x4 v[8];
            conv_load(d, sub, lane, v); conv_colmax(d, sub, lane, v, (gu32*)(ws + WS_CTL) + CW_CMAX + mtx * DFF); }
    }
    const float* x = A->in[0]; const float* g = A->in[3]; bf16* HN = (bf16*)(ws + WS_HN);
    f32x4 gv[4];
#pragma unroll
    for (int j = 0; j < 4; ++j) gv[j] = *(const GAS f32x4*)(g + 4 * lane + 256 * j);
#define P0_ROW(V, m_) do { const float r_ = rms_scale(V); _Pragma("unroll") for (int j = 0; j < 4; ++j) V[j] = V[j] * r_ * gv[j]; \
        if (PROJ_I8_IN) st_row_i8((unsigned char*)HN + (size_t)(m_) * DM, (float*)(ws + WS_SA) + (m_), lane, V); else st_row_bf16(HN + (size_t)(m_) * DM, lane, V); } while (0)
    { f32x4 vA[4], vB[4]; int m = gw;
      if (m < NTOK) ld_row_f32(x + (size_t)m * DM, lane, vA);
      for (; m < NTOK; m += 2 * NGW) { const bool hasB = m + NGW < NTOK;
          if (hasB) ld_row_f32(x + (size_t)(m + NGW) * DM, lane, vB);
          P0_ROW(vA, m);
          if (m + 2 * NGW < NTOK) ld_row_f32(x + (size_t)(m + 2 * NGW) * DM, lane, vA);
          if (hasB) P0_ROW(vB, m + NGW); } }
#undef P0_ROW
}
__device__ __forceinline__ void unpack8(v4u w, float (&f)[8]) {
    f[0] = __uint_as_float(w.x << 16); f[1] = __uint_as_float(w.x & 0xffff0000u); f[2] = __uint_as_float(w.y << 16); f[3] = __uint_as_float(w.y & 0xffff0000u);
    f[4] = __uint_as_float(w.z << 16); f[5] = __uint_as_float(w.z & 0xffff0000u); f[6] = __uint_as_float(w.w << 16); f[7] = __uint_as_float(w.w & 0xffff0000u);
}
__device__ __forceinline__ v4u pack8(const float (&f)[8]) { v4u w; w.x = cvtpk(f[0], f[1]); w.y = cvtpk(f[2], f[3]); w.z = cvtpk(f[4], f[5]); w.w = cvtpk(f[6], f[7]); return w; }
__device__ __forceinline__ void phase_t2(const bf16* OA, const bf16* OB, bf16* AO, const float* g_out_a, const float* g_subln, const float* lp, float lam_init, int gw, int NGW, int lane) {
    const float sa = wave_sum(lp[lane] * lp[64 + lane]), sb = wave_sum(lp[128 + lane] * lp[192 + lane]);
    const float lam = expf(sa) - expf(sb) + lam_init;
    float ga[8], gb[8];
#pragma unroll
    for (int i = 0; i < 8; ++i) { ga[i] = g_out_a[8 * lane + i]; gb[i] = g_subln[(8 * lane + i) & 127] * (1.0f - lam_init); }
    for (int row = gw; row < NTOK; row += NGW) {
        const v4u wa = *(const GAS v4u*)(OA + (size_t)row * 512 + 8 * lane), w0 = *(const GAS v4u*)(OB + (size_t)row * 1024 + 8 * lane), w1 = *(const GAS v4u*)(OB + (size_t)row * 1024 + 512 + 8 * lane);
        float a[8], b0[8], b1[8]; unpack8(wa, a); unpack8(w0, b0); unpack8(w1, b1);
        float ssa = 0.f, ssb = 0.f;
#pragma unroll
        for (int i = 0; i < 8; ++i) { ssa += a[i] * a[i]; b0[i] = b0[i] - lam * b1[i]; ssb += b0[i] * b0[i]; }
        ssa = wave_sum(ssa);
        ssb += __shfl_xor(ssb, 1); ssb += __shfl_xor(ssb, 2); ssb += __shfl_xor(ssb, 4); ssb += __shfl_xor(ssb, 8);
        const float ra = 1.0f / sqrtf(ssa * (1.0f / 512.0f) + EPS), rb = 1.0f / sqrtf(ssb * (1.0f / 128.0f) + EPS);
#pragma unroll
        for (int i = 0; i < 8; ++i) { a[i] = a[i] * ra * ga[i]; b0[i] = b0[i] * rb * gb[i]; }
        if (PROJ_I8_OUT) { float am = 0.f;
#pragma unroll
            for (int i = 0; i < 8; ++i) am = fmaxf(am, fmaxf(fabsf(a[i]), fabsf(b0[i])));
#pragma unroll
            for (int o = 1; o < 64; o <<= 1) am = fmaxf(am, __shfl_xor(am, o));
            const float q = am > 0.f ? 127.0f / am : 0.f; unsigned char* rp = (unsigned char*)AO + (size_t)row * 1024;
            u32x2 wa_, wb_; wa_.x = pack4_i8(a[0] * q, a[1] * q, a[2] * q, a[3] * q); wa_.y = pack4_i8(a[4] * q, a[5] * q, a[6] * q, a[7] * q); wb_.x = pack4_i8(b0[0] * q, b0[1] * q, b0[2] * q, b0[3] * q); wb_.y = pack4_i8(b0[4] * q, b0[5] * q, b0[6] * q, b0[7] * q);
            *(GAS u32x2*)(rp + 8 * lane) = wa_; *(GAS u32x2*)(rp + 512 + 8 * lane) = wb_;
            if (lane == 0) ((float*)((unsigned char*)AO + (WS_SA2 - WS_AO)))[row] = am * (1.0f / 127.0f);
        } else { *(GAS v4u*)(AO + (size_t)row * 1024 + 8 * lane) = pack8(a); *(GAS v4u*)(AO + (size_t)row * 1024 + 512 + 8 * lane) = pack8(b0); }
    }
}
template <bool ROUTE, bool F8OUT = ROUTE, bool I8OUT = false>
__device__ __forceinline__ void phase_t3(const float* hsrc, float* hdst, const bf16* MIX, bf16* HN, const float* gpost, const float* gpre, const float* wrt, v4u* TOK, unsigned* WGB, gu32* cnt,
                                         LAS unsigned* lcnt, LAS f32x4* wrl, int vcu, int G, int wave, int lane, int tid) {
    f32x4 gp[4], gf[4];
#pragma unroll
    for (int j = 0; j < 4; ++j) { gp[j] = *(const GAS f32x4*)(gpost + 4 * lane + 256 * j); gf[j] = *(const GAS f32x4*)(gpre + 4 * lane + 256 * j); }
    if (ROUTE) { for (int i = tid; i < 2048; i += NWAVES * 64) { const int row = i >> 1, hf = i & 1; wrl[(((row >> 8) * 4 + (row & 3)) * 2 + hf) * 64 + ((row & 255) >> 2)] = *(const GAS f32x4*)(wrt + 4 * i); } __syncthreads(); }
#define T3_LOAD(HV, MV, r) do { ld_row_f32(hsrc + (size_t)(r) * DM, lane, HV); ld_row_bf16(MIX + (size_t)(r) * DM, lane, MV); } while (0)
#define T3_ROW(HV, MV, row) do { \
        const float r_ = rms_scale(MV); \
        _Pragma("unroll") for (int j = 0; j < 4; ++j) HV[j] = HV[j] + MV[j] * r_ * gp[j]; \
        st_row_f32(hdst + (size_t)(row) * DM, lane, HV); \
        const float r2_ = rms_scale(HV); \
        _Pragma("unroll") for (int j = 0; j < 4; ++j) MV[j] = HV[j] * r2_ * gf[j]; \
        if (F8OUT) { \
            _Pragma("unroll") for (int j = 0; j < 4; ++j) *(GAS unsigned*)((unsigned char*)HN + (size_t)(row) * DM + 4 * lane + 256 * j) = pg8::cvt4_fp8(MV[j][0] * A8SCALE, MV[j][1] * A8SCALE, MV[j][2] * A8SCALE, MV[j][3] * A8SCALE); \
        } else if (I8OUT) {                                    \
            float am_ = 0.f; \
            _Pragma("unroll") for (int j = 0; j < 4; ++j) am_ = fmaxf(fmaxf(fmaxf(am_, fabsf(MV[j][0])), fmaxf(fabsf(MV[j][1]), fabsf(MV[j][2]))), fabsf(MV[j][3])); \
            _Pragma("unroll") for (int o_ = 1; o_ < 64; o_ <<= 1) am_ = fmaxf(am_, __shfl_xor(am_, o_)); \
            const float q_ = am_ > 0.f ? 127.0f / am_ : 0.f; \
            _Pragma("unroll") for (int j = 0; j < 4; ++j) *(GAS unsigned*)((unsigned char*)HN + (size_t)(row) * DM + 4 * lane + 256 * j) = pack4_i8(MV[j][0] * q_, MV[j][1] * q_, MV[j][2] * q_, MV[j][3] * q_); \
            if (lane == 0) ((float*)((unsigned char*)HN + (WS_SA - WS_HN)))[row] = am_ * (1.0f / 127.0f); \
        } else st_row_bf16(HN + (size_t)(row) * DM, lane, MV); \
        if (ROUTE) { \
            float lg[8]; \
            _Pragma("unroll") for (int e = 0; e < 8; ++e) lg[e] = 0.f; \
            _Pragma("unroll") for (int j = 0; j < 4; ++j) \
            _Pragma("unroll") for (int k = 0; k < 4; ++k) { const float xv = MV[j][k]; const f32x4 w0_ = wrl[((j * 4 + k) * 2) * 64 + lane], w1_ = wrl[((j * 4 + k) * 2 + 1) * 64 + lane]; \
                _Pragma("unroll") for (int e = 0; e < 4; ++e) { lg[e] += xv * w0_[e]; lg[4 + e] += xv * w1_[e]; } } \
            _Pragma("unroll") for (int e = 0; e < 8; ++e) lg[e] = wave_sum(lg[e]); \
            int e0 = 0; float l0 = lg[0]; \
            _Pragma("unroll") for (int e = 1; e < 8; ++e) if (lg[e] > l0) { l0 = lg[e]; e0 = e; } \
            int e1 = -1; float l1 = -INFINITY; \
            _Pragma("unroll") for (int e = 0; e < 8; ++e) if (e != e0 && lg[e] > l1) { l1 = lg[e]; e1 = e; } \
            if (e1 < 0) e1 = (e0 + 1) & 7; \
            const float w0 = 1.0f / (1.0f + expf(l1 - l0)); \
            if (lane == 0) { const unsigned r0 = __hip_atomic_fetch_add(lcnt + e0, 1u, __ATOMIC_RELAXED, __HIP_MEMORY_SCOPE_WORKGROUP), r1 = __hip_atomic_fetch_add(lcnt + e1, 1u, __ATOMIC_RELAXED, __HIP_MEMORY_SCOPE_WORKGROUP); \
                v4u tk; tk.x = (unsigned)e0 | ((unsigned)e1 << 8); tk.y = r0; tk.z = r1; tk.w = __float_as_uint(w0); *(GAS v4u*)(TOK + (row)) = tk; } \
        } \
    } while (0)
    for (int blk = vcu; blk < NTOK / 256; blk += G) {
        if (ROUTE) { if (tid < 8) lcnt[tid] = 0u; __syncthreads(); }
        const int rowb = blk * 256 + wave;
        f32x4 hA[4], mA[4], hB[4], mB[4];
        T3_LOAD(hA, mA, rowb);
        for (int i = 0; i < 32; i += 2) {
            T3_LOAD(hB, mB, rowb + 8 * (i + 1));
            T3_ROW(hA, mA, rowb + 8 * i);
            if (i + 2 < 32) T3_LOAD(hA, mA, rowb + 8 * (i + 2));
            T3_ROW(hB, mB, rowb + 8 * (i + 1));
        }
        if (ROUTE) { __syncthreads(); if (tid < 8) { const unsigned c = lcnt[tid]; const unsigned base = __hip_atomic_fetch_add(cnt + tid, c, __ATOMIC_RELAXED, __HIP_MEMORY_SCOPE_AGENT); WGB[blk * 8 + tid] = base; } __syncthreads(); }
    }
#undef T3_LOAD
#undef T3_ROW
}
__device__ __forceinline__ void load_layout(gu32* cnt, int (&cn)[8], int (&ps)[8], int (&pe)[8]) {
    int acc = 0;
#pragma unroll
    for (int e = 0; e < 8; ++e) { const int c = __builtin_amdgcn_readfirstlane((int)__hip_atomic_load(cnt + e, RLX_AGENT)); cn[e] = c; ps[e] = acc; acc += (c + 511) & ~511; pe[e] = acc; }
}
__device__ __forceinline__ void phase_gather(const unsigned char* HN, unsigned char* XS, const v4u* TOK, const unsigned* WGB, gu32* cnt, LAS int* psl, int gw, int NGW, int lane, int tid) {
    int cn[8], ps[8], pe[8]; load_layout(cnt, cn, ps, pe);
    if (tid == 0) {
#pragma unroll
        for (int e = 0; e < 8; ++e) psl[e] = ps[e]; }
    __syncthreads();
    for (int row0 = gw; row0 < NTOK; row0 += 4 * NGW) {
        v4u tk[4], v0[4]; size_t d0[4], d1[4];
#pragma unroll
        for (int u = 0; u < 4; ++u) { const int row = row0 + u * NGW; tk[u] = *(const GAS v4u*)(TOK + row); v0[u] = *(const GAS v4u*)(HN + (size_t)row * DM + 16 * lane); }
#pragma unroll
        for (int u = 0; u < 4; ++u) { const int row = row0 + u * NGW; const int e0 = tk[u].x & 255, e1 = (tk[u].x >> 8) & 255;
            d0[u] = (size_t)(psl[e0] + (int)WGB[(row >> 8) * 8 + e0] + (int)tk[u].y); d1[u] = (size_t)(psl[e1] + (int)WGB[(row >> 8) * 8 + e1] + (int)tk[u].z); }
#pragma unroll
        for (int u = 0; u < 4; ++u) { *(GAS v4u*)(XS + d0[u] * DM + 16 * lane) = v0[u]; *(GAS v4u*)(XS + d1[u] * DM + 16 * lane) = v0[u]; }
    }
    const v4u z = (v4u){0u, 0u, 0u, 0u};
#pragma unroll
    for (int e = 0; e < 8; ++e)
        for (int r = ps[e] + cn[e] + gw; r < pe[e]; r += NGW) *(GAS v4u*)(XS + (size_t)r * DM + 16 * lane) = z;
}
template <bool MOE, bool NEXT>
__device__ __forceinline__ void phase_t4(float* h, const bf16* F, const v4u* TOK, const unsigned* WGB, gu32* cnt, LAS int* psl, const float* gpost, const float* gnext, bf16* HN, int gw, int NGW, int lane, int tid) {
    if (MOE) { int cn[8], ps[8], pe[8]; load_layout(cnt, cn, ps, pe);
        if (tid == 0) {
#pragma unroll
            for (int e = 0; e < 8; ++e) psl[e] = ps[e]; }
        __syncthreads(); }
    f32x4 gp[4], gn[4];
#pragma unroll
    for (int j = 0; j < 4; ++j) { gp[j] = *(const GAS f32x4*)(gpost + 4 * lane + 256 * j); gn[j] = NEXT ? *(const GAS f32x4*)(gnext + 4 * lane + 256 * j) : (f32x4){0.f, 0.f, 0.f, 0.f}; }
#define T4_META(TK, r) do { if (MOE) TK = *(const GAS v4u*)(TOK + (r)); } while (0)
#define T4_LOAD(FV, F1, HV, TK, r) do { \
        if (MOE) { const int e0_ = TK.x & 255, e1_ = (TK.x >> 8) & 255; \
            const size_t d0_ = (size_t)(psl[e0_] + (int)WGB[((r) >> 8) * 8 + e0_] + (int)TK.y), d1_ = (size_t)(psl[e1_] + (int)WGB[((r) >> 8) * 8 + e1_] + (int)TK.z); \
            ld_row_bf16(F + d0_ * DM, lane, FV); ld_row_bf16(F + d1_ * DM, lane, F1); } \
        else ld_row_bf16(F + (size_t)(r) * DM, lane, FV); \
        ld_row_f32(h + (size_t)(r) * DM, lane, HV); } while (0)
#define T4_ROW(FV, F1, HV, W0, row) do { \
        if (MOE) { const float w0_ = W0, w1_ = 1.0f - w0_; _Pragma("unroll") for (int j = 0; j < 4; ++j) FV[j] = FV[j] * w0_ + F1[j] * w1_; } \
        const float r_ = rms_scale(FV); \
        _Pragma("unroll") for (int j = 0; j < 4; ++j) HV[j] = HV[j] + FV[j] * r_ * gp[j]; \
        st_row_f32(h + (size_t)(row) * DM, lane, HV); \
        if (NEXT) { const float r2_ = rms_scale(HV); \
            _Pragma("unroll") for (int j = 0; j < 4; ++j) FV[j] = HV[j] * r2_ * gn[j]; \
            if (PROJ_I8_IN) st_row_i8((unsigned char*)HN + (size_t)(row) * DM, (float*)((unsigned char*)HN + (WS_SA - WS_HN)) + (row), lane, FV); else st_row_bf16(HN + (size_t)(row) * DM, lane, FV); } \
    } while (0)
    const int nrow = (NTOK - gw + NGW - 1) / NGW;
    f32x4 fA[4], gA[4], hA[4], fB[4], gB[4], hB[4]; v4u tA = (v4u){0u, 0u, 0u, 0u}, tB = tA, tN = tA; float wA = 0.f, wB = 0.f;
    if (nrow > 0) { T4_META(tA, gw); T4_LOAD(fA, gA, hA, tA, gw); wA = __uint_as_float(tA.w); if (nrow > 1) T4_META(tN, gw + NGW); }
    for (int i = 0; i < nrow; i += 2) {
        if (i + 1 < nrow) { tB = tN; T4_LOAD(fB, gB, hB, tB, gw + (i + 1) * NGW); wB = __uint_as_float(tB.w); if (i + 2 < nrow) T4_META(tN, gw + (i + 2) * NGW); }
        T4_ROW(fA, gA, hA, wA, gw + i * NGW);
        if (i + 1 < nrow) {
            if (i + 2 < nrow) { tA = tN; T4_LOAD(fA, gA, hA, tA, gw + (i + 2) * NGW); wA = __uint_as_float(tA.w); if (i + 3 < nrow) T4_META(tN, gw + (i + 3) * NGW); }
            T4_ROW(fB, gB, hB, wB, gw + (i + 1) * NGW);
        }
    }
#undef T4_META
#undef T4_LOAD
#undef T4_ROW
}
__device__ __forceinline__ void phase_vt(const bf16* VA, const bf16* VB, unsigned char* VT, LAS unsigned char* scr, int gw, int NGW, int lane) {
    const int k5 = lane & 31; const int slot = 32 * ((k5 >> 2) & 1) + (k5 & 3) + 4 * (k5 >> 3) + 16 * (lane >> 5);
    for (int tl = gw; tl < 6144; tl += NGW) {
        const bool isB = tl >= 2048; const int ti = isB ? tl - 2048 : tl, t = ti & 127, bh = ti >> 7, DVt = isB ? 128 : 64;
        const bf16* src = isB ? VB + ((size_t)(bh >> 2) * SEQL + 64 * t + lane) * 512 + 128 * (bh & 3) : VA + ((size_t)(bh >> 1) * SEQL + 64 * t + lane) * 128 + 64 * (bh & 1);
        unsigned char* dst = VT + (isB ? ((size_t)8 * MiB + (size_t)ti * 8192) : (size_t)ti * 4096);
        for (int c = 0; c < DVt / 8; ++c) { const v4u w = *(const GAS v4u*)(src + 8 * c); float f[8]; unpack8(w, f);
            const unsigned lo = pg8::cvt4_fp8(f[0] * attn_body::V8SCALE, f[1] * attn_body::V8SCALE, f[2] * attn_body::V8SCALE, f[3] * attn_body::V8SCALE), hi = pg8::cvt4_fp8(f[4] * attn_body::V8SCALE, f[5] * attn_body::V8SCALE, f[6] * attn_body::V8SCALE, f[7] * attn_body::V8SCALE);
#pragma unroll
            for (int i = 0; i < 4; ++i) { scr[(8 * c + i) * 64 + slot] = (unsigned char)(lo >> (8 * i)); scr[(8 * c + 4 + i) * 64 + slot] = (unsigned char)(hi >> (8 * i)); } }
        LDS_WAIT(); asm volatile("" ::: "memory");
        for (int it = 0; it < DVt / 16; ++it) { const int q = it * 64 + lane; *(GAS v4u*)(dst + 16 * q) = *(const LAS v4u*)(scr + 16 * q); }
        LDS_WAIT(); asm volatile("" ::: "memory");
    }
}
__device__ __forceinline__ void phase_quant_gu(KArgs A, LAS unsigned char* L, int gw, int NGW, int wave, int lane) {
    unsigned char* ws = A->ws; LAS float* scr = (LAS float*)(L + RING_OFF + wave * 16384);
    constexpr int I_FF = (DM / 64) * (DFF / 32);
    if (DENSE_I8) for (int it = gw; it < 2 * I_FF; it += NGW) { const int mtx = it / I_FF, sub = it % I_FF; ConvDesc d{A->in[12 + mtx], ws + WS_WGU_D, DM, DFF, 2 + mtx, 0}; f32x4 v[8];
        conv_load(d, sub, lane, v); conv_store_i8(d, sub, lane, v, scr, (gu32*)(ws + WS_CTL) + CW_CMAX + mtx * DFF, (float*)(ws + WS_SWGU)); }
    if (PROJ_I8) { constexpr int I_IN = (DM / 64) * (INW / 32), I_OUT = (DM / 64) * (DM / 32);
        for (int it = gw; it < 2 * I_IN + 2 * I_OUT; it += NGW) { f32x4 v[8];
            if (it < 2 * I_IN) { if (!PROJ_I8_IN) continue; const int l = it / I_IN, sub = it % I_IN; ConvDesc d{A->in[1] + (size_t)l * DM * INW, ws + WS_WIN + (size_t)l * INW * DM, DM, INW, 1, 0};
                conv_load(d, sub, lane, v); conv_store_i8(d, sub, lane, v, scr, (gu32*)(ws + WS_CTL) + CW_CMAX_IN + l * INW, (float*)(ws + WS_SWIN) + l * INW); }
            else { if (!PROJ_I8_OUT) continue; const int r = it - 2 * I_IN, l = r / I_OUT, sub = r % I_OUT; ConvDesc d{A->in[2] + (size_t)l * DM * DM, ws + WS_WOUT + (size_t)l * DM * DM, DM, DM, 0, 0};
                conv_load(d, sub, lane, v); conv_store_i8(d, sub, lane, v, scr, (gu32*)(ws + WS_CTL) + CW_CMAX_OUT + l * DM, (float*)(ws + WS_SWOUT) + l * DM); } } }
}
#ifndef MK_PER_PHASE
#define MK_PER_PHASE 0
#endif
#ifndef PROBE_BREP
#define PROBE_BREP 1
#endif
#ifndef PROBE_P0
#define PROBE_P0 1
#endif
#ifndef PROBE_G1
#define PROBE_G1 1
#endif
#ifndef PROBE_G2
#define PROBE_G2 1
#endif
#ifndef PROBE_G3
#define PROBE_G3 1
#endif
#ifndef PROBE_G4
#define PROBE_G4 1
#endif
#ifndef PROBE_T2
#define PROBE_T2 1
#endif
#ifndef MK_PH_HI
#define MK_PH_HI 1000
#endif
constexpr int N_PHASES = 31;
constexpr int TE_OFF = LDSCTL_OFF + 1024;
__device__ __forceinline__ int fill_tile_experts(gu32* cnt, LAS int* te, int tid) {
    int cn[8], ps[8], pe[8]; load_layout(cnt, cn, ps, pe);
    for (int i = tid; i < 528; i += NWAVES * 64) { const int row = i * 256; int e = 0;
#pragma unroll
        for (int j = 0; j < 7; ++j) e += (row >= pe[j]) ? 1 : 0;
        te[i] = e; }
    __syncthreads();
    return pe[7] / 256;
}
#define IN() (lo <= ph && ph < hi)
#define SEAM() do { if (lo <= ph && ph + 1 < hi) xcd_barrier(bar); ++ph; } while (0)
#define TIDO() int tid; asm volatile("v_mbcnt_lo_u32_b32 %0, -1, 0\n\tv_mbcnt_hi_u32_b32 %0, -1, %0" : "=v"(tid)); tid += wave_s * 64
#define LANE (tid & 63)
#define WAVE (__builtin_amdgcn_readfirstlane(tid >> 6))
#define GW (vcu * NWAVES + WAVE)
#define NGW (G * NWAVES)
#define LCNT ((LAS unsigned*)(L + LDSCTL_OFF))
#define PSL ((LAS int*)(L + LDSCTL_OFF + 64))
#define TE ((LAS int*)(L + TE_OFF))
template <int LAYER>
__device__ __forceinline__ void layer_body(LAS unsigned char* L, unsigned char* lds, const XcdBarrier& bar, int lo, int hi, int& ph, int G, int bx, int vcu, int wave_s) {
    constexpr int layer = LAYER;
    constexpr bool moe = (LAYER & 1) != 0;
    if (IN()) {
        KArgs A = kargs(); unsigned char* ws = A->ws;
        pg8::StaticOrder S; S.init(NTOK / 256, INW / 256, G, bx, 0);
        if constexpr (PROJ_I8_IN) {
            pg8::Gemm g{(const bf16*)(ws + WS_HN), (const bf16*)(ws + WS_WIN + (size_t)layer * INW * DM), NTOK, INW, DM / 2};
            pg8::EpiInProjI8 E{ws, WS_QA, WS_KA, WS_VA, WS_QB, WS_KB, WS_VB, A->in[7] + 64 * layer, A->in[8] + 64 * layer, attn_body::C2, (const float*)(ws + WS_SA), (const float*)(ws + WS_SWIN) + layer * INW};
            pg8::gemm_phase<pg8::EpiInProjI8, pg8::StaticOrder, true, true, false, true>(L + RING_OFF, g, S, E, wave_s);
        } else {
        pg8::Gemm g{(const bf16*)(ws + WS_HN), (const bf16*)(ws + WS_WIN) + (size_t)layer * INW * DM, NTOK, INW, DM};
        pg8::EpiInProj E{ws, WS_QA, WS_KA, WS_VA, WS_QB, WS_KB, WS_VB, A->in[7] + 64 * layer, A->in[8] + 64 * layer, attn_body::C2};
        for (int rep_ = 0; rep_ < PROBE_G1; ++rep_) pg8::gemm_phase<pg8::EpiInProj, pg8::StaticOrder, true, true>(L + RING_OFF, g, S, E, wave_s);
        }
    }
    SEAM();
    if (IN()) { TIDO(); unsigned char* ws = kargs()->ws; phase_vt((const bf16*)(ws + WS_VA), (const bf16*)(ws + WS_VB), ws + WS_VT8, L + RING_OFF + WAVE * 16384, GW, NGW, LANE); }
    SEAM();
    if (IN()) {
        for (int i = 0;; ++i) {
            int b, st, qb; bool grpB;
            if (G == 256) { if (i >= 16) break; const int grp = vcu >> 3, s = i >> 2; b = grp >> 2; grpB = s >= 2; st = 4 * (s & 1) + (grp & 3); qb = (vcu & 7) + 8 * (i & 3); }
            else { const int Lu = i * G + vcu; if (Lu >= 4096) break; grpB = Lu >= 2048; qb = Lu & 31; const int sm = (Lu & 2047) >> 5; b = sm >> 3; st = sm & 7; }
            unsigned char* ws = kargs()->ws;
            typedef attn_body::bf16 abf;
            const long rb = (long)b * SEQL, qrow = rb + 256 * qb;
            if (!grpB) { const int hq = st, kh = hq >> 2;
                attn_body::attn_unit8<64>((const abf*)(ws + WS_QA) + 64 * hq + qrow * 512, 512, (const abf*)(ws + WS_KA) + 64 * kh + rb * 128, 128, ws + WS_VT8 + (size_t)(b * 2 + kh) * 128 * 4096,
                                          (abf*)(ws + WS_OA) + 64 * hq + qrow * 512, 512, (char*)lds + RING_OFF, wave_s); }
            else for (int rep_ = 0; rep_ < PROBE_BREP; ++rep_) { const int h = st >> 1, m = st & 1;
                attn_body::attn_unit8<128>((const abf*)(ws + WS_QB) + 64 * st + qrow * 512, 512, (const abf*)(ws + WS_KB) + 64 * st + rb * 512, 512, ws + WS_VT8 + (size_t)8 * MiB + (size_t)(b * 4 + h) * 128 * 8192,
                                           (abf*)(ws + WS_OB) + 512 * m + 128 * h + qrow * 1024, 1024, (char*)lds + RING_OFF, wave_s); }
        }
    }
    SEAM();
    if (IN()) { TIDO(); KArgs A = kargs(); unsigned char* ws = A->ws; const float lam_init = 0.8f - 0.6f * expf(-0.3f * (float)layer);
        for (int rep_ = 0; rep_ < PROBE_T2; ++rep_) phase_t2((const bf16*)(ws + WS_OA), (const bf16*)(ws + WS_OB), (bf16*)(ws + WS_AO), A->in[9] + 512 * layer, A->in[11] + 128 * layer, A->in[10] + 256 * layer, lam_init, GW, NGW, LANE); }
    SEAM();
    if (IN()) {
        unsigned char* ws = kargs()->ws;
        pg8::StaticOrder S; S.init(NTOK / 256, DM / 256, G, bx, 0);
        if constexpr (PROJ_I8_OUT) {
            pg8::Gemm g{(const bf16*)(ws + WS_AO), (const bf16*)(ws + WS_WOUT + (size_t)layer * DM * DM), NTOK, DM, DM / 2};
            pg8::EpiBf16I8 E{(bf16*)(ws + WS_MIX), DM, (const float*)(ws + WS_SA2), (const float*)(ws + WS_SWOUT) + layer * DM};
            pg8::gemm_phase<pg8::EpiBf16I8, pg8::StaticOrder, true, true, false, true>(L + RING_OFF, g, S, E, wave_s);
        } else {
        pg8::Gemm g{(const bf16*)(ws + WS_AO), (const bf16*)(ws + WS_WOUT) + (size_t)layer * DM * DM, NTOK, DM, DM};
        pg8::EpiBf16 E{(bf16*)(ws + WS_MIX), DM};
        for (int rep_ = 0; rep_ < PROBE_G2; ++rep_) pg8::gemm_phase<pg8::EpiBf16, pg8::StaticOrder, true, true>(L + RING_OFF, g, S, E, wave_s);
        }
    }
    SEAM();
    if (IN()) {
        TIDO(); KArgs A = kargs(); unsigned char* ws = A->ws;
        const float* hsrc = layer == 0 ? A->in[0] : A->out;
        if constexpr (moe) phase_t3<true>(hsrc, A->out, (const bf16*)(ws + WS_MIX), (bf16*)(ws + WS_HN), A->in[4] + DM * layer, A->in[5] + DM * layer, A->in[15], (v4u*)(ws + WS_TOK), (unsigned*)(ws + WS_WGB), (gu32*)(ws + WS_CTL) + CW_CNT, LCNT, (LAS f32x4*)(L + RING_OFF), vcu, G, WAVE, LANE, tid);
        else phase_t3<false, DENSE_F8 != 0, DENSE_I8 != 0>(hsrc, A->out, (const bf16*)(ws + WS_MIX), (bf16*)(ws + WS_HN), A->in[4] + DM * layer, A->in[5] + DM * layer, A->in[15], (v4u*)(ws + WS_TOK), (unsigned*)(ws + WS_WGB), (gu32*)(ws + WS_CTL) + CW_CNT, LCNT, (LAS f32x4*)(L + RING_OFF), vcu, G, WAVE, LANE, tid);
    }
    SEAM();
    if constexpr (moe) { if (IN()) { TIDO(); unsigned char* ws = kargs()->ws; phase_gather(ws + WS_HN, ws + WS_XS, (const v4u*)(ws + WS_TOK), (const unsigned*)(ws + WS_WGB), (gu32*)(ws + WS_CTL) + CW_CNT, PSL, GW, NGW, LANE, tid); } SEAM(); }
    if constexpr (!moe) {
        for (int c = 0; c < 2; ++c) {
            const int pm0 = c * CHUNK_TILES;
            if (IN()) {
                unsigned char* ws = kargs()->ws;
                pg8::StaticOrder S; S.init(CHUNK_TILES, 2 * DFF / 256, G, bx, pm0);
                if constexpr (DENSE_I8) {
                    pg8::Gemm g{(const bf16*)(ws + WS_HN), (const bf16*)(ws + WS_WGU_D), 0, 2 * DFF, DM / 2};
                    pg8::EpiSwiGLUI8 E{(bf16*)(ws + WS_ACT) - (size_t)pm0 * 256 * DFF, DFF, (const float*)(ws + WS_SA), (const float*)(ws + WS_SWGU)};
                    pg8::gemm_phase<pg8::EpiSwiGLUI8, pg8::StaticOrder, true, true, false, true>(L + RING_OFF, g, S, E, wave_s);
                } else if constexpr (DENSE_F8) {
                    pg8::Gemm g{(const bf16*)(ws + WS_HN), (const bf16*)(ws + WS_WGU_D), 0, 2 * DFF, DM / 2};
                    pg8::EpiSwiGLU8 E{ws + WS_ACT - (size_t)pm0 * 256 * DFF, DFF, 1.0f / (A8SCALE * W8SCALE), H8SCALE};
                    pg8::gemm_phase<pg8::EpiSwiGLU8, pg8::StaticOrder, true, true, true>(L + RING_OFF, g, S, E, wave_s);
                } else {
                    pg8::Gemm g{(const bf16*)(ws + WS_HN), (const bf16*)(ws + WS_WGU_D), 0, 2 * DFF, DM};
                    pg8::EpiSwiGLU E{(bf16*)(ws + WS_ACT) - (size_t)pm0 * 256 * DFF, DFF};
                    for (int rep_ = 0; rep_ < PROBE_G3; ++rep_) pg8::gemm_phase<pg8::EpiSwiGLU, pg8::StaticOrder, true, true>(L + RING_OFF, g, S, E, wave_s);
                }
            }
            SEAM();
            if (IN()) {
                unsigned char* ws = kargs()->ws;
                pg8::StaticOrder S; S.init(CHUNK_TILES, DM / 256, G, bx, pm0);
                if constexpr (DENSE_F8) {
                    pg8::Gemm g{(const bf16*)(ws + WS_ACT - (size_t)pm0 * 256 * DFF), (const bf16*)(ws + WS_WDN_D), 0, DM, DFF / 2};
                    pg8::EpiBf16S E{(bf16*)(ws + WS_F), DM, 1.0f / (H8SCALE * W8SCALE)};
                    pg8::gemm_phase<pg8::EpiBf16S, pg8::StaticOrder, true, true, true>(L + RING_OFF, g, S, E, wave_s);
                } else {
                    pg8::Gemm g{(const bf16*)(ws + WS_ACT) - (size_t)pm0 * 256 * DFF, (const bf16*)(ws + WS_WDN_D), 0, DM, DFF};
                    pg8::EpiBf16 E{(bf16*)(ws + WS_F), DM};
                    for (int rep_ = 0; rep_ < PROBE_G4; ++rep_) pg8::gemm_phase<pg8::EpiBf16, pg8::StaticOrder, true, true>(L + RING_OFF, g, S, E, wave_s);
                }
            }
            SEAM();
        }
    } else {
        for (int c = 0; c < 5; ++c) {
            const int pm0 = c * CHUNK_TILES;
            if (IN()) {
                TIDO(); unsigned char* ws = kargs()->ws;
                const int n_used = fill_tile_experts((gu32*)(ws + WS_CTL) + CW_CNT, TE, tid);
                int nt = n_used - pm0; nt = nt > CHUNK_TILES ? CHUNK_TILES : nt;
                if (nt > 0) {
                    pg8::Gemm g{(const bf16*)(ws + WS_XS), (const bf16*)(ws + WS_WGU_M), 0, 2 * DFF, DM / 2};
                    pg8::StaticOrder S; S.init(nt, 2 * DFF / 256, G, bx, pm0); S.estride = (unsigned)(2 * DFF * DM); S.te = TE;
                    pg8::EpiSwiGLU8 E{ws + WS_ACT8 - (size_t)pm0 * 256 * DFF, DFF, 1.0f / (A8SCALE * W8SCALE), H8SCALE};
                    for (int rep_ = 0; rep_ < PROBE_G3; ++rep_) pg8::gemm_phase<pg8::EpiSwiGLU8, pg8::StaticOrder, true, true, true>(L + RING_OFF, g, S, E, wave_s);
                }
            }
            SEAM();
            if (IN()) {
                TIDO(); unsigned char* ws = kargs()->ws;
                const int n_used = fill_tile_experts((gu32*)(ws + WS_CTL) + CW_CNT, TE, tid);
                int nt = n_used - pm0; nt = nt > CHUNK_TILES ? CHUNK_TILES : nt;
                if (nt > 0) {
                    pg8::Gemm g{(const bf16*)(ws + WS_ACT8 - (size_t)pm0 * 256 * DFF), (const bf16*)(ws + WS_WDN_M), 0, DM, DFF / 2};
                    pg8::StaticOrder S; S.init(nt, DM / 256, G, bx, pm0); S.estride = (unsigned)(DM * DFF); S.te = TE;
                    pg8::EpiBf16S E{(bf16*)(ws + WS_YS), DM, 1.0f / (H8SCALE * W8SCALE)};
                    for (int rep_ = 0; rep_ < PROBE_G4; ++rep_) pg8::gemm_phase<pg8::EpiBf16S, pg8::StaticOrder, true, true, true>(L + RING_OFF, g, S, E, wave_s);
                }
            }
            SEAM();
        }
    }
    if (IN()) {
        TIDO(); KArgs A = kargs(); unsigned char* ws = A->ws;
        if constexpr (moe) phase_t4<true, false>(A->out, (const bf16*)(ws + WS_YS), (const v4u*)(ws + WS_TOK), (const unsigned*)(ws + WS_WGB), (gu32*)(ws + WS_CTL) + CW_CNT, PSL, A->in[6] + DM * layer, nullptr, (bf16*)(ws + WS_HN), GW, NGW, LANE, tid);
        else phase_t4<false, true>(A->out, (const bf16*)(ws + WS_F), (const v4u*)(ws + WS_TOK), (const unsigned*)(ws + WS_WGB), (gu32*)(ws + WS_CTL) + CW_CNT, PSL, A->in[6] + DM * layer, A->in[3] + DM * (layer + 1), (bf16*)(ws + WS_HN), GW, NGW, LANE, tid);
    }
    if constexpr (LAYER + 1 < NLAYER) SEAM();
}
__global__ void __launch_bounds__(NWAVES * 64, 2) fwd_kernel(Args args_unused) {
    extern __shared__ __attribute__((aligned(16))) unsigned char lds[];
    LAS unsigned char* L = (LAS unsigned char*)lds;
    const int tid0 = threadIdx.x; const int wave_s = __builtin_amdgcn_readfirstlane(tid0 >> 6);
    const int G = gridDim.x, bx = blockIdx.x;
    const int vcu = (G % 8 == 0) ? (bx % 8) * (G / 8) + bx / 8 : bx;
    for (int u = tid0; u < (LDS_BYTES - LDSCTL_OFF) / 4; u += NWAVES * 64) ((LAS unsigned*)(L + LDSCTL_OFF))[u] = 0u;
    __syncthreads();
    XcdBarrier bar;
    int lo, hi;
    { KArgs A = kargs(); lo = A->ph_lo; hi = A->ph_hi; bar = xcd_barrier_post((unsigned*)(A->ws + WS_CTL) + CW_BAR, (volatile LAS unsigned*)(L + MISC_OFF) + 8); }
    int ph = 0;

    if (IN()) { for (int rep_ = 0; rep_ < PROBE_P0; ++rep_) { TIDO(); phase_prologue(kargs(), L, GW, NGW, WAVE, LANE); } }
    SEAM();
    if (DENSE_I8 || PROJ_I8) { if (IN()) { TIDO(); phase_quant_gu(kargs(), L, GW, NGW, WAVE, LANE); } SEAM(); }
    layer_body<0>(L, lds, bar, lo, hi, ph, G, bx, vcu, wave_s);
    layer_body<1>(L, lds, bar, lo, hi, ph, G, bx, vcu, wave_s);
#undef IN
#undef SEAM
}

extern "C" void kernel_launch(void* const* d_in, const int* in_sizes, int n_in, void* d_out, int out_size, void* d_ws, size_t ws_size, hipStream_t stream) {
    static int grid = 0;
    if (grid == 0) {
        if (n_in != 19 || in_sizes[0] != NTOK * DM || out_size != NTOK * DM || ws_size < WS_END) {
            fprintf(stderr, "kernel_launch: built for 19 inputs, x/out of %d floats, >= %zu bytes of workspace; got n_in %d, in0 %d, out %d, ws %zu; nothing launched\n", NTOK * DM, (size_t)WS_END, n_in, n_in > 0 ? in_sizes[0] : -1, out_size, ws_size);
            grid = -1; return; }
        int dev = 0, cus = 0, per_cu = 0;
        if (hipGetDevice(&dev) != hipSuccess || hipDeviceGetAttribute(&cus, hipDeviceAttributeMultiprocessorCount, dev) != hipSuccess) { fprintf(stderr, "kernel_launch: device query failed\n"); grid = -1; return; }
        if (hipFuncSetAttribute((const void*)fwd_kernel, hipFuncAttributeMaxDynamicSharedMemorySize, LDS_BYTES) != hipSuccess) { fprintf(stderr, "kernel_launch: hipFuncSetAttribute failed\n"); grid = -1; return; }
        if (hipOccupancyMaxActiveBlocksPerMultiprocessor(&per_cu, (const void*)fwd_kernel, NWAVES * 64, LDS_BYTES) != hipSuccess || per_cu < 1)
            fprintf(stderr, "kernel_launch: note: occupancy query reports %d workgroups per CU\n", per_cu);
        (void)hipGetLastError();
        grid = cus;
    }
    if (grid < 0) return;
    if (hipMemsetAsync((char*)d_ws + WS_CTL, 0, CTL_ZERO_BYTES, stream) != hipSuccess) { fprintf(stderr, "kernel_launch: memset failed\n"); return; }
    Args a{};
    for (int i = 0; i < 19; ++i) a.in[i] = (const float*)d_in[i];
    a.out = (float*)d_out; a.ws = (unsigned char*)d_ws;
    const int ph_end = MK_PH_HI < N_PHASES ? MK_PH_HI : N_PHASES;
#if MK_PER_PHASE
    for (int p = 0; p < ph_end; ++p) { a.ph_lo = p; a.ph_hi = p + 1; hipLaunchKernelGGL(fwd_kernel, dim3(grid), dim3(NWAVES * 64), LDS_BYTES, stream, a); }
#else
    a.ph_lo = 0; a.ph_hi = ph_end;
    hipLaunchKernelGGL(fwd_kernel, dim3(grid), dim3(NWAVES * 64), LDS_BYTES, stream, a);
#endif
    const hipError_t le = hipPeekAtLastError();
    if (le != hipSuccess) fprintf(stderr, "kernel_launch: launch failed: %s\n", hipGetErrorName(le));
}
```

```cpp
#include <hip/hip_runtime.h>
#include <hip/hip_bf16.h>
#include <cstdio>
#include <cstdint>
#include <cmath>
namespace pg8 {
#define PG8_LAS __attribute__((address_space(3)))
typedef unsigned short bf16_t;
typedef short bf16x8 __attribute__((ext_vector_type(8)));
typedef float f32x4 __attribute__((ext_vector_type(4)));
typedef unsigned u32x4 __attribute__((ext_vector_type(4)));
typedef int i32x4 __attribute__((ext_vector_type(4)));
typedef int i32x8 __attribute__((ext_vector_type(8)));
constexpr int BM = 256, BK = 64, HALF = 128, HTB = HALF * BK * 2  , STAGE_BYTES = 8 * HTB, NXCD = 8, WGM = 8;

__host__ __device__ __forceinline__ int lds_byte(int r, int c) { const int st = (r >> 4) * 2 + (c >> 5), rr = r & 15, cc = c & 31, ob = rr * 64 + cc * 2; return st * 1024 + (ob ^ (((ob >> 9) & 1) << 5)); }
__host__ __device__ __forceinline__ void stage_rc(int b, int& R, int& C) { const int st = b / 1024, sb = b % 1024, swz = sb ^ (((sb >> 9) & 1) << 5); R = (st >> 1) * 16 + swz / 64; C = (st & 1) * 32 + (swz % 64) / 2; }
__host__ __device__ __forceinline__ int perm32(int rho) { const int n = rho >> 4, i = rho & 15; return 8 * (i >> 2) + 4 * n + (i & 3); }

struct Unit { int pm, pn; };
struct Gemm { const bf16_t* A; const bf16_t* Bt; int M, N, K; };

struct StaticOrder {
    int nM, nN, nwg, G, c, pm0; const PG8_LAS int* te; unsigned estride;
    __device__ void init(int nM_, int nN_, int G_, int c_, int pm0_) { nM = nM_; nN = nN_; nwg = nM * nN; G = G_; c = c_; pm0 = pm0_; estride = 0; te = nullptr; }
    __device__ bool next(int i, Unit& u) const {
        const long L = (long)i * G + c; if (L >= nwg) return false;
        int wgid = (int)L; { const int q = nwg / NXCD, r = nwg % NXCD, xcd = wgid % NXCD, off = wgid / NXCD; wgid = (xcd < r ? xcd * (q + 1) : r * (q + 1) + (xcd - r) * q) + off; }
        const int nig = WGM * nN, gid = wgid / nig, fm = gid * WGM, gsz = (nM - fm) < WGM ? (nM - fm) : WGM;
        u.pm = pm0 + fm + ((wgid % nig) % gsz); u.pn = (wgid % nig) / gsz; return true;
    }
    __device__ __forceinline__ size_t bofs(const Unit& u) const { if (estride == 0) return 0; const int e = __builtin_amdgcn_readfirstlane(te[u.pm]); return (size_t)e * estride; }
    __device__ __forceinline__ void a_ready(const Unit&) const {}
    __device__ __forceinline__ void done(const Unit&) const {}
};

__device__ __forceinline__ unsigned cvt_pk_bf16(float lo, float hi) { unsigned r; asm volatile("v_cvt_pk_bf16_f32 %0, %1, %2" : "=v"(r) : "v"(lo), "v"(hi)); return r; }

struct EpiBf16 {
    static constexpr bool PERM = true, AFTER_DRAIN = false;
    bf16_t* O; int ldc;
    __device__ __forceinline__ void operator()(const f32x4 (&acc)[2][2][4][2], const Unit& u, int wr, int wc, int fr, int fq) const {
        const int row0 = u.pm * BM + wr * 64 + fr; const int col0 = u.pn * BM + wc * 32 + 8 * fq;
#pragma unroll
        for (int ai = 0; ai < 2; ++ai)
#pragma unroll
            for (int m = 0; m < 4; ++m) { bf16_t* rowp = O + (size_t)(row0 + ai * HALF + m * 16) * ldc + col0;
#pragma unroll
                for (int bj = 0; bj < 2; ++bj) { const f32x4 v0 = acc[ai][bj][m][0], v1 = acc[ai][bj][m][1];
                    u32x4 w; w.x = cvt_pk_bf16(v0[0], v0[1]); w.y = cvt_pk_bf16(v0[2], v0[3]); w.z = cvt_pk_bf16(v1[0], v1[1]); w.w = cvt_pk_bf16(v1[2], v1[3]);
                    *(u32x4*)(rowp + bj * HALF) = w; } }
    }
};
__device__ __forceinline__ unsigned cvt4_fp8(float a, float b, float c, float d) {
    a = __builtin_amdgcn_fmed3f(a, -448.f, 448.f); b = __builtin_amdgcn_fmed3f(b, -448.f, 448.f); c = __builtin_amdgcn_fmed3f(c, -448.f, 448.f); d = __builtin_amdgcn_fmed3f(d, -448.f, 448.f);
    int w = 0; w = __builtin_amdgcn_cvt_pk_fp8_f32(a, b, w, false); w = __builtin_amdgcn_cvt_pk_fp8_f32(c, d, w, true); return (unsigned)w; }
struct EpiBf16S {
    static constexpr bool PERM = true, AFTER_DRAIN = false;
    bf16_t* O; int ldc; float s;
    __device__ __forceinline__ void operator()(const f32x4 (&acc)[2][2][4][2], const Unit& u, int wr, int wc, int fr, int fq) const {
        const int row0 = u.pm * BM + wr * 64 + fr; const int col0 = u.pn * BM + wc * 32 + 8 * fq;
#pragma unroll
        for (int ai = 0; ai < 2; ++ai)
#pragma unroll
            for (int m = 0; m < 4; ++m) { bf16_t* rowp = O + (size_t)(row0 + ai * HALF + m * 16) * ldc + col0;
#pragma unroll
                for (int bj = 0; bj < 2; ++bj) { const f32x4 v0 = acc[ai][bj][m][0] * s, v1 = acc[ai][bj][m][1] * s;
                    u32x4 w; w.x = cvt_pk_bf16(v0[0], v0[1]); w.y = cvt_pk_bf16(v0[2], v0[3]); w.z = cvt_pk_bf16(v1[0], v1[1]); w.w = cvt_pk_bf16(v1[2], v1[3]);
                    *(u32x4*)(rowp + bj * HALF) = w; } }
    }
};
struct EpiBf16I8 {
    static constexpr bool PERM = true, AFTER_DRAIN = false;
    bf16_t* O; int ldc; const float* sa; const float* sw;
    __device__ __forceinline__ void operator()(const f32x4 (&acc)[2][2][4][2], const Unit& u, int wr, int wc, int fr, int fq) const {
        const int row0 = u.pm * BM + wr * 64 + fr; const int col0 = u.pn * BM + wc * 32 + 8 * fq;
        f32x4 sv[2][2];
#pragma unroll
        for (int bj = 0; bj < 2; ++bj)
#pragma unroll
            for (int n = 0; n < 2; ++n) sv[bj][n] = *(const f32x4*)(sw + col0 + bj * HALF + 4 * n);
#pragma unroll
        for (int ai = 0; ai < 2; ++ai)
#pragma unroll
            for (int m = 0; m < 4; ++m) { const int row = row0 + ai * HALF + m * 16; bf16_t* rowp = O + (size_t)row * ldc + col0; const float a = sa[row];
#pragma unroll
                for (int bj = 0; bj < 2; ++bj) { const f32x4 v0 = __builtin_convertvector(__builtin_bit_cast(i32x4, acc[ai][bj][m][0]), f32x4) * (sv[bj][0] * a), v1 = __builtin_convertvector(__builtin_bit_cast(i32x4, acc[ai][bj][m][1]), f32x4) * (sv[bj][1] * a);
                    u32x4 w; w.x = cvt_pk_bf16(v0[0], v0[1]); w.y = cvt_pk_bf16(v0[2], v0[3]); w.z = cvt_pk_bf16(v1[0], v1[1]); w.w = cvt_pk_bf16(v1[2], v1[3]);
                    *(u32x4*)(rowp + bj * HALF) = w; } }
    }
};
__device__ __forceinline__ float silu_mul(float g, float u) { const float e = __builtin_amdgcn_exp2f(-1.4426950408889634f * g); return g * __builtin_amdgcn_rcpf(1.0f + e) * u; }
struct EpiSwiGLU {
    static constexpr bool PERM = true, AFTER_DRAIN = false;
    bf16_t* O; int ldc;
    __device__ __forceinline__ void operator()(const f32x4 (&acc)[2][2][4][2], const Unit& u, int wr, int wc, int fr, int fq) const {
        const int row0 = u.pm * BM + wr * 64 + fr; const int col0 = u.pn * HALF + wc * 32 + 8 * fq;
#pragma unroll
        for (int ai = 0; ai < 2; ++ai)
#pragma unroll
            for (int m = 0; m < 4; ++m) { bf16_t* rowp = O + (size_t)(row0 + ai * HALF + m * 16) * ldc + col0;
                const f32x4 g0 = acc[ai][0][m][0], g1 = acc[ai][0][m][1], u0 = acc[ai][1][m][0], u1 = acc[ai][1][m][1];
                u32x4 w; w.x = cvt_pk_bf16(silu_mul(g0[0], u0[0]), silu_mul(g0[1], u0[1])); w.y = cvt_pk_bf16(silu_mul(g0[2], u0[2]), silu_mul(g0[3], u0[3]));
                w.z = cvt_pk_bf16(silu_mul(g1[0], u1[0]), silu_mul(g1[1], u1[1])); w.w = cvt_pk_bf16(silu_mul(g1[2], u1[2]), silu_mul(g1[3], u1[3]));
                *(u32x4*)rowp = w; }
    }
};
struct EpiSwiGLUI8 {
    static constexpr bool PERM = true, AFTER_DRAIN = false;
    bf16_t* O; int ldc; const float* sa; const float* sw;
    __device__ __forceinline__ void operator()(const f32x4 (&acc)[2][2][4][2], const Unit& u, int wr, int wc, int fr, int fq) const {
        const int row0 = u.pm * BM + wr * 64 + fr; const int col0 = u.pn * HALF + wc * 32 + 8 * fq; const int brow0 = u.pn * BM + wc * 32 + 8 * fq;
        const f32x4 sg0 = *(const f32x4*)(sw + brow0), sg1 = *(const f32x4*)(sw + brow0 + 4), su0 = *(const f32x4*)(sw + brow0 + HALF), su1 = *(const f32x4*)(sw + brow0 + HALF + 4);
#pragma unroll
        for (int ai = 0; ai < 2; ++ai)
#pragma unroll
            for (int m = 0; m < 4; ++m) { const int row = row0 + ai * HALF + m * 16; bf16_t* rowp = O + (size_t)row * ldc + col0; const float a = sa[row];
                const i32x4 ig0 = __builtin_bit_cast(i32x4, acc[ai][0][m][0]), ig1 = __builtin_bit_cast(i32x4, acc[ai][0][m][1]), iu0 = __builtin_bit_cast(i32x4, acc[ai][1][m][0]), iu1 = __builtin_bit_cast(i32x4, acc[ai][1][m][1]);
                f32x4 g0, g1, u0, u1;
#pragma unroll
                for (int e = 0; e < 4; ++e) { g0[e] = (float)ig0[e] * (a * sg0[e]); g1[e] = (float)ig1[e] * (a * sg1[e]); u0[e] = (float)iu0[e] * (a * su0[e]); u1[e] = (float)iu1[e] * (a * su1[e]); }
                u32x4 w; w.x = cvt_pk_bf16(silu_mul(g0[0], u0[0]), silu_mul(g0[1], u0[1])); w.y = cvt_pk_bf16(silu_mul(g0[2], u0[2]), silu_mul(g0[3], u0[3]));
                w.z = cvt_pk_bf16(silu_mul(g1[0], u1[0]), silu_mul(g1[1], u1[1])); w.w = cvt_pk_bf16(silu_mul(g1[2], u1[2]), silu_mul(g1[3], u1[3]));
                *(u32x4*)rowp = w; }
    }
};
struct EpiSwiGLU8 {
    static constexpr bool PERM = true, AFTER_DRAIN = false;
    unsigned char* O; int ldc; float sin, sout;
    __device__ __forceinline__ void operator()(const f32x4 (&acc)[2][2][4][2], const Unit& u, int wr, int wc, int fr, int fq) const {
        typedef unsigned u32x2 __attribute__((ext_vector_type(2)));
        const int row0 = u.pm * BM + wr * 64 + fr; const int col0 = u.pn * HALF + wc * 32 + 8 * fq;
#pragma unroll
        for (int ai = 0; ai < 2; ++ai)
#pragma unroll
            for (int m = 0; m < 4; ++m) { unsigned char* rowp = O + (size_t)(row0 + ai * HALF + m * 16) * ldc + col0;
                const f32x4 g0 = acc[ai][0][m][0] * sin, g1 = acc[ai][0][m][1] * sin, u0 = acc[ai][1][m][0] * (sin * sout), u1 = acc[ai][1][m][1] * (sin * sout);
                u32x2 w; w.x = cvt4_fp8(silu_mul(g0[0], u0[0]), silu_mul(g0[1], u0[1]), silu_mul(g0[2], u0[2]), silu_mul(g0[3], u0[3]));
                w.y = cvt4_fp8(silu_mul(g1[0], u1[0]), silu_mul(g1[1], u1[1]), silu_mul(g1[2], u1[2]), silu_mul(g1[3], u1[3]));
                *(u32x2*)rowp = w; }
    }
};
template <bool I8> struct EpiInProjT {
    static constexpr bool PERM = false, AFTER_DRAIN = false;
    unsigned char* ws; size_t oQA, oKA, oVA, oQB, oKB, oVB; const float* gq; const float* gk; float qscale; const float* sa; const float* sw;
    __device__ __forceinline__ void operator()(const f32x4 (&acc)[2][2][4][2], const Unit& u, int wr, int wc, int fr_, int fq_) const {
        int fr = fr_, fq = fq_; asm volatile("" : "+v"(fr), "+v"(fq));
        const int pn = u.pn; int kind, pitch, col0; bf16_t* base;
        if (pn < 2) { kind = 0; base = (bf16_t*)(ws + oQA); pitch = 512; col0 = 64 * (4 * pn + wc); }
        else if (pn == 2) { if (wc < 2) { kind = 1; base = (bf16_t*)(ws + oKA); pitch = 128; col0 = 64 * wc; } else { kind = 2; base = (bf16_t*)(ws + oVA); pitch = 128; col0 = 64 * (wc - 2); } }
        else if (pn < 5) { kind = 3; base = (bf16_t*)(ws + oQB); pitch = 512; col0 = 64 * (4 * (pn - 3) + wc); }
        else if (pn < 7) { kind = 4; base = (bf16_t*)(ws + oKB); pitch = 512; col0 = 64 * (4 * (pn - 5) + wc); }
        else { kind = 2; base = (bf16_t*)(ws + oVB); pitch = 512; col0 = 64 * (4 * (pn - 7) + wc); }
        const int row0 = u.pm * BM + wr * 64 + fr;
        bf16_t* outp = base + (size_t)row0 * pitch + col0 + 16 * fq;
        const float* swp = I8 ? sw + u.pn * BM + 32 * wc + 4 * fq : nullptr;
#define IP_ACC(ai, bj, m, n, sar) (I8 ? __builtin_convertvector(__builtin_bit_cast(i32x4, acc[ai][bj][m][n]), f32x4) * (*(const f32x4*)(swp + 128 * (bj) + 16 * (n)) * (sar)) : acc[ai][bj][m][n])
        const float L2T = 13.287712379549449f;
        if (kind == 2) {
#pragma unroll
            for (int ai = 0; ai < 2; ++ai)
#pragma unroll
                for (int m = 0; m < 4; ++m) { bf16_t* rp = outp + (size_t)(ai * HALF + m * 16) * pitch; const float sar = I8 ? sa[row0 + ai * HALF + m * 16] : 1.f;
#pragma unroll
                    for (int bj = 0; bj < 2; ++bj) { const f32x4 v0 = IP_ACC(ai, bj, m, 0, sar), v1 = IP_ACC(ai, bj, m, 1, sar);
                        u32x4 w; w.x = cvt_pk_bf16(v0[0], v0[1]); w.y = cvt_pk_bf16(v0[2], v0[3]); w.z = cvt_pk_bf16(v1[0], v1[1]); w.w = cvt_pk_bf16(v1[2], v1[3]);
                        *(u32x4*)(rp + 8 * bj) = w; } }
        } else if (kind <= 1) {
            const float* g = kind == 0 ? gq : gk; const float sc = kind == 0 ? qscale : 1.0f;
            float inv[4];
#pragma unroll
            for (int e = 0; e < 4; ++e) inv[e] = __builtin_amdgcn_exp2f(-(float)(4 * fq + e) * (L2T / 16.0f)) * 0.15915494309189535f;
#pragma unroll
            for (int ai = 0; ai < 2; ++ai)
#pragma unroll
                for (int m = 0; m < 4; ++m) { const int row = row0 + ai * HALF + m * 16; const int t = row & 8191; const float pr = (float)(t >> 6), pc = (float)(t & 63);
                    f32x4 v[2][2]; float ss = 0.f; const float sar = I8 ? sa[row] : 1.f;
#pragma unroll
                    for (int bj = 0; bj < 2; ++bj)
#pragma unroll
                        for (int n = 0; n < 2; ++n) { v[bj][n] = IP_ACC(ai, bj, m, n, sar); ss += (v[bj][n][0] * v[bj][n][0] + v[bj][n][1] * v[bj][n][1]) + (v[bj][n][2] * v[bj][n][2] + v[bj][n][3] * v[bj][n][3]); }
                    ss += __shfl_xor(ss, 16); ss += __shfl_xor(ss, 32);
                    const float rinv = __builtin_amdgcn_rsqf(ss * (1.0f / 64.0f) + 1e-6f) * sc;
#pragma unroll
                    for (int bj = 0; bj < 2; ++bj) { const float pos = bj == 0 ? pr : pc; const f32x4 gv0 = *(const f32x4*)(g + 32 * bj + 4 * fq), gv1 = *(const f32x4*)(g + 32 * bj + 16 + 4 * fq);
#pragma unroll
                        for (int e = 0; e < 4; ++e) { float rev = pos * inv[e]; rev = rev - __builtin_floorf(rev);
                            const float sn = __builtin_amdgcn_sinf(rev), cs = __builtin_amdgcn_cosf(rev);
                            float x1 = v[bj][0][e] * rinv * gv0[e], x2 = v[bj][1][e] * rinv * gv1[e]; asm volatile("" : "+v"(x1), "+v"(x2));
                            v[bj][0][e] = x1 * cs - x2 * sn; v[bj][1][e] = x2 * cs + x1 * sn; } }
                    bf16_t* rp = outp + (size_t)(ai * HALF + m * 16) * pitch;
#pragma unroll
                    for (int bj = 0; bj < 2; ++bj) { const f32x4 v0 = v[bj][0], v1 = v[bj][1];
                        u32x4 w; w.x = cvt_pk_bf16(v0[0], v0[1]); w.y = cvt_pk_bf16(v0[2], v0[3]); w.z = cvt_pk_bf16(v1[0], v1[1]); w.w = cvt_pk_bf16(v1[2], v1[3]);
                        *(u32x4*)(rp + 8 * bj) = w; } }
        } else {
            const float sc = kind == 3 ? qscale : 1.0f;
            float inv[2][4];
#pragma unroll
            for (int n = 0; n < 2; ++n)
#pragma unroll
                for (int e = 0; e < 4; ++e) inv[n][e] = __builtin_amdgcn_exp2f(-(float)(16 * n + 4 * fq + e) * (L2T / 32.0f)) * 0.15915494309189535f;
#pragma unroll
            for (int ai = 0; ai < 2; ++ai)
#pragma unroll
                for (int m = 0; m < 4; ++m) { const int row = row0 + ai * HALF + m * 16; const float pos = (float)(row & 8191);
                    f32x4 v[2][2]; const float sar = I8 ? sa[row] : 1.f;
#pragma unroll
                    for (int n = 0; n < 2; ++n) { const f32x4 a1_ = IP_ACC(ai, 0, m, n, sar), a2_ = IP_ACC(ai, 1, m, n, sar);
#pragma unroll
                        for (int e = 0; e < 4; ++e) { float rev = pos * inv[n][e]; rev = rev - __builtin_floorf(rev);
                            const float sn = __builtin_amdgcn_sinf(rev) * sc, cs = __builtin_amdgcn_cosf(rev) * sc;
                            float x1 = a1_[e], x2 = a2_[e]; asm volatile("" : "+v"(x1), "+v"(x2));
                            v[0][n][e] = x1 * cs - x2 * sn; v[1][n][e] = x2 * cs + x1 * sn; } }
                    bf16_t* rp = outp + (size_t)(ai * HALF + m * 16) * pitch;
#pragma unroll
                    for (int bj = 0; bj < 2; ++bj) { const f32x4 v0 = v[bj][0], v1 = v[bj][1];
                        u32x4 w; w.x = cvt_pk_bf16(v0[0], v0[1]); w.y = cvt_pk_bf16(v0[2], v0[3]); w.z = cvt_pk_bf16(v1[0], v1[1]); w.w = cvt_pk_bf16(v1[2], v1[3]);
                        *(u32x4*)(rp + 8 * bj) = w; } }
        }
    }
#undef IP_ACC
};
typedef EpiInProjT<false> EpiInProj;
typedef EpiInProjT<true> EpiInProjI8;


template <class Epi, class Sched, bool ALIGN_EPI = false, bool SP2 = false, bool F8 = false, bool I8 = false>
__device__ __forceinline__ void gemm_phase(PG8_LAS unsigned char* lds, const Gemm g, const Sched& S, const Epi& E, int wave_in) {
    int tid_; asm volatile("v_mbcnt_lo_u32_b32 %0, -1, 0\n\tv_mbcnt_hi_u32_b32 %0, -1, %0" : "=v"(tid_)); tid_ += wave_in * 64;
    const int tid = tid_, wid = __builtin_amdgcn_readfirstlane(tid >> 6), lane = tid & 63, wr = wid >> 2, wc = wid & 3, fr = lane & 15, fq = lane >> 4;
    const int K = g.K, nt = K / BK;
    unsigned voffA, voffB;
    { int R, C; stage_rc(tid * 16, R, C); const int Rb = Epi::PERM ? ((R & ~31) + perm32(R & 31)) : R; voffA = (unsigned)(R * K + C) * 2u; voffB = (unsigned)(Rb * K + C) * 2u; }
    const size_t qstep = (size_t)64 * K * 2;
    const size_t kstep = (size_t)(BK * 2);
    const size_t hstep = (size_t)HALF * K * 2;
    const size_t tstep = 2 * hstep;
    const unsigned ldsw = (unsigned)wid * 1024u;
    const int aoff = F8 ? lds_byte(wr * 64 + fr, fq * 16) : lds_byte(wr * 64 + fr, fq * 8), boff = F8 ? lds_byte(wc * 32 + fr, fq * 16) : lds_byte(wc * 32 + fr, fq * 8);
#define PG8_SA(b, h) (((b) * 2 + (h)) * HTB)
#define PG8_SB(b, h) ((4 + (b) * 2 + (h)) * HTB)
#define PG8_STAGE(bufoff, gbase, voff) do { _Pragma("unroll") for (int _i = 0; _i < 2; ++_i) \
        __builtin_amdgcn_global_load_lds((const unsigned*)((const char*)(gbase) + _i * qstep + (voff)), (PG8_LAS unsigned*)(lds + (bufoff) + ldsw + _i * 8192), 16, 0, 0); } while (0)
#define PG8_LDF(off) (*(const PG8_LAS bf16x8*)(lds + (off)))
#define PG8_LDA(dst, b, h) do { if constexpr (!F8) { _Pragma("unroll") for (int m = 0; m < 4; ++m) _Pragma("unroll") for (int k = 0; k < 2; ++k) dst[m][k] = PG8_LDF(PG8_SA(b, h) + aoff + m * 2048 + k * 1024); } \
        else { _Pragma("unroll") for (int m = 0; m < 4; ++m) dst##8[m] = *(const PG8_LAS i32x8*)(lds + PG8_SA(b, h) + aoff + m * 2048); } } while (0)
#define PG8_LDB(dst, b, h) do { if constexpr (!F8) { _Pragma("unroll") for (int n = 0; n < 2; ++n) _Pragma("unroll") for (int k = 0; k < 2; ++k) dst[n][k] = PG8_LDF(PG8_SB(b, h) + boff + n * 2048 + k * 1024); } \
        else { _Pragma("unroll") for (int n = 0; n < 2; ++n) dst##8[n] = *(const PG8_LAS i32x8*)(lds + PG8_SB(b, h) + boff + n * 2048); } } while (0)
#define PG8_MMA(ai, bj, At, Bt) do { __builtin_amdgcn_s_setprio(1); if constexpr (!F8) { _Pragma("unroll") for (int m = 0; m < 4; ++m) _Pragma("unroll") for (int n = 0; n < 2; ++n) _Pragma("unroll") for (int k = 0; k < 2; ++k) \
        { if constexpr (I8) acc[ai][bj][m][n] = __builtin_bit_cast(f32x4, __builtin_amdgcn_mfma_i32_16x16x64_i8(__builtin_bit_cast(i32x4, Bt[n][k]), __builtin_bit_cast(i32x4, At[m][k]), __builtin_bit_cast(i32x4, acc[ai][bj][m][n]), 0, 0, 0)); \
          else acc[ai][bj][m][n] = __builtin_amdgcn_mfma_f32_16x16x32_bf16(Bt[n][k], At[m][k], acc[ai][bj][m][n], 0, 0, 0); } } else { \
        _Pragma("unroll") for (int m = 0; m < 4; ++m) _Pragma("unroll") for (int n = 0; n < 2; ++n) \
        asm volatile("v_mfma_scale_f32_16x16x128_f8f6f4 %0, %1, %2, %0, %3, %3 op_sel_hi:[0,0,0]" : "+v"(acc[ai][bj][m][n]) : "v"(Bt##8[n]), "v"(At##8[m]), "v"(f8scale)); } \
        __builtin_amdgcn_s_setprio(0); } while (0)
#define PG8_CAT(x, y) __builtin_shufflevector(__builtin_bit_cast(i32x4, x), __builtin_bit_cast(i32x4, y), 0, 1, 2, 3, 4, 5, 6, 7)
#define PG8_WAIT_V(n) asm volatile("s_waitcnt vmcnt(" #n ")" ::: "memory")
#define PG8_WAIT_L(n) asm volatile("s_waitcnt lgkmcnt(" #n ")" ::: "memory")
#define PG8_BAR __builtin_amdgcn_s_barrier()
#define PG8_SCHED __builtin_amdgcn_sched_barrier(0)
    Unit cur, nxt; int ui = 0;
    if (!S.next(0, cur)) return;
    f32x4 acc[2][2][4][2];
#pragma unroll
    for (int a = 0; a < 2; ++a)
#pragma unroll
        for (int b = 0; b < 2; ++b)
#pragma unroll
            for (int m = 0; m < 4; ++m)
#pragma unroll
                for (int n = 0; n < 2; ++n) acc[a][b][m][n] = (f32x4){0.f, 0.f, 0.f, 0.f};
    const int f8scale = 0x7f7f7f7f;
    bf16x8 At[4][2], B0[2][2], B1[2][2]; i32x8 At8[4], B08[2], B18[2];
    const char* cA = (const char*)g.A + (size_t)cur.pm * tstep; const char* cB = (const char*)g.Bt + S.bofs(cur) + (size_t)cur.pn * tstep;
    S.a_ready(cur);
    if constexpr (SP2) {
        PG8_STAGE(PG8_SB(0, 0), cB, voffB); PG8_STAGE(PG8_SB(0, 1), cB + hstep, voffB); PG8_STAGE(PG8_SA(0, 0), cA, voffA); PG8_STAGE(PG8_SA(0, 1), cA + hstep, voffA);
        if (wr == 1) PG8_BAR;
        PG8_WAIT_V(2); PG8_BAR;
        PG8_STAGE(PG8_SB(1, 0), cB + kstep, voffB); PG8_STAGE(PG8_SA(1, 0), cA + kstep, voffA); PG8_STAGE(PG8_SB(1, 1), cB + hstep + kstep, voffB);
        PG8_WAIT_V(6); PG8_BAR;
    } else {
        PG8_STAGE(PG8_SB(0, 0), cB, voffB); PG8_STAGE(PG8_SA(0, 0), cA, voffA); PG8_STAGE(PG8_SB(0, 1), cB + hstep, voffB); PG8_STAGE(PG8_SA(0, 1), cA + hstep, voffA);
        if (wr == 1) PG8_BAR;
        PG8_WAIT_V(4); PG8_BAR;
        PG8_STAGE(PG8_SB(1, 0), cB + kstep, voffB); PG8_STAGE(PG8_SA(1, 0), cA + kstep, voffA); PG8_STAGE(PG8_SB(1, 1), cB + hstep + kstep, voffB);
        PG8_WAIT_V(6); PG8_BAR;
    }
    for (;;) {
        const bool has_next = S.next(ui + 1, nxt);
        const char* nA = has_next ? (const char*)g.A + (size_t)nxt.pm * tstep : cA; const char* nB = has_next ? (const char*)g.Bt + S.bofs(nxt) + (size_t)nxt.pn * tstep : cB;
#pragma nounroll
        for (int t = 0; t < nt; t += 2) {
            const bool last = (t == nt - 2);
            const char* a1 = cA + (size_t)(t + 1) * kstep;
            const char* a2 = last ? nA : cA + (size_t)(t + 2) * kstep; const char* b2 = last ? nB : cB + (size_t)(t + 2) * kstep;
            const char* a3 = a2 + kstep; const char* b3 = b2 + kstep;
            if (last && has_next) S.a_ready(nxt);
            if constexpr (SP2) {
            PG8_LDB(B0, 0, 0); PG8_LDB(B1, 0, 1); PG8_SCHED; PG8_LDA(At, 0, 0); PG8_STAGE(PG8_SA(1, 1), a1 + hstep, voffA);
            PG8_WAIT_V(8); PG8_WAIT_L(0); PG8_BAR; PG8_MMA(0, 0, At, B0); PG8_MMA(0, 1, At, B1); PG8_BAR; PG8_SCHED;
            PG8_LDA(At, 0, 1); PG8_STAGE(PG8_SB(0, 0), b2, voffB); PG8_STAGE(PG8_SB(0, 1), b2 + hstep, voffB); PG8_STAGE(PG8_SA(0, 0), a2, voffA);
            PG8_WAIT_V(8); PG8_WAIT_L(0); PG8_BAR; PG8_MMA(1, 0, At, B0); PG8_MMA(1, 1, At, B1); PG8_BAR; PG8_SCHED;
            PG8_LDB(B0, 1, 0); PG8_LDB(B1, 1, 1); PG8_SCHED; PG8_LDA(At, 1, 0); PG8_STAGE(PG8_SA(0, 1), a2 + hstep, voffA);
            PG8_WAIT_V(8); PG8_WAIT_L(0); PG8_BAR; PG8_MMA(0, 0, At, B0); PG8_MMA(0, 1, At, B1); PG8_BAR; PG8_SCHED;
            PG8_LDA(At, 1, 1); PG8_STAGE(PG8_SB(1, 0), b3, voffB); PG8_STAGE(PG8_SB(1, 1), b3 + hstep, voffB); PG8_STAGE(PG8_SA(1, 0), a3, voffA);
            PG8_WAIT_V(8); PG8_WAIT_L(0); PG8_BAR; PG8_MMA(1, 0, At, B0); PG8_MMA(1, 1, At, B1); PG8_BAR; PG8_SCHED;
            } else {
            PG8_LDB(B0, 0, 0); PG8_SCHED; PG8_LDA(At, 0, 0); PG8_STAGE(PG8_SA(1, 1), a1 + hstep, voffA);
            PG8_WAIT_L(8); PG8_BAR; PG8_WAIT_L(0); PG8_MMA(0, 0, At, B0); PG8_BAR; PG8_SCHED;
            PG8_LDB(B1, 0, 1); PG8_STAGE(PG8_SB(0, 0), b2, voffB);
            PG8_BAR; PG8_WAIT_L(0); PG8_MMA(0, 1, At, B1); PG8_BAR;
            PG8_LDA(At, 0, 1); PG8_STAGE(PG8_SA(0, 0), a2, voffA);
            PG8_BAR; PG8_WAIT_L(0); PG8_MMA(1, 0, At, B0); PG8_BAR; PG8_SCHED;
            PG8_STAGE(PG8_SB(0, 1), b2 + hstep, voffB);
            PG8_WAIT_V(6); PG8_BAR; PG8_MMA(1, 1, At, B1); PG8_BAR;
            PG8_LDB(B0, 1, 0); PG8_SCHED; PG8_LDA(At, 1, 0); PG8_STAGE(PG8_SA(0, 1), a2 + hstep, voffA);
            PG8_WAIT_L(8); PG8_BAR; PG8_WAIT_L(0); PG8_MMA(0, 0, At, B0); PG8_BAR; PG8_SCHED;
            PG8_LDB(B1, 1, 1); PG8_STAGE(PG8_SB(1, 0), b3, voffB);
            PG8_BAR; PG8_WAIT_L(0); PG8_MMA(0, 1, At, B1); PG8_BAR;
            PG8_LDA(At, 1, 1); PG8_STAGE(PG8_SA(1, 0), a3, voffA);
            PG8_BAR; PG8_WAIT_L(0); PG8_MMA(1, 0, At, B0); PG8_BAR; PG8_SCHED;
            PG8_STAGE(PG8_SB(1, 1), b3 + hstep, voffB);
            PG8_WAIT_V(6); PG8_BAR; PG8_MMA(1, 1, At, B1); PG8_BAR;
            }
        }
        if constexpr (F8) { asm volatile("s_nop 15\n\ts_nop 15\n\ts_nop 15\n\ts_nop 15" ::: "memory");
            _Pragma("unroll") for (int m = 0; m < 4; ++m) asm volatile("" :: "v"(At8[m]));
            _Pragma("unroll") for (int n = 0; n < 2; ++n) asm volatile("" :: "v"(B08[n]), "v"(B18[n])); }
        if constexpr (ALIGN_EPI) { if (wr == 0) PG8_BAR; }
        if constexpr (!Epi::AFTER_DRAIN) { E(acc, cur, wr, wc, fr, fq); S.done(cur); }
        if (!has_next) break;
#pragma unroll
        for (int a = 0; a < 2; ++a)
#pragma unroll
            for (int b = 0; b < 2; ++b)
#pragma unroll
                for (int m = 0; m < 4; ++m)
#pragma unroll
                    for (int n = 0; n < 2; ++n) acc[a][b][m][n] = (f32x4){0.f, 0.f, 0.f, 0.f};
        cur = nxt; cA = nA; cB = nB; ++ui;
        if constexpr (ALIGN_EPI) { if (wr == 1) PG8_BAR; }
    }
    PG8_WAIT_V(0);
    if constexpr (!ALIGN_EPI) { if (wr == 0) PG8_BAR; }
    PG8_BAR;
    if constexpr (Epi::AFTER_DRAIN) { E.fused(acc, cur, wr, wc, fr, fq, lds, wid, lane); S.done(cur); }
#undef PG8_SA
#undef PG8_SB
#undef PG8_STAGE
#undef PG8_LDA
#undef PG8_LDF
#undef PG8_LDB
#undef PG8_MMA
#undef PG8_CAT
#undef PG8_WAIT_V
#undef PG8_WAIT_L
#undef PG8_BAR
#undef PG8_SCHED
}
}
namespace attn_body {
using bf16=__hip_bfloat16;
using bf16x8=__attribute__((ext_vector_type(8)))short;
using s16x4=__attribute__((ext_vector_type(4)))short;
using f32x16=__attribute__((ext_vector_type(16)))float;
using u32x4=__attribute__((ext_vector_type(4)))unsigned;
constexpr int SEQ=8192,D=64;
constexpr int NW=8,QBLK=32,QB=QBLK*NW,KVBLK=64,NQB=SEQ/QB;
constexpr int ATTN_UNIT_ROWS=QB;
__device__ __forceinline__ int crow(int r,int hi){return (r&3)+8*(r>>2)+4*hi;}
#define SBAR() __builtin_amdgcn_sched_barrier(0)
__device__ __forceinline__ void cmask(f32x16&p0,f32x16&p1,int jb,int qrel,int hi){
  const float NEG=-INFINITY; int kb=64*jb+4*hi;
  #pragma unroll
  for(int r=0;r<16;++r){int kv=kb+(r&3)+8*(r>>2); if(kv>qrel)p0[r]=NEG; if(kv+32>qrel)p1[r]=NEG;}
}

constexpr int NSLOT=3, SLOTB=8192;
constexpr int LDS_K=0, LDS_V=NSLOT*SLOTB, LDS_WS=LDS_V+NSLOT*2*SLOTB, LDS_OST=LDS_WS+NW*64*4, LDS_BYTES=LDS_OST+NW*4096;
constexpr float C2=0.125f*1.4426950408889634f;
__device__ __forceinline__ void glds16(const void*gsrc,unsigned lds_dst){unsigned keep;
  asm volatile("s_mov_b32 %0, m0\n\ts_mov_b32 m0, %2\n\ts_nop 0\n\tglobal_load_lds_dwordx4 %1, off\n\ts_mov_b32 m0, %0":"=&s"(keep):"v"(gsrc),"s"(lds_dst):"memory");}
__device__ __forceinline__ float max3f(float a,float b,float c){float r;asm("v_max3_f32 %0, %1, %2, %3":"=v"(r):"v"(a),"v"(b),"v"(c));return r;}
__device__ __forceinline__ float max2f(float a,float b){float r;asm("v_max_f32_e32 %0, %1, %2":"=v"(r):"v"(a),"v"(b));return r;}
__device__ __forceinline__ float fadd_s(float a,float b){float r;asm("v_add_f32_e32 %0, %1, %2":"=v"(r):"v"(a),"v"(b));return r;}
__device__ __forceinline__ float fsub_s(float a,float b){float r;asm("v_sub_f32_e32 %0, %1, %2":"=v"(r):"v"(a),"v"(b));return r;}
typedef float f32x2_t __attribute__((ext_vector_type(2))); typedef __bf16 bf16x2_t __attribute__((ext_vector_type(2)));
__device__ __forceinline__ unsigned cvtpk_s(float lo,float hi){f32x2_t v={lo,hi};bf16x2_t b=__builtin_convertvector(v,bf16x2_t);return __builtin_bit_cast(unsigned,b);}
#define WAIT_BAR(N) asm volatile("s_waitcnt vmcnt(" #N ") lgkmcnt(0)\n\ts_barrier":::"memory")

__device__ __forceinline__ void qkt(f32x16&p0,f32x16&p1,const char*Kslot,const bf16x8*qr,const f32x16&negm,int r32,int hi){
  const char*kb=Kslot+hi*1024+r32*16;
  #pragma unroll
  for(int d0=0;d0<4;++d0){
    const bf16x8 b0=*reinterpret_cast<const bf16x8*>(kb+d0*2048);
    const bf16x8 b1=*reinterpret_cast<const bf16x8*>(kb+d0*2048+512);
    if(d0==0){p0=__builtin_amdgcn_mfma_f32_32x32x16_bf16(b0,qr[0],negm,0,0,0);p1=__builtin_amdgcn_mfma_f32_32x32x16_bf16(b1,qr[0],negm,0,0,0);}
    else{p0=__builtin_amdgcn_mfma_f32_32x32x16_bf16(b0,qr[d0],p0,0,0,0);p1=__builtin_amdgcn_mfma_f32_32x32x16_bf16(b1,qr[d0],p1,0,0,0);}}
}
typedef __attribute__((address_space(3))) const char* lds_cptr;
typedef short v4i16_t __attribute__((ext_vector_type(4)));
__device__ __forceinline__ void kload8(bf16x8*kf,lds_cptr kp){
  kf[0]=*(const __attribute__((address_space(3))) bf16x8*)(kp);      kf[1]=*(const __attribute__((address_space(3))) bf16x8*)(kp+512);
  kf[2]=*(const __attribute__((address_space(3))) bf16x8*)(kp+2048); kf[3]=*(const __attribute__((address_space(3))) bf16x8*)(kp+2560);
  kf[4]=*(const __attribute__((address_space(3))) bf16x8*)(kp+4096); kf[5]=*(const __attribute__((address_space(3))) bf16x8*)(kp+4608);
  kf[6]=*(const __attribute__((address_space(3))) bf16x8*)(kp+6144); kf[7]=*(const __attribute__((address_space(3))) bf16x8*)(kp+6656);
}
__device__ __forceinline__ void kload2(bf16x8*kf,lds_cptr kp,int j){ kf[2*j]=*(const __attribute__((address_space(3))) bf16x8*)(kp+j*2048); kf[2*j+1]=*(const __attribute__((address_space(3))) bf16x8*)(kp+j*2048+512); }
__device__ __forceinline__ s16x4 vtr(lds_cptr p){ return __builtin_bit_cast(s16x4,__builtin_amdgcn_ds_read_tr16_b64_v4i16((__attribute__((address_space(3))) v4i16_t*)p)); }
__device__ __forceinline__ float rowmax(const f32x16&p0,const f32x16&p1){
  float a=max3f(p0[0],p0[1],p1[0]),b=max3f(p0[2],p0[3],p1[1]);a=max3f(a,p1[2],p1[3]);
  #pragma unroll
  for(int r=4;r<16;r+=4){a=max3f(a,p0[r],p0[r+1]);b=max3f(b,p0[r+2],p0[r+3]);a=max3f(a,p1[r],p1[r+1]);b=max3f(b,p1[r+2],p1[r+3]);}
  const float m=max2f(a,b);
  auto rr=__builtin_amdgcn_permlane32_swap(__float_as_uint(m),__float_as_uint(m),false,false);
  return max2f(__uint_as_float(rr[0]),__uint_as_float(rr[1]));
}
template<int NOB> __device__ __forceinline__ void pv(f32x16*o,int vb,bf16x8 pa0,bf16x8 pa1,bf16x8 pa2,bf16x8 pa3){
  #pragma unroll
  for(int d0=0;d0<NOB;++d0){s16x4 lo[4],hi[4];
    #pragma unroll
    for(int ks=0;ks<4;++ks){
      asm volatile("ds_read_b64_tr_b16 %0,%1 offset:%c2":"=&v"(lo[ks]):"v"(vb),"i"(d0*4096+ks*1024):"memory");
      asm volatile("ds_read_b64_tr_b16 %0,%1 offset:%c2":"=&v"(hi[ks]):"v"(vb),"i"(d0*4096+ks*1024+512):"memory");}
    asm volatile("s_waitcnt lgkmcnt(0)":::"memory");SBAR();
    #define PK(k) (bf16x8){lo[k][0],lo[k][1],lo[k][2],lo[k][3],hi[k][0],hi[k][1],hi[k][2],hi[k][3]}
    o[d0]=__builtin_amdgcn_mfma_f32_32x32x16_bf16(pa0,PK(0),o[d0],0,0,0);
    o[d0]=__builtin_amdgcn_mfma_f32_32x32x16_bf16(pa1,PK(1),o[d0],0,0,0);
    o[d0]=__builtin_amdgcn_mfma_f32_32x32x16_bf16(pa2,PK(2),o[d0],0,0,0);
    o[d0]=__builtin_amdgcn_mfma_f32_32x32x16_bf16(pa3,PK(3),o[d0],0,0,0);
    #undef PK
  }
}

#ifndef ATTN_STORE16
#define ATTN_STORE16(p,v) (*(u32x4*)(p)=(v))
#endif
template<int THRL,int DV> __device__ __forceinline__ void attn_unit(const bf16*Qu,int QP,const bf16*__restrict__ Kh,int KP,const bf16*__restrict__ Vh,int VP,bf16*Ou,int OP,char*shm,int wave_in){
  int tid_; asm volatile("v_mbcnt_lo_u32_b32 %0, -1, 0\n\tv_mbcnt_hi_u32_b32 %0, -1, %0":"=v"(tid_)); tid_+=wave_in*64; const int tid=tid_,lane=tid&63,r32=lane&31,hi=lane>>5; const int wid=__builtin_amdgcn_readfirstlane(tid>>6);
  const bf16*Qw=Qu+(long)(wid*QBLK)*QP;
  constexpr int VS=DV/64, NOB=DV/32;
  const unsigned lds0=(unsigned)(uintptr_t)shm;
  float*wsf=(float*)(shm+LDS_WS)+wid*64;
  const bf16*ksrc=Kh+(long)lane*KP+wid*8;
  const bf16*vsrc=Vh+(long)(16*(wid&3)+(lane>>2))*VP+(wid>>2)*32+(lane&3)*8;
  const unsigned kdst=lds0+LDS_K+wid*1024, vdst=lds0+LDS_V+wid*1024;
  #define DMA_K(t,slot) glds16(ksrc+(long)(t)*KVBLK*KP,(unsigned)__builtin_amdgcn_readfirstlane(kdst+(slot)))
  #define DMA_V(t,slot) do{ glds16(vsrc+(long)(t)*KVBLK*VP,(unsigned)__builtin_amdgcn_readfirstlane(vdst+VS*(slot))); if constexpr(VS==2) glds16(vsrc+(long)(t)*KVBLK*VP+64,(unsigned)__builtin_amdgcn_readfirstlane(vdst+VS*(slot)+8192)); }while(0)
  const int vb0=(int)(lds0+LDS_V)+((lane>>4)&1)*32+(lane&3)*8+(4*hi+((lane&15)>>2))*64;
  const char*Kbase=shm+LDS_K; bf16x8 kf[8];
  const lds_cptr shm3=(lds_cptr)shm; const lds_cptr kp0=shm3+LDS_K+hi*1024+r32*16; const lds_cptr vp0=shm3+LDS_V+((lane>>4)&1)*32+(lane&3)*8+(4*hi+((lane&15)>>2))*64;
  constexpr int NT=SEQ/KVBLK;
  DMA_K(0,0);DMA_V(0,0);DMA_K(1,SLOTB);
  bf16x8 qr[4];
  #pragma unroll
  for(int d0=0;d0<4;++d0)qr[d0]=*reinterpret_cast<const bf16x8*>(&Qw[(long)r32*QP+d0*16+hi*8]);
  float mhat=0.f,l_reg=0.f;f32x16 o[NOB];
  #pragma unroll
  for(int d_=0;d_<NOB;++d_)o[d_]=f32x16{};
  f32x16 negm=f32x16{};asm volatile("":"+v"(negm));
  #define CMASK(P0,P1,t) do{}while(0)
  bool resc=false;
  #define START(P0,P1) do{ const float rm=rowmax(P0,P1); resc=false; \
    { const float dl=rm; mhat=fadd_s(mhat,dl); \
      _Pragma("unroll") for(int r=0;r<16;++r){P0[r]=fsub_s(P0[r],dl);P1[r]=fsub_s(P1[r],dl);} \
      _Pragma("unroll") for(int r=0;r<16;++r)negm[r]=-mhat; asm volatile("":"+v"(negm)); } \
    _Pragma("unroll") for(int r=0;r<16;++r)P0[r]=__builtin_amdgcn_exp2f(P0[r]); }while(0)
  #define RESC() do{ if(resc){ asm volatile("s_waitcnt lgkmcnt(0)":::"memory"); \
      _Pragma("unroll") for(int d_=0;d_<NOB;++d_) _Pragma("unroll") for(int r=0;r<16;++r)o[d_][r]*=wsf[crow(r,hi)]; } }while(0)
  f32x16 pA0,pA1,pB0,pB1;
  int sl_prev=0,sl_cur=0,sl_next=SLOTB;
  #define ROT() do{sl_prev=sl_cur;sl_cur=sl_next;sl_next=(sl_next==(NSLOT-1)*SLOTB)?0:sl_next+SLOTB;}while(0)
  #define WBV(N,N2) do{ if constexpr(VS==2){WAIT_BAR(N2);} else {WAIT_BAR(N);} }while(0)
  DMA_K(2,2*SLOTB);
  WAIT_BAR(3);
  qkt(pA0,pA1,Kbase,qr,negm,r32,hi);asm volatile("s_nop 15\n\ts_nop 7":"+v"(pA0),"+v"(pA1));CMASK(pA0,pA1,0);
  START(pA0,pA1);
  _Pragma("unroll") for(int r=0;r<16;++r)pA1[r]=__builtin_amdgcn_exp2f(pA1[r]);
  WAIT_BAR(0);
  DMA_K(3,0);DMA_V(1,SLOTB);
  ROT();
  kload8(kf,kp0+sl_cur);
  WBV(2,3);
  s16x4 vlo[8],vhi[8]; u32x4 pw0,pw1,pw2,pw3;
  #define PKW(P,B) cvtpk_s(P[B],P[B+1])
  #define PAF(k) __builtin_bit_cast(bf16x8,pw##k)
  #define VFR(i) (bf16x8){vlo[i][0],vlo[i][1],vlo[i][2],vlo[i][3],vhi[i][0],vhi[i][1],vhi[i][2],vhi[i][3]}
  #define PIN(x) asm volatile("":"+v"(x))
  #define MX3(a,b,c) __builtin_fmaxf(__builtin_fmaxf((a),(b)),(c))
  #define GAPA(MF,A0,A1,A2,A3,W0,W1,PW) do{ MF; sacc+=A0; sacc+=A1; sacc+=A2; sacc+=A3; PIN(sacc); W0; W1; PIN(PW); SBAR(); }while(0)
  #define EX(v) __builtin_amdgcn_exp2f(v)
  #define GAPB(MF,X,B) do{ MF; X[B]=EX(X[B]); X[B+1]=EX(X[B+1]); X[B+2]=EX(X[B+2]); X[B+3]=EX(X[B+3]); PIN(X); SBAR(); }while(0)
  #define GAPB2(MF,RD,X,B) do{ MF; RD; X[B]=EX(X[B]); X[B+1]=EX(X[B+1]); PIN(X); SBAR(); }while(0)
  #define VRD2(i) do{ vlo[i]=vtr(vp_+(8192+((i)>>2)*4096+((i)&3)*1024)); vhi[i]=vtr(vp_+(8192+((i)>>2)*4096+((i)&3)*1024+512)); }while(0)
  #define VRD(i) do{ vlo[i]=vtr(vp_+(((i)>>2)*4096+((i)&3)*1024)); vhi[i]=vtr(vp_+(((i)>>2)*4096+((i)&3)*1024+512)); }while(0)
  #define KRD(G,j) do{ if(G){ kload2(kf,kp0+sl_next,j); SBAR(); } }while(0)
  #define STEP(C0,C1,P0,P1,t,GK,GV,GL) do{ SBAR(); \
    const lds_cptr vp_=vp0+VS*sl_prev; \
    VRD(0); SBAR(); float sacc=(P0[0]+P0[1]); \
    GAPA(C0=__builtin_amdgcn_mfma_f32_32x32x16_bf16(kf[0],qr[0],negm,0,0,0), P0[2],P0[3],P0[4],P0[5],     pw0[0]=PKW(P0,0), pw0[1]=PKW(P0,2), pw0); \
    VRD(4); SBAR(); GAPA(C1=__builtin_amdgcn_mfma_f32_32x32x16_bf16(kf[1],qr[0],negm,0,0,0), P0[6],P0[7],P0[8],P0[9],     pw0[2]=PKW(P0,4), pw0[3]=PKW(P0,6), pw0); \
    VRD(1); SBAR(); GAPA(C0=__builtin_amdgcn_mfma_f32_32x32x16_bf16(kf[2],qr[1],C0,0,0,0),   P0[10],P0[11],P0[12],P0[13], pw1[0]=PKW(P0,8), pw1[1]=PKW(P0,10), pw1); \
    VRD(5); SBAR(); GAPA(C1=__builtin_amdgcn_mfma_f32_32x32x16_bf16(kf[3],qr[1],C1,0,0,0),   P0[14],P0[15],P1[0],P1[1],   pw1[2]=PKW(P0,12),pw1[3]=PKW(P0,14), pw1); \
    VRD(2); SBAR(); GAPA(C0=__builtin_amdgcn_mfma_f32_32x32x16_bf16(kf[4],qr[2],C0,0,0,0),   P1[2],P1[3],P1[4],P1[5],     pw2[0]=PKW(P1,0), pw2[1]=PKW(P1,2), pw2); \
    VRD(6); SBAR(); GAPA(C1=__builtin_amdgcn_mfma_f32_32x32x16_bf16(kf[5],qr[2],C1,0,0,0),   P1[6],P1[7],P1[8],P1[9],     pw2[2]=PKW(P1,4), pw2[3]=PKW(P1,6), pw2); \
    VRD(3); SBAR(); GAPA(C0=__builtin_amdgcn_mfma_f32_32x32x16_bf16(kf[6],qr[3],C0,0,0,0),   P1[10],P1[11],P1[12],P1[13], pw3[0]=PKW(P1,8), pw3[1]=PKW(P1,10), pw3); \
    VRD(7); SBAR(); GAPA(C1=__builtin_amdgcn_mfma_f32_32x32x16_bf16(kf[7],qr[3],C1,0,0,0),   P1[14],P1[15],0.f,0.f,       pw3[2]=PKW(P1,12),pw3[3]=PKW(P1,14), pw3); \
    l_reg+=sacc; \
    if(GK){DMA_K((t)+3,sl_cur);} if(GV){DMA_V((t)+1,sl_next);} \
    CMASK(C0,C1,t); \
    { float a=MX3(C0[0],C0[1],C1[0]),b=MX3(C0[2],C0[3],C1[1]); a=MX3(a,C1[2],C1[3]); \
      _Pragma("unroll") for(int r=4;r<16;r+=4){a=MX3(a,C0[r],C0[r+1]);b=MX3(b,C0[r+2],C0[r+3]);a=MX3(a,C1[r],C1[r+1]);b=MX3(b,C1[r+2],C1[r+3]);} \
      float rm=__builtin_fmaxf(a,b); { auto rr=__builtin_amdgcn_permlane32_swap(__float_as_uint(rm),__float_as_uint(rm),false,false); rm=__builtin_fmaxf(__uint_as_float(rr[0]),__uint_as_float(rr[1])); } \
      resc=false; \
      if(__builtin_expect(__any(rm>(float)THRL),0)){ const float dl=__builtin_fmaxf(rm,0.f); mhat+=dl; \
        _Pragma("unroll") for(int r=0;r<16;++r){C0[r]-=dl;C1[r]-=dl;} \
        _Pragma("unroll") for(int r=0;r<16;++r)negm[r]=-mhat; asm volatile("":"+v"(negm)); \
        const float f=__builtin_amdgcn_exp2f(-dl); l_reg*=f; if(hi==0)wsf[r32]=f; resc=true; } } \
    SBAR(); \
    if constexpr(VS==1){ \
    GAPB(o[0]=__builtin_amdgcn_mfma_f32_32x32x16_bf16(PAF(0),VFR(0),o[0],0,0,0), C0,0); \
    GAPB(o[1]=__builtin_amdgcn_mfma_f32_32x32x16_bf16(PAF(0),VFR(4),o[1],0,0,0), C0,4); \
    KRD(GL,0); GAPB(o[0]=__builtin_amdgcn_mfma_f32_32x32x16_bf16(PAF(1),VFR(1),o[0],0,0,0), C0,8); \
    KRD(GL,1); GAPB(o[1]=__builtin_amdgcn_mfma_f32_32x32x16_bf16(PAF(1),VFR(5),o[1],0,0,0), C0,12); \
    KRD(GL,2); GAPB(o[0]=__builtin_amdgcn_mfma_f32_32x32x16_bf16(PAF(2),VFR(2),o[0],0,0,0), C1,0); \
    KRD(GL,3); GAPB(o[1]=__builtin_amdgcn_mfma_f32_32x32x16_bf16(PAF(2),VFR(6),o[1],0,0,0), C1,4); \
    GAPB(o[0]=__builtin_amdgcn_mfma_f32_32x32x16_bf16(PAF(3),VFR(3),o[0],0,0,0), C1,8); \
    GAPB(o[1]=__builtin_amdgcn_mfma_f32_32x32x16_bf16(PAF(3),VFR(7),o[1],0,0,0), C1,12); \
    } else { \
    GAPB2(o[0]=__builtin_amdgcn_mfma_f32_32x32x16_bf16(PAF(0),VFR(0),o[0],0,0,0), VRD2(0), C0,0); \
    GAPB2(o[1]=__builtin_amdgcn_mfma_f32_32x32x16_bf16(PAF(0),VFR(4),o[1],0,0,0), VRD2(4), C0,2); \
    GAPB2(o[0]=__builtin_amdgcn_mfma_f32_32x32x16_bf16(PAF(1),VFR(1),o[0],0,0,0), VRD2(1), C0,4); \
    GAPB2(o[1]=__builtin_amdgcn_mfma_f32_32x32x16_bf16(PAF(1),VFR(5),o[1],0,0,0), VRD2(5), C0,6); \
    GAPB2(o[0]=__builtin_amdgcn_mfma_f32_32x32x16_bf16(PAF(2),VFR(2),o[0],0,0,0), VRD2(2), C0,8); \
    GAPB2(o[1]=__builtin_amdgcn_mfma_f32_32x32x16_bf16(PAF(2),VFR(6),o[1],0,0,0), VRD2(6), C0,10); \
    GAPB2(o[0]=__builtin_amdgcn_mfma_f32_32x32x16_bf16(PAF(3),VFR(3),o[0],0,0,0), VRD2(3), C0,12); \
    GAPB2(o[1]=__builtin_amdgcn_mfma_f32_32x32x16_bf16(PAF(3),VFR(7),o[1],0,0,0), VRD2(7), C0,14); \
    GAPB2(o[2]=__builtin_amdgcn_mfma_f32_32x32x16_bf16(PAF(0),VFR(0),o[2],0,0,0), (void)0, C1,0); \
    GAPB2(o[3]=__builtin_amdgcn_mfma_f32_32x32x16_bf16(PAF(0),VFR(4),o[3],0,0,0), (void)0, C1,2); \
    KRD(GL,0); GAPB2(o[2]=__builtin_amdgcn_mfma_f32_32x32x16_bf16(PAF(1),VFR(1),o[2],0,0,0), (void)0, C1,4); \
    KRD(GL,1); GAPB2(o[3]=__builtin_amdgcn_mfma_f32_32x32x16_bf16(PAF(1),VFR(5),o[3],0,0,0), (void)0, C1,6); \
    KRD(GL,2); GAPB2(o[2]=__builtin_amdgcn_mfma_f32_32x32x16_bf16(PAF(2),VFR(2),o[2],0,0,0), (void)0, C1,8); \
    KRD(GL,3); GAPB2(o[3]=__builtin_amdgcn_mfma_f32_32x32x16_bf16(PAF(2),VFR(6),o[3],0,0,0), (void)0, C1,10); \
    GAPB2(o[2]=__builtin_amdgcn_mfma_f32_32x32x16_bf16(PAF(3),VFR(3),o[2],0,0,0), (void)0, C1,12); \
    GAPB2(o[3]=__builtin_amdgcn_mfma_f32_32x32x16_bf16(PAF(3),VFR(7),o[3],0,0,0), (void)0, C1,14); \
    } \
    }while(0)
  int t=1;
  for(;t+5<NT;t+=2){
    STEP(pB0,pB1,pA0,pA1,t,true,true,true);     WBV(2,3); RESC(); ROT();
    STEP(pA0,pA1,pB0,pB1,t+1,true,true,true);   WBV(2,3); RESC(); ROT();
  }
  #define ENDW(tt) do{ if((tt)+3<NT){WBV(2,3);} else if((tt)+2<NT){WBV(1,2);} else {WAIT_BAR(0);} }while(0)
  for(;t+1<NT;t+=2){
    STEP(pB0,pB1,pA0,pA1,t,(t+3<NT),(t+1<NT),(t+1<NT));       ENDW(t);   RESC(); ROT();
    STEP(pA0,pA1,pB0,pB1,t+1,(t+4<NT),(t+2<NT),(t+2<NT));     ENDW(t+1); RESC(); ROT();
  }
  STEP(pB0,pB1,pA0,pA1,NT-1,false,false,false); RESC();
  { float sacc=pB0[0]+pB0[1]; _Pragma("unroll") for(int r=2;r<16;++r)sacc+=pB0[r]; _Pragma("unroll") for(int r=0;r<16;++r)sacc+=pB1[r]; l_reg+=sacc;
    pw0=(u32x4){PKW(pB0,0),PKW(pB0,2),PKW(pB0,4),PKW(pB0,6)};pw1=(u32x4){PKW(pB0,8),PKW(pB0,10),PKW(pB0,12),PKW(pB0,14)};pw2=(u32x4){PKW(pB1,0),PKW(pB1,2),PKW(pB1,4),PKW(pB1,6)};pw3=(u32x4){PKW(pB1,8),PKW(pB1,10),PKW(pB1,12),PKW(pB1,14)};
    SBAR(); pv<NOB>(o,vb0+VS*sl_cur,PAF(0),PAF(1),PAF(2),PAF(3)); }
  #undef PKW
  #undef PAF
  #undef VFR
  #undef PIN
  #undef MX3
  #undef GAPA
  #undef GAPB
  #undef GAPB2
  #undef VRD2
  #undef WBV
  #undef EX
  #undef VRD
  #undef KRD
  #undef STEP
  #undef ENDW
  {auto rr=__builtin_amdgcn_permlane32_swap(__float_as_uint(l_reg),__float_as_uint(l_reg),false,false);l_reg=__uint_as_float(rr[0])+__uint_as_float(rr[1]);}
  if(hi==0)wsf[32+r32]=l_reg;asm volatile("s_waitcnt lgkmcnt(0)":::"memory");
  float rli[16];
  #pragma unroll
  for(int r=0;r<16;++r)rli[r]=__builtin_amdgcn_rcpf(wsf[32+crow(r,hi)]);
  bf16*Ow=Ou+(long)(wid*QBLK)*OP;
  { bf16*stg=(bf16*)(shm+LDS_OST)+wid*2048;
    #pragma unroll
    for(int ps=0;ps<VS;++ps){
    #pragma unroll
    for(int r=0;r<16;++r){const int orow=crow(r,hi);
      #pragma unroll
      for(int d0=0;d0<2;++d0)stg[orow*64+d0*32+r32]=__float2bfloat16(o[2*ps+d0][r]*rli[r]);}
    asm volatile("s_waitcnt lgkmcnt(0)":::"memory");
    #pragma unroll
    for(int i=0;i<4;++i){const int row=i*8+(lane>>3),ch=lane&7; const u32x4 v=*(const u32x4*)(stg+row*64+ch*8); ATTN_STORE16(Ow+(long)row*OP+ps*64+ch*8,v);}
    asm volatile("s_waitcnt lgkmcnt(0)":::"memory"); } }
  asm volatile("s_waitcnt lgkmcnt(0)\n\ts_barrier":::"memory");
  #undef DMA_K
  #undef DMA_V
  #undef CMASK
  #undef START
  #undef RESC
  #undef ROT
}
constexpr float V8SCALE=8.f, P8BIAS=2.f;
template<int DV> __device__ __forceinline__ void attn_unit8(const bf16*Qu,int QP,const bf16*__restrict__ Kh,int KP,const unsigned char*__restrict__ Vt,bf16*Ou,int OP,char*shm,int wave_in){
  int tid_; asm volatile("v_mbcnt_lo_u32_b32 %0, -1, 0\n\tv_mbcnt_hi_u32_b32 %0, -1, %0":"=v"(tid_)); tid_+=wave_in*64; const int tid=tid_,lane=tid&63,r32=lane&31,hi=lane>>5; const int wid=__builtin_amdgcn_readfirstlane(tid>>6);
  const bf16*Qw=Qu+(long)(wid*QBLK)*QP;
  constexpr int VS=DV/64, NOB=DV/32;
  const unsigned lds0=(unsigned)(uintptr_t)shm;
  constexpr int NKS=4, L8_K=0, L8_V=NKS*SLOTB, L8_WS=L8_V+4*8192, L8_OST=L8_WS+NW*64*4;
  static_assert(L8_OST+NW*4096<=131072,"attn_unit8 LDS");
  float*wsf=(float*)(shm+L8_WS)+wid*64;
  const bf16*ksrc=Kh+(long)lane*KP+wid*8;
  const int vgrp=(DV==128)?(wid>>2):0;
  const unsigned char*vsrc=Vt+(64*vgrp+lane)*64+(wid&3)*16;
  const unsigned kdst=lds0+L8_K+wid*1024, vdst=lds0+L8_V+(wid&3)*(DV*16)+vgrp*1024;
  #define DMA_K(t,slot) glds16(ksrc+(long)(t)*KVBLK*KP,(unsigned)__builtin_amdgcn_readfirstlane(kdst+(slot)))
  #define VSL(t) ((((t))&3)*8192)
  #define DMA_V(t) glds16(vsrc+(long)(t)*(DV*64),(unsigned)__builtin_amdgcn_readfirstlane(vdst+VSL(t)))
  const char*Kbase=shm+L8_K; bf16x8 kf[8];
  const lds_cptr shm3=(lds_cptr)shm; const lds_cptr kp0=shm3+L8_K+hi*1024+r32*16; const lds_cptr vp0=shm3+L8_V+(2*hi)*(DV*16)+r32*16;
  constexpr int NT=SEQ/KVBLK;
  DMA_K(0,0);DMA_V(0);DMA_K(1,SLOTB);
  bf16x8 qr[4];
  #pragma unroll
  for(int d0=0;d0<4;++d0)qr[d0]=*reinterpret_cast<const bf16x8*>(&Qw[(long)r32*QP+d0*16+hi*8]);
  float mhat=0.f,l_reg=0.f;f32x16 o[NOB];
  #pragma unroll
  for(int d_=0;d_<NOB;++d_)o[d_]=f32x16{};
  f32x16 negm=f32x16{};asm volatile("":"+v"(negm));
  typedef int i32x8_t __attribute__((ext_vector_type(8))); i32x8_t v8[NOB]; i32x8_t p8={0,0,0,0,0,0,0,0}; const int one8=0x7f7f7f7f; f32x16 osum=f32x16{}; i32x8_t ones8={0x38383838,0x38383838,0x38383838,0x38383838,0x38383838,0x38383838,0x38383838,0x38383838}; if constexpr(NOB==2) asm volatile("":"+v"(ones8));
  typedef int i32x4_t __attribute__((ext_vector_type(4)));
  #define PK8(g,P,B) do{ int w_=p8[g]; w_=__builtin_amdgcn_cvt_pk_fp8_f32(P[B],P[(B)+1],w_,false); w_=__builtin_amdgcn_cvt_pk_fp8_f32(P[(B)+2],P[(B)+3],w_,true); p8[g]=w_; }while(0)
  #define PS8() asm volatile("v_mfma_scale_f32_32x32x64_f8f6f4 %0, %1, %2, %0, %3, %3 op_sel_hi:[0,0,0]":"+v"(osum):"v"(p8),"v"(ones8),"v"(one8))
  #define PV8(db) asm volatile("v_mfma_scale_f32_32x32x64_f8f6f4 %0, %1, %2, %0, %3, %3 op_sel_hi:[0,0,0]":"+v"(o[db]):"v"(p8),"v"(v8[db]),"v"(one8))
  #define VRD8(db) do{ const i32x4_t lo_=*(const __attribute__((address_space(3))) i32x4_t*)(vp_+(db)*512), hi_=*(const __attribute__((address_space(3))) i32x4_t*)(vp_+(db)*512+DV*16); v8[db]=__builtin_shufflevector(lo_,hi_,0,1,2,3,4,5,6,7); }while(0)
  #define MX3(a,b,c) __builtin_fmaxf(__builtin_fmaxf((a),(b)),(c))
  #define MF(A,B,C) __builtin_amdgcn_mfma_f32_32x32x16_bf16(A,B,C,0,0,0)
  #define WAIT_Y() asm volatile("s_waitcnt lgkmcnt(0)\n\ts_barrier":::"memory")
  DMA_K(2,2*SLOTB);DMA_K(3,3*SLOTB);
  WAIT_BAR(4);
  f32x16 C0,C1;
  qkt(C0,C1,Kbase,qr,negm,r32,hi);asm volatile("s_nop 15\n\ts_nop 7":"+v"(C0),"+v"(C1));
  { const float rm=rowmax(C0,C1); const float dl=rm-P8BIAS; mhat=fadd_s(mhat,dl);
    _Pragma("unroll") for(int r=0;r<16;++r){C0[r]=fsub_s(C0[r],dl);C1[r]=fsub_s(C1[r],dl);}
    _Pragma("unroll") for(int r=0;r<16;++r)negm[r]=-mhat; asm volatile("":"+v"(negm));
    _Pragma("unroll") for(int r=0;r<16;++r){C0[r]=__builtin_amdgcn_exp2f(C0[r]);C1[r]=__builtin_amdgcn_exp2f(C1[r]);}
    if constexpr(NOB==4){ float sacc=C0[0]+C0[1]; _Pragma("unroll") for(int r=2;r<16;++r)sacc+=C0[r]; _Pragma("unroll") for(int r=0;r<16;++r)sacc+=C1[r]; l_reg=sacc; }
    PK8(0,C0,0);PK8(1,C0,4);PK8(2,C0,8);PK8(3,C0,12);PK8(4,C1,0);PK8(5,C1,4);PK8(6,C1,8);PK8(7,C1,12); }
  WAIT_BAR(0);
  DMA_V(1);DMA_K(4,0);DMA_V(2);
  int sl_cur=SLOTB,sl_next=2*SLOTB;
  kload8(kf,kp0+sl_cur);
  WAIT_BAR(3);
  if(wid>=4) asm volatile("s_barrier":::"memory");
  #pragma nounroll
  for(int t=1;t<NT;++t){
    SBAR();
    __builtin_amdgcn_s_setprio(1);
    { const lds_cptr vp_=vp0+VSL(t-1);
      _Pragma("unroll") for(int db=0;db<NOB;++db)VRD8(db); }
    SBAR();
    C0=MF(kf[0],qr[0],negm); asm volatile("":"+v"(C0)); C1=MF(kf[1],qr[0],negm); asm volatile("":"+v"(C1)); SBAR(); kload2(kf,kp0+sl_next,0); SBAR();
    C0=MF(kf[2],qr[1],C0); asm volatile("":"+v"(C0)); C1=MF(kf[3],qr[1],C1); asm volatile("":"+v"(C1)); SBAR(); kload2(kf,kp0+sl_next,1); SBAR();
    C0=MF(kf[4],qr[2],C0); asm volatile("":"+v"(C0)); C1=MF(kf[5],qr[2],C1); asm volatile("":"+v"(C1)); SBAR(); kload2(kf,kp0+sl_next,2); SBAR();
    C0=MF(kf[6],qr[3],C0); asm volatile("":"+v"(C0)); C1=MF(kf[7],qr[3],C1); asm volatile("":"+v"(C1)); SBAR(); kload2(kf,kp0+sl_next,3); SBAR();
    if constexpr(NOB==2){ PS8(); SBAR(); if(t+4<NT){DMA_K(t+4,sl_cur);} SBAR(); PV8(0); SBAR(); if(t+2<NT){DMA_V(t+2);} SBAR(); PV8(1); }
    else { PV8(0); SBAR(); if(t+4<NT){DMA_K(t+4,sl_cur);} SBAR(); PV8(1); SBAR(); if(t+2<NT){DMA_V(t+2);} SBAR(); PV8(2); PV8(3); }
    __builtin_amdgcn_s_setprio(0);
    SBAR();
    if(t+4<NT){WAIT_BAR(4);} else {WAIT_BAR(0);}
    SBAR();
    _Pragma("unroll") for(int db=0;db<NOB;++db) asm volatile(""::"v"(v8[db]),"v"(p8));
    asm volatile("":"+v"(C0),"+v"(C1));
    { float a=MX3(C0[0],C0[1],C1[0]),b=MX3(C0[2],C0[3],C1[1]); a=MX3(a,C1[2],C1[3]);
      _Pragma("unroll") for(int r=4;r<16;r+=4){a=MX3(a,C0[r],C0[r+1]);b=MX3(b,C0[r+2],C0[r+3]);a=MX3(a,C1[r],C1[r+1]);b=MX3(b,C1[r+2],C1[r+3]);}
      float rm=__builtin_fmaxf(a,b); { auto rr=__builtin_amdgcn_permlane32_swap(__float_as_uint(rm),__float_as_uint(rm),false,false); rm=__builtin_fmaxf(__uint_as_float(rr[0]),__uint_as_float(rr[1])); }
      if(__builtin_expect(__any(rm>8.0f),0)){ const float dl=__builtin_fmaxf(rm-P8BIAS,0.f); mhat+=dl;
        _Pragma("unroll") for(int r=0;r<16;++r){C0[r]-=dl;C1[r]-=dl;}
        _Pragma("unroll") for(int r=0;r<16;++r)negm[r]=-mhat; asm volatile("":"+v"(negm));
        const float f=__builtin_amdgcn_exp2f(-dl); l_reg*=f; if(hi==0)wsf[r32]=f;
        asm volatile("s_nop 15\n\ts_nop 15\n\ts_nop 15\n\ts_nop 15\n\ts_nop 15\n\ts_nop 15\n\ts_waitcnt lgkmcnt(0)":::"memory");
        _Pragma("unroll") for(int d_=0;d_<NOB;++d_) _Pragma("unroll") for(int r=0;r<16;++r)o[d_][r]*=wsf[crow(r,hi)];
        if constexpr(NOB==2){ _Pragma("unroll") for(int r=0;r<16;++r)osum[r]*=wsf[crow(r,hi)]; } } }
    _Pragma("unroll") for(int r=0;r<16;++r){C0[r]=__builtin_amdgcn_exp2f(C0[r]);C1[r]=__builtin_amdgcn_exp2f(C1[r]);}
    if constexpr(NOB==4){ float sacc=C0[0]+C0[1]; _Pragma("unroll") for(int r=2;r<16;++r)sacc+=C0[r]; _Pragma("unroll") for(int r=0;r<16;++r)sacc+=C1[r]; l_reg+=sacc; }
    PK8(0,C0,0);PK8(1,C0,4);PK8(2,C0,8);PK8(3,C0,12);PK8(4,C1,0);PK8(5,C1,4);PK8(6,C1,8);PK8(7,C1,12);
    asm volatile("":"+v"(p8)); asm volatile("":"+v"(l_reg));
    SBAR();
    WAIT_Y();
    SBAR();
    sl_cur=sl_next; sl_next=(sl_next==(NKS-1)*SLOTB)?0:sl_next+SLOTB;
  }
  if(wid<4) asm volatile("s_barrier":::"memory");
  { SBAR(); { const lds_cptr vp_=vp0+VSL(NT-1);
      #pragma unroll
      for(int db=0;db<NOB;++db)VRD8(db);
      if constexpr(NOB==2) PS8();
      #pragma unroll
      for(int db=0;db<NOB;++db)PV8(db);
      asm volatile("s_nop 15\n\ts_nop 15\n\ts_nop 15\n\ts_nop 15\n\ts_nop 15\n\ts_nop 15\n\ts_nop 15\n\ts_nop 15\n\ts_nop 15\n\ts_nop 15":::"memory");
      #pragma unroll
      for(int db=0;db<NOB;++db) asm volatile("":"+v"(o[db]):"v"(v8[db]),"v"(p8));
      if constexpr(NOB==2) asm volatile("":"+v"(osum):"v"(ones8),"v"(p8)); } }
  #undef PK8
  #undef PV8
  #undef PS8
  #undef VRD8
  #undef MX3
  #undef MF
  #undef WAIT_Y
  float rli[16];
  if constexpr(NOB==2){
    #pragma unroll
    for(int r=0;r<16;++r)rli[r]=__builtin_amdgcn_rcpf(osum[r])*(1.0f/V8SCALE);
  } else {
    {auto rr=__builtin_amdgcn_permlane32_swap(__float_as_uint(l_reg),__float_as_uint(l_reg),false,false);l_reg=__uint_as_float(rr[0])+__uint_as_float(rr[1]);}
    if(hi==0)wsf[32+r32]=l_reg;asm volatile("s_waitcnt lgkmcnt(0)":::"memory");
    #pragma unroll
    for(int r=0;r<16;++r)rli[r]=__builtin_amdgcn_rcpf(wsf[32+crow(r,hi)])*(1.0f/V8SCALE);
  }
  bf16*Ow=Ou+(long)(wid*QBLK)*OP;
  { bf16*stg=(bf16*)(shm+L8_OST)+wid*2048;
    #pragma unroll
    for(int ps=0;ps<VS;++ps){
    #pragma unroll
    for(int r=0;r<16;++r){const int orow=crow(r,hi);
      #pragma unroll
      for(int d0=0;d0<2;++d0)stg[orow*64+d0*32+r32]=__float2bfloat16(o[2*ps+d0][r]*rli[r]);}
    asm volatile("s_waitcnt lgkmcnt(0)":::"memory");
    #pragma unroll
    for(int i=0;i<4;++i){const int row=i*8+(lane>>3),ch=lane&7; const u32x4 v=*(const u32x4*)(stg+row*64+ch*8); ATTN_STORE16(Ow+(long)row*OP+ps*64+ch*8,v);}
    asm volatile("s_waitcnt lgkmcnt(0)":::"memory"); } }
  asm volatile("s_waitcnt lgkmcnt(0)\n\ts_barrier":::"memory");
  #undef DMA_K
  #undef DMA_V
  #undef VSL
}

constexpr int ATTN_LDS_BYTES=LDS_BYTES;
#undef SBAR
#undef WAIT_BAR
}
constexpr int NWAVES = 8;
constexpr int NTOK = 65536, SEQL = 8192, DM = 1024, INW = 2304, DFF = 3584, NEXP = 8, NLAYER = 2;
constexpr float EPS = 1e-6f;
constexpr size_t MiB = 1u << 20;
constexpr size_t WS_CTL = 0, CTL_ZERO_BYTES = 128 * 1024;
constexpr size_t WS_WIN = 1 * MiB;
constexpr size_t WS_WOUT = 10 * MiB;
constexpr size_t WS_WGU_D = 14 * MiB;
constexpr size_t WS_WDN_D = 28 * MiB;
constexpr size_t WS_WGU_M = 35 * MiB;
constexpr size_t WS_WDN_M = 91 * MiB;
constexpr size_t WS_HN = 203 * MiB;
constexpr size_t WS_QA = 331 * MiB, WS_QB = 395 * MiB, WS_KA = 459 * MiB, WS_VA = 475 * MiB, WS_KB = 491 * MiB, WS_VB = 555 * MiB;
constexpr size_t WS_OA = 619 * MiB, WS_OB = 683 * MiB;
constexpr size_t WS_AO = 331 * MiB;
constexpr size_t WS_MIX = 491 * MiB;
constexpr size_t WS_XS = 331 * MiB;
constexpr size_t WS_YS = 463 * MiB;
constexpr size_t WS_ACT8 = 727 * MiB;
constexpr float A8SCALE = 16.f, W8SCALE = 256.f, H8SCALE = 8.f;
constexpr size_t WS_ACT = 595 * MiB;
constexpr size_t WS_F = 819 * MiB;
constexpr size_t WS_VT8 = WS_F;
constexpr size_t WS_TOK = 947 * MiB;
constexpr size_t WS_WGB = 948 * MiB;
constexpr size_t WS_END = 949 * MiB;
#ifndef PROJ_I8
#define PROJ_I8 1
#endif
#define PROJ_I8_IN ((PROJ_I8 & 1) != 0)
#define PROJ_I8_OUT ((PROJ_I8 & 2) != 0)
#ifndef DENSE_I8
#define DENSE_I8 1
#endif
#ifndef DENSE_F8
#define DENSE_F8 0
#endif
constexpr int CHUNK_TILES = 128;
constexpr int CW_TMO = 0, CW_CODE = 1, CW_BAR = 4096, CW_CNT = 8192, CW_CMAX = 9000;
constexpr int CW_CMAX_IN = 16384, CW_CMAX_OUT = 21000;
constexpr size_t WS_SWIN = WS_WIN + 5 * MiB, WS_SWOUT = WS_WOUT + 3 * MiB;
constexpr size_t WS_SA2 = WS_AO + 64 * MiB;
constexpr size_t WS_SWGU = WS_WGU_D + 8 * MiB;
constexpr size_t WS_SA = WS_HN + 64 * MiB;
constexpr int RING_OFF = 0, RING_BYTES = 131072;
constexpr int LDSCTL_OFF = RING_BYTES, MISC_OFF = LDSCTL_OFF + 320;
constexpr int LDS_BYTES = 147456;
#define GAS __attribute__((address_space(1)))
#define LAS __attribute__((address_space(3)))
typedef unsigned short bf16;
typedef unsigned v4u __attribute__((ext_vector_type(4)));
typedef float f32x4 __attribute__((ext_vector_type(4)));
typedef short bf16x8 __attribute__((ext_vector_type(8)));
typedef GAS unsigned gu32;
typedef GAS unsigned long long gu64;
#define RLX_AGENT __ATOMIC_RELAXED, __HIP_MEMORY_SCOPE_AGENT
#define LDS_WAIT() asm volatile("s_waitcnt lgkmcnt(0)" ::: "memory")
#define VM_WAIT() asm volatile("s_waitcnt vmcnt(0)" ::: "memory")
__device__ __forceinline__ unsigned long long rt() { return __builtin_amdgcn_s_memrealtime(); }
__device__ __forceinline__ unsigned f2bf(float f) { unsigned u = __builtin_bit_cast(unsigned, f); return (u + 0x7fffu + ((u >> 16) & 1u)) >> 16; }
__device__ __forceinline__ unsigned pk2(float lo, float hi) { return f2bf(lo) | (f2bf(hi) << 16); }

#define XB_TMO      128
#define XB_XCNT(j)  (256  + 64 * (j))
#define XB_XSUB(j)  (1280 + 64 * (j))
#define XB_XGEN(j)  (2304 + 64 * (j))
#define XB_TOP      3328
#define XB_TOPGEN   3392
#define XCD_BAR_WORDS 3456
#define XB_SPIN_CAP (1u << 18)

__device__ __forceinline__ unsigned xb_ld(unsigned* p)              { return __hip_atomic_load(p, __ATOMIC_RELAXED, __HIP_MEMORY_SCOPE_AGENT); }
__device__ __forceinline__ unsigned xb_add(unsigned* p, unsigned v) { return __hip_atomic_fetch_add(p, v, __ATOMIC_RELAXED, __HIP_MEMORY_SCOPE_AGENT); }
__device__ __forceinline__ unsigned xb_xcc_id() { return (unsigned)__builtin_amdgcn_s_getreg((3 << 11) | 20) & 0xFu; }
#define XB_SPIN(cond, bar) do { unsigned _sp = 0; while (cond) { __builtin_amdgcn_s_sleep(1); \
    if ((++_sp & 255u) == 0u) { if (xb_ld(&(bar)[XB_TMO])) break; if (_sp > XB_SPIN_CAP) { atomicAdd(&(bar)[XB_TMO], 1u); break; } } } } while (0)

struct XcdBarrier {
    unsigned* bar; unsigned x;
    volatile LAS unsigned* st;
};

__device__ __forceinline__ XcdBarrier xcd_barrier_post(unsigned* bar, volatile LAS unsigned* st) {
    XcdBarrier b; b.bar = bar; b.x = xb_xcc_id(); b.st = st;
    if (threadIdx.x == 0) (void)xb_add(&bar[XB_XCNT(b.x)], 1u);
    return b;
}
__device__ __forceinline__ void xcd_barrier_complete(unsigned* bar, unsigned x, unsigned& nloc, unsigned& nx) {
    const unsigned G = gridDim.x * gridDim.y * gridDim.z;
    unsigned sum, cnt, mine, sp = 0u;
    for (;;) {
        sum = 0u; cnt = 0u; mine = 0u;
#pragma unroll
        for (unsigned j = 0; j < 16; ++j) { const unsigned c = xb_ld(&bar[XB_XCNT(j)]); sum += c; cnt += (c > 0u) ? 1u : 0u; mine = (j == x) ? c : mine; }
        if (sum == G) break;
        __builtin_amdgcn_s_sleep(1);
        if ((++sp & 255u) == 0u) { if (xb_ld(&bar[XB_TMO])) break; if (sp > XB_SPIN_CAP) { atomicAdd(&bar[XB_TMO], 1u); break; } }
    }
    nloc = mine > 0u ? mine : 1u; nx = cnt > 0u ? cnt : 1u;
}

__device__ __forceinline__ void xcd_barrier(const XcdBarrier& b) {
    asm volatile("s_waitcnt vmcnt(0)" ::: "memory");
    __syncthreads();
    if (threadIdx.x == 0) {
        unsigned* bar = b.bar;
        __builtin_amdgcn_s_waitcnt(0);
        unsigned nloc = b.st[0], nx = b.st[1];
        if (nloc == 0u) { xcd_barrier_complete(bar, b.x, nloc, nx); b.st[0] = nloc; b.st[1] = nx; }
        const unsigned old = xb_add(&bar[XB_XSUB(b.x)], 1u);
        const unsigned gen = old / nloc;
        if (old + 1u == (gen + 1u) * nloc) {
            __builtin_amdgcn_fence(__ATOMIC_RELEASE, "agent");
            asm volatile("s_waitcnt vmcnt(0)" ::: "memory");
            const unsigned og = xb_add(&bar[XB_TOP], 1u);
            const unsigned tg = og / nx;
            if (og + 1u == (tg + 1u) * nx) xb_add(&bar[XB_TOPGEN], 1u);
            else XB_SPIN(xb_ld(&bar[XB_TOPGEN]) == tg, bar);
            __builtin_amdgcn_fence(__ATOMIC_ACQUIRE, "agent");
            xb_add(&bar[XB_XGEN(b.x)], 1u);
            asm volatile("s_waitcnt vmcnt(0)" ::: "memory");
        } else {
            XB_SPIN(xb_ld(&bar[XB_XGEN(b.x)]) == gen, bar);
            __builtin_amdgcn_fence(__ATOMIC_ACQUIRE, "agent");
            asm volatile("s_waitcnt vmcnt(0)" ::: "memory");
        }
    }
    __syncthreads();
}
typedef unsigned u32x2 __attribute__((ext_vector_type(2)));
__device__ __forceinline__ float wave_sum(float v) {
#pragma unroll
    for (int o = 1; o < 64; o <<= 1) v += __shfl_xor(v, o);
    return v;
}
__device__ __forceinline__ unsigned cvtpk(float lo, float hi) { return pg8::cvt_pk_bf16(lo, hi); }
__device__ __forceinline__ f32x4 unpack4(u32x2 w) { return (f32x4){__uint_as_float(w.x << 16), __uint_as_float(w.x & 0xffff0000u), __uint_as_float(w.y << 16), __uint_as_float(w.y & 0xffff0000u)}; }
__device__ __forceinline__ u32x2 pack4(f32x4 v) { u32x2 r; r.x = cvtpk(v[0], v[1]); r.y = cvtpk(v[2], v[3]); return r; }
__device__ __forceinline__ float sumsq4(f32x4 v) { return (v[0] * v[0] + v[1] * v[1]) + (v[2] * v[2] + v[3] * v[3]); }
__device__ __forceinline__ void ld_row_f32(const float* row, int lane, f32x4 (&v)[4]) {
#pragma unroll
    for (int j = 0; j < 4; ++j) v[j] = *(const GAS f32x4*)(row + 4 * lane + 256 * j);
}
__device__ __forceinline__ void st_row_f32(float* row, int lane, const f32x4 (&v)[4]) {
#pragma unroll
    for (int j = 0; j < 4; ++j) *(GAS f32x4*)(row + 4 * lane + 256 * j) = v[j];
}
__device__ __forceinline__ void ld_row_bf16(const bf16* row, int lane, f32x4 (&v)[4]) {
#pragma unroll
    for (int j = 0; j < 4; ++j) v[j] = unpack4(*(const GAS u32x2*)(row + 4 * lane + 256 * j));
}
__device__ __forceinline__ void st_row_bf16(bf16* row, int lane, const f32x4 (&v)[4]) {
#pragma unroll
    for (int j = 0; j < 4; ++j) *(GAS u32x2*)(row + 4 * lane + 256 * j) = pack4(v[j]);
}
__device__ __forceinline__ float rms_scale(const f32x4 (&v)[4]) {
    const float s = wave_sum((sumsq4(v[0]) + sumsq4(v[1])) + (sumsq4(v[2]) + sumsq4(v[3])));
    return 1.0f / sqrtf(s * (1.0f / DM) + EPS);
}

__device__ __forceinline__ int tau_in(int c) {
    int tile, wc, d, isv;
    if (c < 512) { const int hq = c >> 6; tile = hq >> 2; wc = hq & 3; isv = 0; }
    else if (c < 640) { tile = 2; wc = (c - 512) >> 6; isv = 0; }
    else if (c < 768) { tile = 2; wc = 2 + ((c - 640) >> 6); isv = 1; }
    else if (c < 1280) { const int j = (c - 768) >> 6; tile = 3 + (j >> 2); wc = j & 3; isv = 0; }
    else if (c < 1792) { const int j = (c - 1280) >> 6; tile = 5 + (j >> 2); wc = j & 3; isv = 0; }
    else { const int j = (c - 1792) >> 6; tile = 7 + (j >> 2); wc = j & 3; isv = 1; }
    d = c & 63;
    const int slot = isv ? (128 * ((d >> 3) & 1) + 32 * wc + 16 * ((d >> 2) & 1) + 4 * (d >> 4) + (d & 3)) : (128 * (d >> 5) + 32 * wc + (d & 31));
    return 256 * tile + slot;
}
__device__ __forceinline__ void conv_item(const float* W, int K, int N, bf16* WT, int mode, LAS float* scr, int item, int lane) {
    const int nblk = N / 32, kb = item / nblk, nb = item % nblk, k0 = 64 * kb, n0 = 32 * nb;
#pragma unroll 8
    for (int i = 0; i < 32; ++i) { const int kk = 2 * i + (lane >> 5); scr[kk * 33 + (lane & 31)] = W[(size_t)(k0 + kk) * N + n0 + (lane & 31)]; }
    LDS_WAIT(); asm volatile("" ::: "memory");
    const int c = lane & 7;
#pragma unroll
    for (int j = 0; j < 4; ++j) { const int n = (lane >> 3) + 8 * j; const LAS float* s = scr + (8 * c) * 33 + n; const int sn = n0 + n;
        const int dr = mode == 0 ? sn : mode == 1 ? tau_in(sn) : (256 * (sn >> 7) + (sn & 127) + (mode == 3 ? 128 : 0));
        v4u o; o.x = cvtpk(s[0 * 33], s[1 * 33]); o.y = cvtpk(s[2 * 33], s[3 * 33]); o.z = cvtpk(s[4 * 33], s[5 * 33]); o.w = cvtpk(s[6 * 33], s[7 * 33]);
        *(GAS v4u*)(WT + (size_t)dr * K + k0 + 8 * c) = o; }
    LDS_WAIT(); asm volatile("" ::: "memory");
}
__device__ __forceinline__ void conv_item8(const float* W, int K, int N, unsigned char* WT, int mode, float scale, LAS float* scr, int item, int lane) {
    const int nblk = N / 32, kb = item / nblk, nb = item % nblk, k0 = 64 * kb, n0 = 32 * nb;
#pragma unroll 8
    for (int i = 0; i < 32; ++i) { const int kk = 2 * i + (lane >> 5); scr[kk * 33 + (lane & 31)] = W[(size_t)(k0 + kk) * N + n0 + (lane & 31)]; }
    LDS_WAIT(); asm volatile("" ::: "memory");
    const int c = lane & 7;
#pragma unroll
    for (int j = 0; j < 4; ++j) { const int n = (lane >> 3) + 8 * j; const LAS float* s = scr + (8 * c) * 33 + n; const int sn = n0 + n;
        const int dr = mode == 0 ? sn : (256 * (sn >> 7) + (sn & 127) + (mode == 3 ? 128 : 0));
        u32x2 o; o.x = pg8::cvt4_fp8(s[0 * 33] * scale, s[1 * 33] * scale, s[2 * 33] * scale, s[3 * 33] * scale); o.y = pg8::cvt4_fp8(s[4 * 33] * scale, s[5 * 33] * scale, s[6 * 33] * scale, s[7 * 33] * scale);
        *(GAS u32x2*)(WT + (size_t)dr * K + k0 + 8 * c) = o; }
    LDS_WAIT(); asm volatile("" ::: "memory");
}
struct ConvDesc { const float* W; unsigned char* dst; int K, N, mode, f8; };
__device__ __forceinline__ void conv_load(const ConvDesc& d, int sub, int lane, f32x4 (&v)[8]) {
    const int nblk = d.N / 32, kb = sub / nblk, nb = sub % nblk, k0 = 64 * kb, n0 = 32 * nb;
#pragma unroll
    for (int u = 0; u < 8; ++u) v[u] = *(const GAS f32x4*)(d.W + (size_t)(k0 + 8 * u + (lane >> 3)) * d.N + n0 + 4 * (lane & 7));
}
__device__ __forceinline__ void conv_store(const ConvDesc& d, int sub, int lane, const f32x4 (&v)[8], LAS float* scr) {
    const int nblk = d.N / 32, kb = sub / nblk, nb = sub % nblk, k0 = 64 * kb, n0 = 32 * nb;
#pragma unroll
    for (int u = 0; u < 8; ++u)
#pragma unroll
        for (int e = 0; e < 4; ++e) scr[(8 * u + (lane >> 3)) * 33 + 4 * (lane & 7) + e] = v[u][e];
    LDS_WAIT(); asm volatile("" ::: "memory");
    const int c = lane & 7;
#pragma unroll
    for (int j = 0; j < 4; ++j) { const int n = (lane >> 3) + 8 * j; const LAS float* s = scr + (8 * c) * 33 + n; const int sn = n0 + n;
        const int dr = d.mode == 0 ? sn : d.mode == 1 ? tau_in(sn) : (256 * (sn >> 7) + (sn & 127) + (d.mode == 3 ? 128 : 0));
        if (d.f8) { u32x2 o; o.x = pg8::cvt4_fp8(s[0 * 33] * W8SCALE, s[1 * 33] * W8SCALE, s[2 * 33] * W8SCALE, s[3 * 33] * W8SCALE); o.y = pg8::cvt4_fp8(s[4 * 33] * W8SCALE, s[5 * 33] * W8SCALE, s[6 * 33] * W8SCALE, s[7 * 33] * W8SCALE);
            *(GAS u32x2*)(d.dst + (size_t)dr * d.K + k0 + 8 * c) = o; }
        else { v4u o; o.x = cvtpk(s[0 * 33], s[1 * 33]); o.y = cvtpk(s[2 * 33], s[3 * 33]); o.z = cvtpk(s[4 * 33], s[5 * 33]); o.w = cvtpk(s[6 * 33], s[7 * 33]);
            *(GAS v4u*)((bf16*)d.dst + (size_t)dr * d.K + k0 + 8 * c) = o; } }
    LDS_WAIT(); asm volatile("" ::: "memory");
}
__device__ __forceinline__ void conv_colmax(const ConvDesc& d, int sub, int lane, const f32x4 (&v)[8], gu32* cmax) {
    const int nblk = d.N / 32, nb = sub % nblk, n0 = 32 * nb;
    f32x4 m = (f32x4){0.f, 0.f, 0.f, 0.f};
#pragma unroll
    for (int u = 0; u < 8; ++u)
#pragma unroll
        for (int e = 0; e < 4; ++e) m[e] = fmaxf(m[e], fabsf(v[u][e]));
#pragma unroll
    for (int e = 0; e < 4; ++e) { m[e] = fmaxf(m[e], __shfl_xor(m[e], 8)); m[e] = fmaxf(m[e], __shfl_xor(m[e], 16)); m[e] = fmaxf(m[e], __shfl_xor(m[e], 32)); }
    if (lane < 8) {
#pragma unroll
        for (int e = 0; e < 4; ++e) __hip_atomic_fetch_max(cmax + n0 + 4 * lane + e, __float_as_uint(m[e]), __ATOMIC_RELAXED, __HIP_MEMORY_SCOPE_AGENT); }
}
__device__ __forceinline__ unsigned pack4_i8(float a, float b, float c, float d) {
    const int ia = (int)__builtin_amdgcn_fmed3f(__builtin_rintf(a), -127.f, 127.f), ib = (int)__builtin_amdgcn_fmed3f(__builtin_rintf(b), -127.f, 127.f), ic = (int)__builtin_amdgcn_fmed3f(__builtin_rintf(c), -127.f, 127.f), id = (int)__builtin_amdgcn_fmed3f(__builtin_rintf(d), -127.f, 127.f);
    return (unsigned)(ia & 255) | ((unsigned)(ib & 255) << 8) | ((unsigned)(ic & 255) << 16) | ((unsigned)id << 24);
}
__device__ __forceinline__ void conv_store_i8(const ConvDesc& d, int sub, int lane, const f32x4 (&v)[8], LAS float* scr, gu32* cmax, float* swout) {
    const int nblk = d.N / 32, kb = sub / nblk, nb = sub % nblk, k0 = 64 * kb, n0 = 32 * nb;
#pragma unroll
    for (int u = 0; u < 8; ++u)
#pragma unroll
        for (int e = 0; e < 4; ++e) scr[(8 * u + (lane >> 3)) * 33 + 4 * (lane & 7) + e] = v[u][e];
    LDS_WAIT(); asm volatile("" ::: "memory");
    const int c = lane & 7;
#pragma unroll
    for (int j = 0; j < 4; ++j) { const int n = (lane >> 3) + 8 * j; const LAS float* s = scr + (8 * c) * 33 + n; const int sn = n0 + n;
        const int dr = d.mode == 0 ? sn : d.mode == 1 ? tau_in(sn) : (256 * (sn >> 7) + (sn & 127) + (d.mode == 3 ? 128 : 0));
        const float cm = __uint_as_float(__hip_atomic_load(cmax + sn, RLX_AGENT)); const float q = cm > 0.f ? 127.0f / cm : 0.f;
        u32x2 o; o.x = pack4_i8(s[0 * 33] * q, s[1 * 33] * q, s[2 * 33] * q, s[3 * 33] * q); o.y = pack4_i8(s[4 * 33] * q, s[5 * 33] * q, s[6 * 33] * q, s[7 * 33] * q);
        *(GAS u32x2*)(d.dst + (size_t)dr * d.K + k0 + 8 * c) = o;
        if (k0 == 0 && c == 0) swout[dr] = cm * (1.0f / 127.0f); }
    LDS_WAIT(); asm volatile("" ::: "memory");
}
__device__ __forceinline__ void st_row_i8(unsigned char* rowp, float* sap, int lane, const f32x4 (&v)[4]) {
    float am = 0.f;
#pragma unroll
    for (int j = 0; j < 4; ++j) am = fmaxf(fmaxf(fmaxf(am, fabsf(v[j][0])), fmaxf(fabsf(v[j][1]), fabsf(v[j][2]))), fabsf(v[j][3]));
#pragma unroll
    for (int o = 1; o < 64; o <<= 1) am = fmaxf(am, __shfl_xor(am, o));
    const float q = am > 0.f ? 127.0f / am : 0.f;
#pragma unroll
    for (int j = 0; j < 4; ++j) *(GAS unsigned*)(rowp + 4 * lane + 256 * j) = pack4_i8(v[j][0] * q, v[j][1] * q, v[j][2] * q, v[j][3] * q);
    if (lane == 0) *sap = am * (1.0f / 127.0f);
}
struct Args { const float* in[19]; float* out; unsigned char* ws; int ph_lo, ph_hi; };
typedef const __attribute__((address_space(4))) Args* KArgs;
__device__ __forceinline__ KArgs kargs() { KArgs p = (KArgs)__builtin_amdgcn_kernarg_segment_ptr(); asm volatile("" : "+s"(p)); return p; }
__device__ __forceinline__ void phase_prologue(KArgs A, LAS unsigned char* L, int gw, int NGW, int wave, int lane) {
    unsigned char* ws = A->ws;
    LAS float* scr = (LAS float*)(L + RING_OFF + wave * 16384);
    constexpr int I_IN = (DM / 64) * (INW / 32), I_OUT = (DM / 64) * (DM / 32), I_FF = (DM / 64) * (DFF / 32);
    static_assert((DFF / 64) * (DM / 32) == I_FF, "item counts");
    constexpr int NITEMS = 2 * I_IN + 2 * I_OUT + 27 * I_FF;
    auto desc = [&](int it, ConvDesc& d, int& sub) {
        int r = it;
        if (r < 2 * I_IN) { const int l = r / I_IN; d = ConvDesc{A->in[1] + (size_t)l * DM * INW, ws + WS_WIN + (size_t)l * INW * DM * 2, DM, INW, 1, PROJ_I8_IN ? 3 : 0}; sub = r % I_IN; return; } r -= 2 * I_IN;
        if (r < 2 * I_OUT) { const int l = r / I_OUT; d = ConvDesc{A->in[2] + (size_t)l * DM * DM, ws + WS_WOUT + (size_t)l * DM * DM * 2, DM, DM, 0, PROJ_I8_OUT ? 3 : 0}; sub = r % I_OUT; return; } r -= 2 * I_OUT;
        const int mtx = r / I_FF; sub = r % I_FF;
        if (mtx == 0) d = ConvDesc{A->in[12], ws + WS_WGU_D, DM, DFF, 2, DENSE_I8 ? 3 : DENSE_F8};
        else if (mtx == 1) d = ConvDesc{A->in[13], ws + WS_WGU_D, DM, DFF, 3, DENSE_I8 ? 3 : DENSE_F8};
        else if (mtx == 2) d = ConvDesc{A->in[14], ws + WS_WDN_D, DFF, DM, 0, DENSE_F8};
        else if (mtx < 11) { const int e = mtx - 3; d = ConvDesc{A->in[16] + (size_t)e * DM * DFF, ws + WS_WGU_M + (size_t)e * 2 * DFF * DM, DM, DFF, 2, 1}; }
        else if (mtx < 19) { const int e = mtx - 11; d = ConvDesc{A->in[17] + (size_t)e * DM * DFF, ws + WS_WGU_M + (size_t)e * 2 * DFF * DM, DM, DFF, 3, 1}; }
        else { const int e = mtx - 19; d = ConvDesc{A->in[18] + (size_t)e * DFF * DM, ws + WS_WDN_M + (size_t)e * DM * DFF, DFF, DM, 0, 1}; }
    };
    {
        ConvDesc dA{}, dB{}; int sA = 0, sB = 0; f32x4 vA[8], vB[8];
        int it = gw;
        if (it < NITEMS) { desc(it, dA, sA); if (dA.f8 != 3) conv_load(dA, sA, lane, vA); }
        for (; it < NITEMS; it += 2 * NGW) {
            const bool hasB = it + NGW < NITEMS;
            if (hasB) { desc(it + NGW, dB, sB); if (dB.f8 != 3) conv_load(dB, sB, lane, vB); }
            if (dA.f8 != 3) conv_store(dA, sA, lane, vA, scr);
            if (it + 2 * NGW < NITEMS) { desc(it + 2 * NGW, dA, sA); if (dA.f8 != 3) conv_load(dA, sA, lane, vA); }
            if (hasB && dB.f8 != 3) conv_store(dB, sB, lane, vB, scr);
        }
    }
    if (PROJ_I8) {
        for (int it = gw; it < 2 * I_IN + 2 * I_OUT; it += NGW) { f32x4 v[8];
            if (it < 2 * I_IN) { if (!PROJ_I8_IN) continue; const int l = it / I_IN, sub = it % I_IN; ConvDesc d{A->in[1] + (size_t)l * DM * INW, nullptr, DM, INW, 1, 0}; conv_load(d, sub, lane, v); conv_colmax(d, sub, lane, v, (gu32*)(ws + WS_CTL) + CW_CMAX_IN + l * INW); }
            else { if (!PROJ_I8_OUT) continue; const int r = it - 2 * I_IN, l = r / I_OUT, sub = r % I_OUT; ConvDesc d{A->in[2] + (size_t)l * DM * DM, nullptr, DM, DM, 0, 0}; conv_load(d, sub, lane, v); conv_colmax(d, sub, lane, v, (gu32*)(ws + WS_CTL) + CW_CMAX_OUT + l * DM); } }
    }
    if (DENSE_I8) {
        for (int it = gw; it < 2 * I_FF; it += NGW) { const int mtx = it / I_FF, sub = it % I_FF; ConvDesc d{A->in[12 + mtx], nullptr, DM, DFF, 2 + mtx, 0}; f32x4 v[8];
            conv_load(d, sub, lane, v); conv_colmax(d, sub, lane, v, (gu32*)(ws + WS_CTL) + CW_CMAX + mtx * DFF); }
    }
    const float* x = A->in[0]; const float* g = A->in[3]; bf16* HN = (bf16*)(ws + WS_HN);
    f32x4 gv[4];
#pragma unroll
    for (int j = 0; j < 4; ++j) gv[j] = *(const GAS f32x4*)(g + 4 * lane + 256 * j);
#define P0_ROW(V, m_) do { const float r_ = rms_scale(V); _Pragma("unroll") for (int j = 0; j < 4; ++j) V[j] = V[j] * r_ * gv[j]; \
        if (PROJ_I8_IN) st_row_i8((unsigned char*)HN + (size_t)(m_) * DM, (float*)(ws + WS_SA) + (m_), lane, V); else st_row_bf16(HN + (size_t)(m_) * DM, lane, V); } while (0)
    { f32x4 vA[4], vB[4]; int m = gw;
      if (m < NTOK) ld_row_f32(x + (size_t)m * DM, lane, vA);
      for (; m < NTOK; m += 2 * NGW) { const bool hasB = m + NGW < NTOK;
          if (hasB) ld_row_f32(x + (size_t)(m + NGW) * DM, lane, vB);
          P0_ROW(vA, m);
          if (m + 2 * NGW < NTOK) ld_row_f32(x + (size_t)(m + 2 * NGW) * DM, lane, vA);
          if (hasB) P0_ROW(vB, m + NGW); } }
#undef P0_ROW
}
__device__ __forceinline__ void unpack8(v4u w, float (&f)[8]) {
    f[0] = __uint_as_float(w.x << 16); f[1] = __uint_as_float(w.x & 0xffff0000u); f[2] = __uint_as_float(w.y << 16); f[3] = __uint_as_float(w.y & 0xffff0000u);
    f[4] = __uint_as_float(w.z << 16); f[5] = __uint_as_float(w.z & 0xffff0000u); f[6] = __uint_as_float(w.w << 16); f[7] = __uint_as_float(w.w & 0xffff0000u);
}
__device__ __forceinline__ v4u pack8(const float (&f)[8]) { v4u w; w.x = cvtpk(f[0], f[1]); w.y = cvtpk(f[2], f[3]); w.z = cvtpk(f[4], f[5]); w.w = cvtpk(f[6], f[7]); return w; }
__device__ __forceinline__ void phase_t2(const bf16* OA, const bf16* OB, bf16* AO, const float* g_out_a, const float* g_subln, const float* lp, float lam_init, int gw, int NGW, int lane) {
    const float sa = wave_sum(lp[lane] * lp[64 + lane]), sb = wave_sum(lp[128 + lane] * lp[192 + lane]);
    const float lam = expf(sa) - expf(sb) + lam_init;
    float ga[8], gb[8];
#pragma unroll
    for (int i = 0; i < 8; ++i) { ga[i] = g_out_a[8 * lane + i]; gb[i] = g_subln[(8 * lane + i) & 127] * (1.0f - lam_init); }
    for (int row = gw; row < NTOK; row += NGW) {
        const v4u wa = *(const GAS v4u*)(OA + (size_t)row * 512 + 8 * lane), w0 = *(const GAS v4u*)(OB + (size_t)row * 1024 + 8 * lane), w1 = *(const GAS v4u*)(OB + (size_t)row * 1024 + 512 + 8 * lane);
        float a[8], b0[8], b1[8]; unpack8(wa, a); unpack8(w0, b0); unpack8(w1, b1);
        float ssa = 0.f, ssb = 0.f;
#pragma unroll
        for (int i = 0; i < 8; ++i) { ssa += a[i] * a[i]; b0[i] = b0[i] - lam * b1[i]; ssb += b0[i] * b0[i]; }
        ssa = wave_sum(ssa);
        ssb += __shfl_xor(ssb, 1); ssb += __shfl_xor(ssb, 2); ssb += __shfl_xor(ssb, 4); ssb += __shfl_xor(ssb, 8);
        const float ra = 1.0f / sqrtf(ssa * (1.0f / 512.0f) + EPS), rb = 1.0f / sqrtf(ssb * (1.0f / 128.0f) + EPS);
#pragma unroll
        for (int i = 0; i < 8; ++i) { a[i] = a[i] * ra * ga[i]; b0[i] = b0[i] * rb * gb[i]; }
        if (PROJ_I8_OUT) { float am = 0.f;
#pragma unroll
            for (int i = 0; i < 8; ++i) am = fmaxf(am, fmaxf(fabsf(a[i]), fabsf(b0[i])));
#pragma unroll
            for (int o = 1; o < 64; o <<= 1) am = fmaxf(am, __shfl_xor(am, o));
            const float q = am > 0.f ? 127.0f / am : 0.f; unsigned char* rp = (unsigned char*)AO + (size_t)row * 1024;
            u32x2 wa_, wb_; wa_.x = pack4_i8(a[0] * q, a[1] * q, a[2] * q, a[3] * q); wa_.y = pack4_i8(a[4] * q, a[5] * q, a[6] * q, a[7] * q); wb_.x = pack4_i8(b0[0] * q, b0[1] * q, b0[2] * q, b0[3] * q); wb_.y = pack4_i8(b0[4] * q, b0[5] * q, b0[6] * q, b0[7] * q);
            *(GAS u32x2*)(rp + 8 * lane) = wa_; *(GAS u32x2*)(rp + 512 + 8 * lane) = wb_;
            if (lane == 0) ((float*)((unsigned char*)AO + (WS_SA2 - WS_AO)))[row] = am * (1.0f / 127.0f);
        } else { *(GAS v4u*)(AO + (size_t)row * 1024 + 8 * lane) = pack8(a); *(GAS v4u*)(AO + (size_t)row * 1024 + 512 + 8 * lane) = pack8(b0); }
    }
}
template <bool ROUTE, bool F8OUT = ROUTE, bool I8OUT = false>
__device__ __forceinline__ void phase_t3(const float* hsrc, float* hdst, const bf16* MIX, bf16* HN, const float* gpost, const float* gpre, const float* wrt, v4u* TOK, unsigned* WGB, gu32* cnt,
                                         LAS unsigned* lcnt, LAS f32x4* wrl, int vcu, int G, int wave, int lane, int tid) {
    f32x4 gp[4], gf[4];
#pragma unroll
    for (int j = 0; j < 4; ++j) { gp[j] = *(const GAS f32x4*)(gpost + 4 * lane + 256 * j); gf[j] = *(const GAS f32x4*)(gpre + 4 * lane + 256 * j); }
    if (ROUTE) { for (int i = tid; i < 2048; i += NWAVES * 64) { const int row = i >> 1, hf = i & 1; wrl[(((row >> 8) * 4 + (row & 3)) * 2 + hf) * 64 + ((row & 255) >> 2)] = *(const GAS f32x4*)(wrt + 4 * i); } __syncthreads(); }
#define T3_LOAD(HV, MV, r) do { ld_row_f32(hsrc + (size_t)(r) * DM, lane, HV); ld_row_bf16(MIX + (size_t)(r) * DM, lane, MV); } while (0)
#define T3_ROW(HV, MV, row) do { \
        const float r_ = rms_scale(MV); \
        _Pragma("unroll") for (int j = 0; j < 4; ++j) HV[j] = HV[j] + MV[j] * r_ * gp[j]; \
        st_row_f32(hdst + (size_t)(row) * DM, lane, HV); \
        const float r2_ = rms_scale(HV); \
        _Pragma("unroll") for (int j = 0; j < 4; ++j) MV[j] = HV[j] * r2_ * gf[j]; \
        if (F8OUT) { \
            _Pragma("unroll") for (int j = 0; j < 4; ++j) *(GAS unsigned*)((unsigned char*)HN + (size_t)(row) * DM + 4 * lane + 256 * j) = pg8::cvt4_fp8(MV[j][0] * A8SCALE, MV[j][1] * A8SCALE, MV[j][2] * A8SCALE, MV[j][3] * A8SCALE); \
        } else if (I8OUT) {                                    \
            float am_ = 0.f; \
            _Pragma("unroll") for (int j = 0; j < 4; ++j) am_ = fmaxf(fmaxf(fmaxf(am_, fabsf(MV[j][0])), fmaxf(fabsf(MV[j][1]), fabsf(MV[j][2]))), fabsf(MV[j][3])); \
            _Pragma("unroll") for (int o_ = 1; o_ < 64; o_ <<= 1) am_ = fmaxf(am_, __shfl_xor(am_, o_)); \
            const float q_ = am_ > 0.f ? 127.0f / am_ : 0.f; \
            _Pragma("unroll") for (int j = 0; j < 4; ++j) *(GAS unsigned*)((unsigned char*)HN + (size_t)(row) * DM + 4 * lane + 256 * j) = pack4_i8(MV[j][0] * q_, MV[j][1] * q_, MV[j][2] * q_, MV[j][3] * q_); \
            if (lane == 0) ((float*)((unsigned char*)HN + (WS_SA - WS_HN)))[row] = am_ * (1.0f / 127.0f); \
        } else st_row_bf16(HN + (size_t)(row) * DM, lane, MV); \
        if (ROUTE) { \
            float lg[8]; \
            _Pragma("unroll") for (int e = 0; e < 8; ++e) lg[e] = 0.f; \
            _Pragma("unroll") for (int j = 0; j < 4; ++j) \
            _Pragma("unroll") for (int k = 0; k < 4; ++k) { const float xv = MV[j][k]; const f32x4 w0_ = wrl[((j * 4 + k) * 2) * 64 + lane], w1_ = wrl[((j * 4 + k) * 2 + 1) * 64 + lane]; \
                _Pragma("unroll") for (int e = 0; e < 4; ++e) { lg[e] += xv * w0_[e]; lg[4 + e] += xv * w1_[e]; } } \
            _Pragma("unroll") for (int e = 0; e < 8; ++e) lg[e] = wave_sum(lg[e]); \
            int e0 = 0; float l0 = lg[0]; \
            _Pragma("unroll") for (int e = 1; e < 8; ++e) if (lg[e] > l0) { l0 = lg[e]; e0 = e; } \
            int e1 = -1; float l1 = -INFINITY; \
            _Pragma("unroll") for (int e = 0; e < 8; ++e) if (e != e0 && lg[e] > l1) { l1 = lg[e]; e1 = e; } \
            if (e1 < 0) e1 = (e0 + 1) & 7; \
            const float w0 = 1.0f / (1.0f + expf(l1 - l0)); \
            if (lane == 0) { const unsigned r0 = __hip_atomic_fetch_add(lcnt + e0, 1u, __ATOMIC_RELAXED, __HIP_MEMORY_SCOPE_WORKGROUP), r1 = __hip_atomic_fetch_add(lcnt + e1, 1u, __ATOMIC_RELAXED, __HIP_MEMORY_SCOPE_WORKGROUP); \
                v4u tk; tk.x = (unsigned)e0 | ((unsigned)e1 << 8); tk.y = r0; tk.z = r1; tk.w = __float_as_uint(w0); *(GAS v4u*)(TOK + (row)) = tk; } \
        } \
    } while (0)
    for (int blk = vcu; blk < NTOK / 256; blk += G) {
        if (ROUTE) { if (tid < 8) lcnt[tid] = 0u; __syncthreads(); }
        const int rowb = blk * 256 + wave;
        f32x4 hA[4], mA[4], hB[4], mB[4];
        T3_LOAD(hA, mA, rowb);
        for (int i = 0; i < 32; i += 2) {
            T3_LOAD(hB, mB, rowb + 8 * (i + 1));
            T3_ROW(hA, mA, rowb + 8 * i);
            if (i + 2 < 32) T3_LOAD(hA, mA, rowb + 8 * (i + 2));
            T3_ROW(hB, mB, rowb + 8 * (i + 1));
        }
        if (ROUTE) { __syncthreads(); if (tid < 8) { const unsigned c = lcnt[tid]; const unsigned base = __hip_atomic_fetch_add(cnt + tid, c, __ATOMIC_RELAXED, __HIP_MEMORY_SCOPE_AGENT); WGB[blk * 8 + tid] = base; } __syncthreads(); }
    }
#undef T3_LOAD
#undef T3_ROW
}
__device__ __forceinline__ void load_layout(gu32* cnt, int (&cn)[8], int (&ps)[8], int (&pe)[8]) {
    int acc = 0;
#pragma unroll
    for (int e = 0; e < 8; ++e) { const int c = __builtin_amdgcn_readfirstlane((int)__hip_atomic_load(cnt + e, RLX_AGENT)); cn[e] = c; ps[e] = acc; acc += (c + 511) & ~511; pe[e] = acc; }
}
__device__ __forceinline__ void phase_gather(const unsigned char* HN, unsigned char* XS, const v4u* TOK, const unsigned* WGB, gu32* cnt, LAS int* psl, int gw, int NGW, int lane, int tid) {
    int cn[8], ps[8], pe[8]; load_layout(cnt, cn, ps, pe);
    if (tid == 0) {
#pragma unroll
        for (int e = 0; e < 8; ++e) psl[e] = ps[e]; }
    __syncthreads();
    for (int row0 = gw; row0 < NTOK; row0 += 4 * NGW) {
        v4u tk[4], v0[4]; size_t d0[4], d1[4];
#pragma unroll
        for (int u = 0; u < 4; ++u) { const int row = row0 + u * NGW; tk[u] = *(const GAS v4u*)(TOK + row); v0[u] = *(const GAS v4u*)(HN + (size_t)row * DM + 16 * lane); }
#pragma unroll
        for (int u = 0; u < 4; ++u) { const int row = row0 + u * NGW; const int e0 = tk[u].x & 255, e1 = (tk[u].x >> 8) & 255;
            d0[u] = (size_t)(psl[e0] + (int)WGB[(row >> 8) * 8 + e0] + (int)tk[u].y); d1[u] = (size_t)(psl[e1] + (int)WGB[(row >> 8) * 8 + e1] + (int)tk[u].z); }
#pragma unroll
        for (int u = 0; u < 4; ++u) { *(GAS v4u*)(XS + d0[u] * DM + 16 * lane) = v0[u]; *(GAS v4u*)(XS + d1[u] * DM + 16 * lane) = v0[u]; }
    }
    const v4u z = (v4u){0u, 0u, 0u, 0u};
#pragma unroll
    for (int e = 0; e < 8; ++e)
        for (int r = ps[e] + cn[e] + gw; r < pe[e]; r += NGW) *(GAS v4u*)(XS + (size_t)r * DM + 16 * lane) = z;
}
template <bool MOE, bool NEXT>
__device__ __forceinline__ void phase_t4(float* h, const bf16* F, const v4u* TOK, const unsigned* WGB, gu32* cnt, LAS int* psl, const float* gpost, const float* gnext, bf16* HN, int gw, int NGW, int lane, int tid) {
    if (MOE) { int cn[8], ps[8], pe[8]; load_layout(cnt, cn, ps, pe);
        if (tid == 0) {
#pragma unroll
            for (int e = 0; e < 8; ++e) psl[e] = ps[e]; }
        __syncthreads(); }
    f32x4 gp[4], gn[4];
#pragma unroll
    for (int j = 0; j < 4; ++j) { gp[j] = *(const GAS f32x4*)(gpost + 4 * lane + 256 * j); gn[j] = NEXT ? *(const GAS f32x4*)(gnext + 4 * lane + 256 * j) : (f32x4){0.f, 0.f, 0.f, 0.f}; }
#define T4_META(TK, r) do { if (MOE) TK = *(const GAS v4u*)(TOK + (r)); } while (0)
#define T4_LOAD(FV, F1, HV, TK, r) do { \
        if (MOE) { const int e0_ = TK.x & 255, e1_ = (TK.x >> 8) & 255; \
            const size_t d0_ = (size_t)(psl[e0_] + (int)WGB[((r) >> 8) * 8 + e0_] + (int)TK.y), d1_ = (size_t)(psl[e1_] + (int)WGB[((r) >> 8) * 8 + e1_] + (int)TK.z); \
            ld_row_bf16(F + d0_ * DM, lane, FV); ld_row_bf16(F + d1_ * DM, lane, F1); } \
        else ld_row_bf16(F + (size_t)(r) * DM, lane, FV); \
        ld_row_f32(h + (size_t)(r) * DM, lane, HV); } while (0)
#define T4_ROW(FV, F1, HV, W0, row) do { \
        if (MOE) { const float w0_ = W0, w1_ = 1.0f - w0_; _Pragma("unroll") for (int j = 0; j < 4; ++j) FV[j] = FV[j] * w0_ + F1[j] * w1_; } \
        const float r_ = rms_scale(FV); \
        _Pragma("unroll") for (int j = 0; j < 4; ++j) HV[j] = HV[j] + FV[j] * r_ * gp[j]; \
        st_row_f32(h + (size_t)(row) * DM, lane, HV); \
        if (NEXT) { const float r2_ = rms_scale(HV); \
            _Pragma("unroll") for (int j = 0; j < 4; ++j) FV[j] = HV[j] * r2_ * gn[j]; \
            if (PROJ_I8_IN) st_row_i8((unsigned char*)HN + (size_t)(row) * DM, (float*)((unsigned char*)HN + (WS_SA - WS_HN)) + (row), lane, FV); else st_row_bf16(HN + (size_t)(row) * DM, lane, FV); } \
    } while (0)
    const int nrow = (NTOK - gw + NGW - 1) / NGW;
    f32x4 fA[4], gA[4], hA[4], fB[4], gB[4], hB[4]; v4u tA = (v4u){0u, 0u, 0u, 0u}, tB = tA, tN = tA; float wA = 0.f, wB = 0.f;
    if (nrow > 0) { T4_META(tA, gw); T4_LOAD(fA, gA, hA, tA, gw); wA = __uint_as_float(tA.w); if (nrow > 1) T4_META(tN, gw + NGW); }
    for (int i = 0; i < nrow; i += 2) {
        if (i + 1 < nrow) { tB = tN; T4_LOAD(fB, gB, hB, tB, gw + (i + 1) * NGW); wB = __uint_as_float(tB.w); if (i + 2 < nrow) T4_META(tN, gw + (i + 2) * NGW); }
        T4_ROW(fA, gA, hA, wA, gw + i * NGW);
        if (i + 1 < nrow) {
            if (i + 2 < nrow) { tA = tN; T4_LOAD(fA, gA, hA, tA, gw + (i + 2) * NGW); wA = __uint_as_float(tA.w); if (i + 3 < nrow) T4_META(tN, gw + (i + 3) * NGW); }
            T4_ROW(fB, gB, hB, wB, gw + (i + 1) * NGW);
        }
    }
#undef T4_META
#undef T4_LOAD
#undef T4_ROW
}
__device__ __forceinline__ void phase_vt(const bf16* VA, const bf16* VB, unsigned char* VT, LAS unsigned char* scr, int gw, int NGW, int lane) {
    const int k5 = lane & 31; const int slot = 32 * ((k5 >> 2) & 1) + (k5 & 3) + 4 * (k5 >> 3) + 16 * (lane >> 5);
    for (int tl = gw; tl < 6144; tl += NGW) {
        const bool isB = tl >= 2048; const int ti = isB ? tl - 2048 : tl, t = ti & 127, bh = ti >> 7, DVt = isB ? 128 : 64;
        const bf16* src = isB ? VB + ((size_t)(bh >> 2) * SEQL + 64 * t + lane) * 512 + 128 * (bh & 3) : VA + ((size_t)(bh >> 1) * SEQL + 64 * t + lane) * 128 + 64 * (bh & 1);
        unsigned char* dst = VT + (isB ? ((size_t)8 * MiB + (size_t)ti * 8192) : (size_t)ti * 4096);
        for (int c = 0; c < DVt / 8; ++c) { const v4u w = *(const GAS v4u*)(src + 8 * c); float f[8]; unpack8(w, f);
            const unsigned lo = pg8::cvt4_fp8(f[0] * attn_body::V8SCALE, f[1] * attn_body::V8SCALE, f[2] * attn_body::V8SCALE, f[3] * attn_body::V8SCALE), hi = pg8::cvt4_fp8(f[4] * attn_body::V8SCALE, f[5] * attn_body::V8SCALE, f[6] * attn_body::V8SCALE, f[7] * attn_body::V8SCALE);
#pragma unroll
            for (int i = 0; i < 4; ++i) { scr[(8 * c + i) * 64 + slot] = (unsigned char)(lo >> (8 * i)); scr[(8 * c + 4 + i) * 64 + slot] = (unsigned char)(hi >> (8 * i)); } }
        LDS_WAIT(); asm volatile("" ::: "memory");
        for (int it = 0; it < DVt / 16; ++it) { const int q = it * 64 + lane; *(GAS v4u*)(dst + 16 * q) = *(const LAS v4u*)(scr + 16 * q); }
        LDS_WAIT(); asm volatile("" ::: "memory");
    }
}
__device__ __forceinline__ void phase_quant_gu(KArgs A, LAS unsigned char* L, int gw, int NGW, int wave, int lane) {
    unsigned char* ws = A->ws; LAS float* scr = (LAS float*)(L + RING_OFF + wave * 16384);
    constexpr int I_FF = (DM / 64) * (DFF / 32);
    if (DENSE_I8) for (int it = gw; it < 2 * I_FF; it += NGW) { const int mtx = it / I_FF, sub = it % I_FF; ConvDesc d{A->in[12 + mtx], ws + WS_WGU_D, DM, DFF, 2 + mtx, 0}; f32x4 v[8];
        conv_load(d, sub, lane, v); conv_store_i8(d, sub, lane, v, scr, (gu32*)(ws + WS_CTL) + CW_CMAX + mtx * DFF, (float*)(ws + WS_SWGU)); }
    if (PROJ_I8) { constexpr int I_IN = (DM / 64) * (INW / 32), I_OUT = (DM / 64) * (DM / 32);
        for (int it = gw; it < 2 * I_IN + 2 * I_OUT; it += NGW) { f32x4 v[8];
            if (it < 2 * I_IN) { if (!PROJ_I8_IN) continue; const int l = it / I_IN, sub = it % I_IN; ConvDesc d{A->in[1] + (size_t)l * DM * INW, ws + WS_WIN + (size_t)l * INW * DM, DM, INW, 1, 0};
                conv_load(d, sub, lane, v); conv_store_i8(d, sub, lane, v, scr, (gu32*)(ws + WS_CTL) + CW_CMAX_IN + l * INW, (float*)(ws + WS_SWIN) + l * INW); }
            else { if (!PROJ_I8_OUT) continue; const int r = it - 2 * I_IN, l = r / I_OUT, sub = r % I_OUT; ConvDesc d{A->in[2] + (size_t)l * DM * DM, ws + WS_WOUT + (size_t)l * DM * DM, DM, DM, 0, 0};
                conv_load(d, sub, lane, v); conv_store_i8(d, sub, lane, v, scr, (gu32*)(ws + WS_CTL) + CW_CMAX_OUT + l * DM, (float*)(ws + WS_SWOUT) + l * DM); } } }
}
#ifndef MK_PER_PHASE
#define MK_PER_PHASE 0
#endif
#ifndef PROBE_BREP
#define PROBE_BREP 1
#endif
#ifndef PROBE_P0
#define PROBE_P0 1
#endif
#ifndef PROBE_G1
#define PROBE_G1 1
#endif
#ifndef PROBE_G2
#define PROBE_G2 1
#endif
#ifndef PROBE_G3
#define PROBE_G3 1
#endif
#ifndef PROBE_G4
#define PROBE_G4 1
#endif
#ifndef PROBE_T2
#define PROBE_T2 1
#endif
#ifndef MK_PH_HI
#define MK_PH_HI 1000
#endif
constexpr int N_PHASES = 31;
constexpr int TE_OFF = LDSCTL_OFF + 1024;
__device__ __forceinline__ int fill_tile_experts(gu32* cnt, LAS int* te, int tid) {
    int cn[8], ps[8], pe[8]; load_layout(cnt, cn, ps, pe);
    for (int i = tid; i < 528; i += NWAVES * 64) { const int row = i * 256; int e = 0;
#pragma unroll
        for (int j = 0; j < 7; ++j) e += (row >= pe[j]) ? 1 : 0;
        te[i] = e; }
    __syncthreads();
    return pe[7] / 256;
}
#define IN() (lo <= ph && ph < hi)
#define SEAM() do { if (lo <= ph && ph + 1 < hi) xcd_barrier(bar); ++ph; } while (0)
#define TIDO() int tid; asm volatile("v_mbcnt_lo_u32_b32 %0, -1, 0\n\tv_mbcnt_hi_u32_b32 %0, -1, %0" : "=v"(tid)); tid += wave_s * 64
#define LANE (tid & 63)
#define WAVE (__builtin_amdgcn_readfirstlane(tid >> 6))
#define GW (vcu * NWAVES + WAVE)
#define NGW (G * NWAVES)
#define LCNT ((LAS unsigned*)(L + LDSCTL_OFF))
#define PSL ((LAS int*)(L + LDSCTL_OFF + 64))
#define TE ((LAS int*)(L + TE_OFF))
template <int LAYER>
__device__ __forceinline__ void layer_body(LAS unsigned char* L, unsigned char* lds, const XcdBarrier& bar, int lo, int hi, int& ph, int G, int bx, int vcu, int wave_s) {
    constexpr int layer = LAYER;
    constexpr bool moe = (LAYER & 1) != 0;
    if (IN()) {
        KArgs A = kargs(); unsigned char* ws = A->ws;
        pg8::StaticOrder S; S.init(NTOK / 256, INW / 256, G, bx, 0);
        if constexpr (PROJ_I8_IN) {
            pg8::Gemm g{(const bf16*)(ws + WS_HN), (const bf16*)(ws + WS_WIN + (size_t)layer * INW * DM), NTOK, INW, DM / 2};
            pg8::EpiInProjI8 E{ws, WS_QA, WS_KA, WS_VA, WS_QB, WS_KB, WS_VB, A->in[7] + 64 * layer, A->in[8] + 64 * layer, attn_body::C2, (const float*)(ws + WS_SA), (const float*)(ws + WS_SWIN) + layer * INW};
            pg8::gemm_phase<pg8::EpiInProjI8, pg8::StaticOrder, true, true, false, true>(L + RING_OFF, g, S, E, wave_s);
        } else {
        pg8::Gemm g{(const bf16*)(ws + WS_HN), (const bf16*)(ws + WS_WIN) + (size_t)layer * INW * DM, NTOK, INW, DM};
        pg8::EpiInProj E{ws, WS_QA, WS_KA, WS_VA, WS_QB, WS_KB, WS_VB, A->in[7] + 64 * layer, A->in[8] + 64 * layer, attn_body::C2};
        for (int rep_ = 0; rep_ < PROBE_G1; ++rep_) pg8::gemm_phase<pg8::EpiInProj, pg8::StaticOrder, true, true>(L + RING_OFF, g, S, E, wave_s);
        }
    }
    SEAM();
    if (IN()) { TIDO(); unsigned char* ws = kargs()->ws; phase_vt((const bf16*)(ws + WS_VA), (const bf16*)(ws + WS_VB), ws + WS_VT8, L + RING_OFF + WAVE * 16384, GW, NGW, LANE); }
    SEAM();
    if (IN()) {
        for (int i = 0;; ++i) {
            int b, st, qb; bool grpB;
            if (G == 256) { if (i >= 16) break; const int grp = vcu >> 3, s = i >> 2; b = grp >> 2; grpB = s >= 2; st = 4 * (s & 1) + (grp & 3); qb = (vcu & 7) + 8 * (i & 3); }
            else { const int Lu = i * G + vcu; if (Lu >= 4096) break; grpB = Lu >= 2048; qb = Lu & 31; const int sm = (Lu & 2047) >> 5; b = sm >> 3; st = sm & 7; }
            unsigned char* ws = kargs()->ws;
            typedef attn_body::bf16 abf;
            const long rb = (long)b * SEQL, qrow = rb + 256 * qb;
            if (!grpB) { const int hq = st, kh = hq >> 2;
                attn_body::attn_unit8<64>((const abf*)(ws + WS_QA) + 64 * hq + qrow * 512, 512, (const abf*)(ws + WS_KA) + 64 * kh + rb * 128, 128, ws + WS_VT8 + (size_t)(b * 2 + kh) * 128 * 4096,
                                          (abf*)(ws + WS_OA) + 64 * hq + qrow * 512, 512, (char*)lds + RING_OFF, wave_s); }
            else for (int rep_ = 0; rep_ < PROBE_BREP; ++rep_) { const int h = st >> 1, m = st & 1;
                attn_body::attn_unit8<128>((const abf*)(ws + WS_QB) + 64 * st + qrow * 512, 512, (const abf*)(ws + WS_KB) + 64 * st + rb * 512, 512, ws + WS_VT8 + (size_t)8 * MiB + (size_t)(b * 4 + h) * 128 * 8192,
                                           (abf*)(ws + WS_OB) + 512 * m + 128 * h + qrow * 1024, 1024, (char*)lds + RING_OFF, wave_s); }
        }
    }
    SEAM();
    if (IN()) { TIDO(); KArgs A = kargs(); unsigned char* ws = A->ws; const float lam_init = 0.8f - 0.6f * expf(-0.3f * (float)layer);
        for (int rep_ = 0; rep_ < PROBE_T2; ++rep_) phase_t2((const bf16*)(ws + WS_OA), (const bf16*)(ws + WS_OB), (bf16*)(ws + WS_AO), A->in[9] + 512 * layer, A->in[11] + 128 * layer, A->in[10] + 256 * layer, lam_init, GW, NGW, LANE); }
    SEAM();
    if (IN()) {
        unsigned char* ws = kargs()->ws;
        pg8::StaticOrder S; S.init(NTOK / 256, DM / 256, G, bx, 0);
        if constexpr (PROJ_I8_OUT) {
            pg8::Gemm g{(const bf16*)(ws + WS_AO), (const bf16*)(ws + WS_WOUT + (size_t)layer * DM * DM), NTOK, DM, DM / 2};
            pg8::EpiBf16I8 E{(bf16*)(ws + WS_MIX), DM, (const float*)(ws + WS_SA2), (const float*)(ws + WS_SWOUT) + layer * DM};
            pg8::gemm_phase<pg8::EpiBf16I8, pg8::StaticOrder, true, true, false, true>(L + RING_OFF, g, S, E, wave_s);
        } else {
        pg8::Gemm g{(const bf16*)(ws + WS_AO), (const bf16*)(ws + WS_WOUT) + (size_t)layer * DM * DM, NTOK, DM, DM};
        pg8::EpiBf16 E{(bf16*)(ws + WS_MIX), DM};
        for (int rep_ = 0; rep_ < PROBE_G2; ++rep_) pg8::gemm_phase<pg8::EpiBf16, pg8::StaticOrder, true, true>(L + RING_OFF, g, S, E, wave_s);
        }
    }
    SEAM();
    if (IN()) {
        TIDO(); KArgs A = kargs(); unsigned char* ws = A->ws;
        const float* hsrc = layer == 0 ? A->in[0] : A->out;
        if constexpr (moe) phase_t3<true>(hsrc, A->out, (const bf16*)(ws + WS_MIX), (bf16*)(ws + WS_HN), A->in[4] + DM * layer, A->in[5] + DM * layer, A->in[15], (v4u*)(ws + WS_TOK), (unsigned*)(ws + WS_WGB), (gu32*)(ws + WS_CTL) + CW_CNT, LCNT, (LAS f32x4*)(L + RING_OFF), vcu, G, WAVE, LANE, tid);
        else phase_t3<false, DENSE_F8 != 0, DENSE_I8 != 0>(hsrc, A->out, (const bf16*)(ws + WS_MIX), (bf16*)(ws + WS_HN), A->in[4] + DM * layer, A->in[5] + DM * layer, A->in[15], (v4u*)(ws + WS_TOK), (unsigned*)(ws + WS_WGB), (gu32*)(ws + WS_CTL) + CW_CNT, LCNT, (LAS f32x4*)(L + RING_OFF), vcu, G, WAVE, LANE, tid);
    }
    SEAM();
    if constexpr (moe) { if (IN()) { TIDO(); unsigned char* ws = kargs()->ws; phase_gather(ws + WS_HN, ws + WS_XS, (const v4u*)(ws + WS_TOK), (const unsigned*)(ws + WS_WGB), (gu32*)(ws + WS_CTL) + CW_CNT, PSL, GW, NGW, LANE, tid); } SEAM(); }
    if constexpr (!moe) {
        for (int c = 0; c < 2; ++c) {
            const int pm0 = c * CHUNK_TILES;
            if (IN()) {
                unsigned char* ws = kargs()->ws;
                pg8::StaticOrder S; S.init(CHUNK_TILES, 2 * DFF / 256, G, bx, pm0);
                if constexpr (DENSE_I8) {
                    pg8::Gemm g{(const bf16*)(ws + WS_HN), (const bf16*)(ws + WS_WGU_D), 0, 2 * DFF, DM / 2};
                    pg8::EpiSwiGLUI8 E{(bf16*)(ws + WS_ACT) - (size_t)pm0 * 256 * DFF, DFF, (const float*)(ws + WS_SA), (const float*)(ws + WS_SWGU)};
                    pg8::gemm_phase<pg8::EpiSwiGLUI8, pg8::StaticOrder, true, true, false, true>(L + RING_OFF, g, S, E, wave_s);
                } else if constexpr (DENSE_F8) {
                    pg8::Gemm g{(const bf16*)(ws + WS_HN), (const bf16*)(ws + WS_WGU_D), 0, 2 * DFF, DM / 2};
                    pg8::EpiSwiGLU8 E{ws + WS_ACT - (size_t)pm0 * 256 * DFF, DFF, 1.0f / (A8SCALE * W8SCALE), H8SCALE};
                    pg8::gemm_phase<pg8::EpiSwiGLU8, pg8::StaticOrder, true, true, true>(L + RING_OFF, g, S, E, wave_s);
                } else {
                    pg8::Gemm g{(const bf16*)(ws + WS_HN), (const bf16*)(ws + WS_WGU_D), 0, 2 * DFF, DM};
                    pg8::EpiSwiGLU E{(bf16*)(ws + WS_ACT) - (size_t)pm0 * 256 * DFF, DFF};
                    for (int rep_ = 0; rep_ < PROBE_G3; ++rep_) pg8::gemm_phase<pg8::EpiSwiGLU, pg8::StaticOrder, true, true>(L + RING_OFF, g, S, E, wave_s);
                }
            }
            SEAM();
            if (IN()) {
                unsigned char* ws = kargs()->ws;
                pg8::StaticOrder S; S.init(CHUNK_TILES, DM / 256, G, bx, pm0);
                if constexpr (DENSE_F8) {
                    pg8::Gemm g{(const bf16*)(ws + WS_ACT - (size_t)pm0 * 256 * DFF), (const bf16*)(ws + WS_WDN_D), 0, DM, DFF / 2};
                    pg8::EpiBf16S E{(bf16*)(ws + WS_F), DM, 1.0f / (H8SCALE * W8SCALE)};
                    pg8::gemm_phase<pg8::EpiBf16S, pg8::StaticOrder, true, true, true>(L + RING_OFF, g, S, E, wave_s);
                } else {
                    pg8::Gemm g{(const bf16*)(ws + WS_ACT) - (size_t)pm0 * 256 * DFF, (const bf16*)(ws + WS_WDN_D), 0, DM, DFF};
                    pg8::EpiBf16 E{(bf16*)(ws + WS_F), DM};
                    for (int rep_ = 0; rep_ < PROBE_G4; ++rep_) pg8::gemm_phase<pg8::EpiBf16, pg8::StaticOrder, true, true>(L + RING_OFF, g, S, E, wave_s);
                }
            }
            SEAM();
        }
    } else {
        for (int c = 0; c < 5; ++c) {
            const int pm0 = c * CHUNK_TILES;
            if (IN()) {
                TIDO(); unsigned char* ws = kargs()->ws;
                const int n_used = fill_tile_experts((gu32*)(ws + WS_CTL) + CW_CNT, TE, tid);
                int nt = n_used - pm0; nt = nt > CHUNK_TILES ? CHUNK_TILES : nt;
                if (nt > 0) {
                    pg8::Gemm g{(const bf16*)(ws + WS_XS), (const bf16*)(ws + WS_WGU_M), 0, 2 * DFF, DM / 2};
                    pg8::StaticOrder S; S.init(nt, 2 * DFF / 256, G, bx, pm0); S.estride = (unsigned)(2 * DFF * DM); S.te = TE;
                    pg8::EpiSwiGLU8 E{ws + WS_ACT8 - (size_t)pm0 * 256 * DFF, DFF, 1.0f / (A8SCALE * W8SCALE), H8SCALE};
                    for (int rep_ = 0; rep_ < PROBE_G3; ++rep_) pg8::gemm_phase<pg8::EpiSwiGLU8, pg8::StaticOrder, true, true, true>(L + RING_OFF, g, S, E, wave_s);
                }
            }
            SEAM();
            if (IN()) {
                TIDO(); unsigned char* ws = kargs()->ws;
                const int n_used = fill_tile_experts((gu32*)(ws + WS_CTL) + CW_CNT, TE, tid);
                int nt = n_used - pm0; nt = nt > CHUNK_TILES ? CHUNK_TILES : nt;
                if (nt > 0) {
                    pg8::Gemm g{(const bf16*)(ws + WS_ACT8 - (size_t)pm0 * 256 * DFF), (const bf16*)(ws + WS_WDN_M), 0, DM, DFF / 2};
                    pg8::StaticOrder S; S.init(nt, DM / 256, G, bx, pm0); S.estride = (unsigned)(DM * DFF); S.te = TE;
                    pg8::EpiBf16S E{(bf16*)(ws + WS_YS), DM, 1.0f / (H8SCALE * W8SCALE)};
                    for (int rep_ = 0; rep_ < PROBE_G4; ++rep_) pg8::gemm_phase<pg8::EpiBf16S, pg8::StaticOrder, true, true, true>(L + RING_OFF, g, S, E, wave_s);
                }
            }
            SEAM();
        }
    }
    if (IN()) {
        TIDO(); KArgs A = kargs(); unsigned char* ws = A->ws;
        if constexpr (moe) phase_t4<true, false>(A->out, (const bf16*)(ws + WS_YS), (const v4u*)(ws + WS_TOK), (const unsigned*)(ws + WS_WGB), (gu32*)(ws + WS_CTL) + CW_CNT, PSL, A->in[6] + DM * layer, nullptr, (bf16*)(ws + WS_HN), GW, NGW, LANE, tid);
        else phase_t4<false, true>(A->out, (const bf16*)(ws + WS_F), (const v4u*)(ws + WS_TOK), (const unsigned*)(ws + WS_WGB), (gu32*)(ws + WS_CTL) + CW_CNT, PSL, A->in[6] + DM * layer, A->in[3] + DM * (layer + 1), (bf16*)(ws + WS_HN), GW, NGW, LANE, tid);
    }
    if constexpr (LAYER + 1 < NLAYER) SEAM();
}
__global__ void __launch_bounds__(NWAVES * 64, 2) fwd_kernel(Args args_unused) {
    extern __shared__ __attribute__((aligned(16))) unsigned char lds[];
    LAS unsigned char* L = (LAS unsigned char*)lds;
    const int tid0 = threadIdx.x; const int wave_s = __builtin_amdgcn_readfirstlane(tid0 >> 6);
    const int G = gridDim.x, bx = blockIdx.x;
    const int vcu = (G % 8 == 0) ? (bx % 8) * (G / 8) + bx / 8 : bx;
    for (int u = tid0; u < (LDS_BYTES - LDSCTL_OFF) / 4; u += NWAVES * 64) ((LAS unsigned*)(L + LDSCTL_OFF))[u] = 0u;
    __syncthreads();
    XcdBarrier bar;
    int lo, hi;
    { KArgs A = kargs(); lo = A->ph_lo; hi = A->ph_hi; bar = xcd_barrier_post((unsigned*)(A->ws + WS_CTL) + CW_BAR, (volatile LAS unsigned*)(L + MISC_OFF) + 8); }
    int ph = 0;

    if (IN()) { for (int rep_ = 0; rep_ < PROBE_P0; ++rep_) { TIDO(); phase_prologue(kargs(), L, GW, NGW, WAVE, LANE); } }
    SEAM();
    if (DENSE_I8 || PROJ_I8) { if (IN()) { TIDO(); phase_quant_gu(kargs(), L, GW, NGW, WAVE, LANE); } SEAM(); }
    layer_body<0>(L, lds, bar, lo, hi, ph, G, bx, vcu, wave_s);
    layer_body<1>(L, lds, bar, lo, hi, ph, G, bx, vcu, wave_s);
#undef IN
#undef SEAM
}

extern "C" void kernel_launch(void* const* d_in, const int* in_sizes, int n_in, void* d_out, int out_size, void* d_ws, size_t ws_size, hipStream_t stream) {
    static int grid = 0;
    if (grid == 0) {
        if (n_in != 19 || in_sizes[0] != NTOK * DM || out_size != NTOK * DM || ws_size < WS_END) {
            fprintf(stderr, "kernel_launch: built for 19 inputs, x/out of %d floats, >= %zu bytes of workspace; got n_in %d, in0 %d, out %d, ws %zu; nothing launched\n", NTOK * DM, (size_t)WS_END, n_in, n_in > 0 ? in_sizes[0] : -1, out_size, ws_size);
            grid = -1; return; }
        int dev = 0, cus = 0, per_cu = 0;
        if (hipGetDevice(&dev) != hipSuccess || hipDeviceGetAttribute(&cus, hipDeviceAttributeMultiprocessorCount, dev) != hipSuccess) { fprintf(stderr, "kernel_launch: device query failed\n"); grid = -1; return; }
        if (hipFuncSetAttribute((const void*)fwd_kernel, hipFuncAttributeMaxDynamicSharedMemorySize, LDS_BYTES) != hipSuccess) { fprintf(stderr, "kernel_launch: hipFuncSetAttribute failed\n"); grid = -1; return; }
        if (hipOccupancyMaxActiveBlocksPerMultiprocessor(&per_cu, (const void*)fwd_kernel, NWAVES * 64, LDS_BYTES) != hipSuccess || per_cu < 1)
            fprintf(stderr, "kernel_launch: note: occupancy query reports %d workgroups per CU\n", per_cu);
        (void)hipGetLastError();
        grid = cus;
    }
    if (grid < 0) return;
    if (hipMemsetAsync((char*)d_ws + WS_CTL, 0, CTL_ZERO_BYTES, stream) != hipSuccess) { fprintf(stderr, "kernel_launch: memset failed\n"); return; }
    Args a{};
    for (int i = 0; i < 19; ++i) a.in[i] = (const float*)d_in[i];
    a.out = (float*)d_out; a.ws = (unsigned char*)d_ws;
    const int ph_end = MK_PH_HI < N_PHASES ? MK_PH_HI : N_PHASES;
#if MK_PER_PHASE
    for (int p = 0; p < ph_end; ++p) { a.ph_lo = p; a.ph_hi = p + 1; hipLaunchKernelGGL(fwd_kernel, dim3(grid), dim3(NWAVES * 64), LDS_BYTES, stream, a); }
#else
    a.ph_lo = 0; a.ph_hi = ph_end;
    hipLaunchKernelGGL(fwd_kernel, dim3(grid), dim3(NWAVES * 64), LDS_BYTES, stream, a);
#endif
    const hipError_t le = hipPeekAtLastError();
    if (le != hipSuccess) fprintf(stderr, "kernel_launch: launch failed: %s\n", hipGetErrorName(le));
}
```

```cpp
#include <hip/hip_runtime.h>
#include <hip/hip_bf16.h>
#include <cstdio>
#include <cstdint>
#include <cmath>
namespace pg8 {
#define PG8_LAS __attribute__((address_space(3)))
typedef unsigned short bf16_t;
typedef short bf16x8 __attribute__((ext_vector_type(8)));
typedef float f32x4 __attribute__((ext_vector_type(4)));
typedef unsigned u32x4 __attribute__((ext_vector_type(4)));
typedef int i32x4 __attribute__((ext_vector_type(4)));
typedef int i32x8 __attribute__((ext_vector_type(8)));
constexpr int BM = 256, BK = 64, HALF = 128, HTB = HALF * BK * 2  , STAGE_BYTES = 8 * HTB, NXCD = 8, WGM = 8;

__host__ __device__ __forceinline__ int lds_byte(int r, int c) { const int st = (r >> 4) * 2 + (c >> 5), rr = r & 15, cc = c & 31, ob = rr * 64 + cc * 2; return st * 1024 + (ob ^ (((ob >> 9) & 1) << 5)); }
__host__ __device__ __forceinline__ void stage_rc(int b, int& R, int& C) { const int st = b / 1024, sb = b % 1024, swz = sb ^ (((sb >> 9) & 1) << 5); R = (st >> 1) * 16 + swz / 64; C = (st & 1) * 32 + (swz % 64) / 2; }
__host__ __device__ __forceinline__ int perm32(int rho) { const int n = rho >> 4, i = rho & 15; return 8 * (i >> 2) + 4 * n + (i & 3); }

struct Unit { int pm, pn; };
struct Gemm { const bf16_t* A; const bf16_t* Bt; int M, N, K; };

struct StaticOrder {
    int nM, nN, nwg, G, c, pm0; const PG8_LAS int* te; unsigned estride;
    __device__ void init(int nM_, int nN_, int G_, int c_, int pm0_) { nM = nM_; nN = nN_; nwg = nM * nN; G = G_; c = c_; pm0 = pm0_; estride = 0; te = nullptr; }
    __device__ bool next(int i, Unit& u) const {
        const long L = (long)i * G + c; if (L >= nwg) return false;
        int wgid = (int)L; { const int q = nwg / NXCD, r = nwg % NXCD, xcd = wgid % NXCD, off = wgid / NXCD; wgid = (xcd < r ? xcd * (q + 1) : r * (q + 1) + (xcd - r) * q) + off; }
        const int nig = WGM * nN, gid = wgid / nig, fm = gid * WGM, gsz = (nM - fm) < WGM ? (nM - fm) : WGM;
        u.pm = pm0 + fm + ((wgid % nig) % gsz); u.pn = (wgid % nig) / gsz; return true;
    }
    __device__ __forceinline__ size_t bofs(const Unit& u) const { if (estride == 0) return 0; const int e = __builtin_amdgcn_readfirstlane(te[u.pm]); return (size_t)e * estride; }
    __device__ __forceinline__ void a_ready(const Unit&) const {}
    __device__ __forceinline__ void done(const Unit&) const {}
};

__device__ __forceinline__ unsigned cvt_pk_bf16(float lo, float hi) { unsigned r; asm volatile("v_cvt_pk_bf16_f32 %0, %1, %2" : "=v"(r) : "v"(lo), "v"(hi)); return r; }

struct EpiBf16 {
    static constexpr bool PERM = true, AFTER_DRAIN = false;
    bf16_t* O; int ldc;
    __device__ __forceinline__ void operator()(const f32x4 (&acc)[2][2][4][2], const Unit& u, int wr, int wc, int fr, int fq) const {
        const int row0 = u.pm * BM + wr * 64 + fr; const int col0 = u.pn * BM + wc * 32 + 8 * fq;
#pragma unroll
        for (int ai = 0; ai < 2; ++ai)
#pragma unroll
            for (int m = 0; m < 4; ++m) { bf16_t* rowp = O + (size_t)(row0 + ai * HALF + m * 16) * ldc + col0;
#pragma unroll
                for (int bj = 0; bj < 2; ++bj) { const f32x4 v0 = acc[ai][bj][m][0], v1 = acc[ai][bj][m][1];
                    u32x4 w; w.x = cvt_pk_bf16(v0[0], v0[1]); w.y = cvt_pk_bf16(v0[2], v0[3]); w.z = cvt_pk_bf16(v1[0], v1[1]); w.w = cvt_pk_bf16(v1[2], v1[3]);
                    *(u32x4*)(rowp + bj * HALF) = w; } }
    }
};
__device__ __forceinline__ unsigned cvt4_fp8(float a, float b, float c, float d) {
    a = __builtin_amdgcn_fmed3f(a, -448.f, 448.f); b = __builtin_amdgcn_fmed3f(b, -448.f, 448.f); c = __builtin_amdgcn_fmed3f(c, -448.f, 448.f); d = __builtin_amdgcn_fmed3f(d, -448.f, 448.f);
    int w = 0; w = __builtin_amdgcn_cvt_pk_fp8_f32(a, b, w, false); w = __builtin_amdgcn_cvt_pk_fp8_f32(c, d, w, true); return (unsigned)w; }
struct EpiBf16S {
    static constexpr bool PERM = true, AFTER_DRAIN = false;
    bf16_t* O; int ldc; float s;
    __device__ __forceinline__ void operator()(const f32x4 (&acc)[2][2][4][2], const Unit& u, int wr, int wc, int fr, int fq) const {
        const int row0 = u.pm * BM + wr * 64 + fr; const int col0 = u.pn * BM + wc * 32 + 8 * fq;
#pragma unroll
        for (int ai = 0; ai < 2; ++ai)
#pragma unroll
            for (int m = 0; m < 4; ++m) { bf16_t* rowp = O + (size_t)(row0 + ai * HALF + m * 16) * ldc + col0;
#pragma unroll
                for (int bj = 0; bj < 2; ++bj) { const f32x4 v0 = acc[ai][bj][m][0] * s, v1 = acc[ai][bj][m][1] * s;
                    u32x4 w; w.x = cvt_pk_bf16(v0[0], v0[1]); w.y = cvt_pk_bf16(v0[2], v0[3]); w.z = cvt_pk_bf16(v1[0], v1[1]); w.w = cvt_pk_bf16(v1[2], v1[3]);
                    *(u32x4*)(rowp + bj * HALF) = w; } }
    }
};
struct EpiBf16I8 {
    static constexpr bool PERM = true, AFTER_DRAIN = false;
    bf16_t* O; int ldc; const float* sa; const float* sw;
    __device__ __forceinline__ void operator()(const f32x4 (&acc)[2][2][4][2], const Unit& u, int wr, int wc, int fr, int fq) const {
        const int row0 = u.pm * BM + wr * 64 + fr; const int col0 = u.pn * BM + wc * 32 + 8 * fq;
        f32x4 sv[2][2];
#pragma unroll
        for (int bj = 0; bj < 2; ++bj)
#pragma unroll
            for (int n = 0; n < 2; ++n) sv[bj][n] = *(const f32x4*)(sw + col0 + bj * HALF + 4 * n);
#pragma unroll
        for (int ai = 0; ai < 2; ++ai)
#pragma unroll
            for (int m = 0; m < 4; ++m) { const int row = row0 + ai * HALF + m * 16; bf16_t* rowp = O + (size_t)row * ldc + col0; const float a = sa[row];
#pragma unroll
                for (int bj = 0; bj < 2; ++bj) { const f32x4 v0 = __builtin_convertvector(__builtin_bit_cast(i32x4, acc[ai][bj][m][0]), f32x4) * (sv[bj][0] * a), v1 = __builtin_convertvector(__builtin_bit_cast(i32x4, acc[ai][bj][m][1]), f32x4) * (sv[bj][1] * a);
                    u32x4 w; w.x = cvt_pk_bf16(v0[0], v0[1]); w.y = cvt_pk_bf16(v0[2], v0[3]); w.z = cvt_pk_bf16(v1[0], v1[1]); w.w = cvt_pk_bf16(v1[2], v1[3]);
                    *(u32x4*)(rowp + bj * HALF) = w; } }
    }
};
__device__ __forceinline__ float silu_mul(float g, float u) { const float e = __builtin_amdgcn_exp2f(-1.4426950408889634f * g); return g * __builtin_amdgcn_rcpf(1.0f + e) * u; }
struct EpiSwiGLU {
    static constexpr bool PERM = true, AFTER_DRAIN = false;
    bf16_t* O; int ldc;
    __device__ __forceinline__ void operator()(const f32x4 (&acc)[2][2][4][2], const Unit& u, int wr, int wc, int fr, int fq) const {
        const int row0 = u.pm * BM + wr * 64 + fr; const int col0 = u.pn * HALF + wc * 32 + 8 * fq;
#pragma unroll
        for (int ai = 0; ai < 2; ++ai)
#pragma unroll
            for (int m = 0; m < 4; ++m) { bf16_t* rowp = O + (size_t)(row0 + ai * HALF + m * 16) * ldc + col0;
                const f32x4 g0 = acc[ai][0][m][0], g1 = acc[ai][0][m][1], u0 = acc[ai][1][m][0], u1 = acc[ai][1][m][1];
                u32x4 w; w.x = cvt_pk_bf16(silu_mul(g0[0], u0[0]), silu_mul(g0[1], u0[1])); w.y = cvt_pk_bf16(silu_mul(g0[2], u0[2]), silu_mul(g0[3], u0[3]));
                w.z = cvt_pk_bf16(silu_mul(g1[0], u1[0]), silu_mul(g1[1], u1[1])); w.w = cvt_pk_bf16(silu_mul(g1[2], u1[2]), silu_mul(g1[3], u1[3]));
                *(u32x4*)rowp = w; }
    }
};
struct EpiSwiGLUI8 {
    static constexpr bool PERM = true, AFTER_DRAIN = false;
    bf16_t* O; int ldc; const float* sa; const float* sw;
    __device__ __forceinline__ void operator()(const f32x4 (&acc)[2][2][4][2], const Unit& u, int wr, int wc, int fr, int fq) const {
        const int row0 = u.pm * BM + wr * 64 + fr; const int col0 = u.pn * HALF + wc * 32 + 8 * fq; const int brow0 = u.pn * BM + wc * 32 + 8 * fq;
        const f32x4 sg0 = *(const f32x4*)(sw + brow0), sg1 = *(const f32x4*)(sw + brow0 + 4), su0 = *(const f32x4*)(sw + brow0 + HALF), su1 = *(const f32x4*)(sw + brow0 + HALF + 4);
#pragma unroll
        for (int ai = 0; ai < 2; ++ai)
#pragma unroll
            for (int m = 0; m < 4; ++m) { const int row = row0 + ai * HALF + m * 16; bf16_t* rowp = O + (size_t)row * ldc + col0; const float a = sa[row];
                const i32x4 ig0 = __builtin_bit_cast(i32x4, acc[ai][0][m][0]), ig1 = __builtin_bit_cast(i32x4, acc[ai][0][m][1]), iu0 = __builtin_bit_cast(i32x4, acc[ai][1][m][0]), iu1 = __builtin_bit_cast(i32x4, acc[ai][1][m][1]);
                f32x4 g0, g1, u0, u1;
#pragma unroll
                for (int e = 0; e < 4; ++e) { g0[e] = (float)ig0[e] * (a * sg0[e]); g1[e] = (float)ig1[e] * (a * sg1[e]); u0[e] = (float)iu0[e] * (a * su0[e]); u1[e] = (float)iu1[e] * (a * su1[e]); }
                u32x4 w; w.x = cvt_pk_bf16(silu_mul(g0[0], u0[0]), silu_mul(g0[1], u0[1])); w.y = cvt_pk_bf16(silu_mul(g0[2], u0[2]), silu_mul(g0[3], u0[3]));
                w.z = cvt_pk_bf16(silu_mul(g1[0], u1[0]), silu_mul(g1[1], u1[1])); w.w = cvt_pk_bf16(silu_mul(g1[2], u1[2]), silu_mul(g1[3], u1[3]));
                *(u32x4*)rowp = w; }
    }
};
struct EpiSwiGLU8 {
    static constexpr bool PERM = true, AFTER_DRAIN = false;
    unsigned char* O; int ldc; float sin, sout;
    __device__ __forceinline__ void operator()(const f32x4 (&acc)[2][2][4][2], const Unit& u, int wr, int wc, int fr, int fq) const {
        typedef unsigned u32x2 __attribute__((ext_vector_type(2)));
        const int row0 = u.pm * BM + wr * 64 + fr; const int col0 = u.pn * HALF + wc * 32 + 8 * fq;
#pragma unroll
        for (int ai = 0; ai < 2; ++ai)
#pragma unroll
            for (int m = 0; m < 4; ++m) { unsigned char* rowp = O + (size_t)(row0 + ai * HALF + m * 16) * ldc + col0;
                const f32x4 g0 = acc[ai][0][m][0] * sin, g1 = acc[ai][0][m][1] * sin, u0 = acc[ai][1][m][0] * (sin * sout), u1 = acc[ai][1][m][1] * (sin * sout);
                u32x2 w; w.x = cvt4_fp8(silu_mul(g0[0], u0[0]), silu_mul(g0[1], u0[1]), silu_mul(g0[2], u0[2]), silu_mul(g0[3], u0[3]));
                w.y = cvt4_fp8(silu_mul(g1[0], u1[0]), silu_mul(g1[1], u1[1]), silu_mul(g1[2], u1[2]), silu_mul(g1[3], u1[3]));
                *(u32x2*)rowp = w; }
    }
};
template <bool I8> struct EpiInProjT {
    static constexpr bool PERM = false, AFTER_DRAIN = false;
    unsigned char* ws; size_t oQA, oKA, oVA, oQB, oKB, oVB; const float* gq; const float* gk; float qscale; const float* sa; const float* sw;
    __device__ __forceinline__ void operator()(const f32x4 (&acc)[2][2][4][2], const Unit& u, int wr, int wc, int fr_, int fq_) const {
        int fr = fr_, fq = fq_; asm volatile("" : "+v"(fr), "+v"(fq));
        const int pn = u.pn; int kind, pitch, col0; bf16_t* base;
        if (pn < 2) { kind = 0; base = (bf16_t*)(ws + oQA); pitch = 512; col0 = 64 * (4 * pn + wc); }
        else if (pn == 2) { if (wc < 2) { kind = 1; base = (bf16_t*)(ws + oKA); pitch = 128; col0 = 64 * wc; } else { kind = 2; base = (bf16_t*)(ws + oVA); pitch = 128; col0 = 64 * (wc - 2); } }
        else if (pn < 5) { kind = 3; base = (bf16_t*)(ws + oQB); pitch = 512; col0 = 64 * (4 * (pn - 3) + wc); }
        else if (pn < 7) { kind = 4; base = (bf16_t*)(ws + oKB); pitch = 512; col0 = 64 * (4 * (pn - 5) + wc); }
        else { kind = 2; base = (bf16_t*)(ws + oVB); pitch = 512; col0 = 64 * (4 * (pn - 7) + wc); }
        const int row0 = u.pm * BM + wr * 64 + fr;
        bf16_t* outp = base + (size_t)row0 * pitch + col0 + 16 * fq;
        const float* swp = I8 ? sw + u.pn * BM + 32 * wc + 4 * fq : nullptr;
#define IP_ACC(ai, bj, m, n, sar) (I8 ? __builtin_convertvector(__builtin_bit_cast(i32x4, acc[ai][bj][m][n]), f32x4) * (*(const f32x4*)(swp + 128 * (bj) + 16 * (n)) * (sar)) : acc[ai][bj][m][n])
        const float L2T = 13.287712379549449f;
        if (kind == 2) {
#pragma unroll
            for (int ai = 0; ai < 2; ++ai)
#pragma unroll
                for (int m = 0; m < 4; ++m) { bf16_t* rp = outp + (size_t)(ai * HALF + m * 16) * pitch; const float sar = I8 ? sa[row0 + ai * HALF + m * 16] : 1.f;
#pragma unroll
                    for (int bj = 0; bj < 2; ++bj) { const f32x4 v0 = IP_ACC(ai, bj, m, 0, sar), v1 = IP_ACC(ai, bj, m, 1, sar);
                        u32x4 w; w.x = cvt_pk_bf16(v0[0], v0[1]); w.y = cvt_pk_bf16(v0[2], v0[3]); w.z = cvt_pk_bf16(v1[0], v1[1]); w.w = cvt_pk_bf16(v1[2], v1[3]);
                        *(u32x4*)(rp + 8 * bj) = w; } }
        } else if (kind <= 1) {
            const float* g = kind == 0 ? gq : gk; const float sc = kind == 0 ? qscale : 1.0f;
            float inv[4];
#pragma unroll
            for (int e = 0; e < 4; ++e) inv[e] = __builtin_amdgcn_exp2f(-(float)(4 * fq + e) * (L2T / 16.0f)) * 0.15915494309189535f;
#pragma unroll
            for (int ai = 0; ai < 2; ++ai)
#pragma unroll
                for (int m = 0; m < 4; ++m) { const int row = row0 + ai * HALF + m * 16; const int t = row & 8191; const float pr = (float)(t >> 6), pc = (float)(t & 63);
                    f32x4 v[2][2]; float ss = 0.f; const float sar = I8 ? sa[row] : 1.f;
#pragma unroll
                    for (int bj = 0; bj < 2; ++bj)
#pragma unroll
                        for (int n = 0; n < 2; ++n) { v[bj][n] = IP_ACC(ai, bj, m, n, sar); ss += (v[bj][n][0] * v[bj][n][0] + v[bj][n][1] * v[bj][n][1]) + (v[bj][n][2] * v[bj][n][2] + v[bj][n][3] * v[bj][n][3]); }
                    ss += __shfl_xor(ss, 16); ss += __shfl_xor(ss, 32);
                    const float rinv = __builtin_amdgcn_rsqf(ss * (1.0f / 64.0f) + 1e-6f) * sc;
#pragma unroll
                    for (int bj = 0; bj < 2; ++bj) { const float pos = bj == 0 ? pr : pc; const f32x4 gv0 = *(const f32x4*)(g + 32 * bj + 4 * fq), gv1 = *(const f32x4*)(g + 32 * bj + 16 + 4 * fq);
#pragma unroll
                        for (int e = 0; e < 4; ++e) { float rev = pos * inv[e]; rev = rev - __builtin_floorf(rev);
                            const float sn = __builtin_amdgcn_sinf(rev), cs = __builtin_amdgcn_cosf(rev);
                            float x1 = v[bj][0][e] * rinv * gv0[e], x2 = v[bj][1][e] * rinv * gv1[e]; asm volatile("" : "+v"(x1), "+v"(x2));
                            v[bj][0][e] = x1 * cs - x2 * sn; v[bj][1][e] = x2 * cs + x1 * sn; } }
                    bf16_t* rp = outp + (size_t)(ai * HALF + m * 16) * pitch;
#pragma unroll
                    for (int bj = 0; bj < 2; ++bj) { const f32x4 v0 = v[bj][0], v1 = v[bj][1];
                        u32x4 w; w.x = cvt_pk_bf16(v0[0], v0[1]); w.y = cvt_pk_bf16(v0[2], v0[3]); w.z = cvt_pk_bf16(v1[0], v1[1]); w.w = cvt_pk_bf16(v1[2], v1[3]);
                        *(u32x4*)(rp + 8 * bj) = w; } }
        } else {
            const float sc = kind == 3 ? qscale : 1.0f;
            float inv[2][4];
#pragma unroll
            for (int n = 0; n < 2; ++n)
#pragma unroll
                for (int e = 0; e < 4; ++e) inv[n][e] = __builtin_amdgcn_exp2f(-(float)(16 * n + 4 * fq + e) * (L2T / 32.0f)) * 0.15915494309189535f;
#pragma unroll
            for (int ai = 0; ai < 2; ++ai)
#pragma unroll
                for (int m = 0; m < 4; ++m) { const int row = row0 + ai * HALF + m * 16; const float pos = (float)(row & 8191);
                    f32x4 v[2][2]; const float sar = I8 ? sa[row] : 1.f;
#pragma unroll
                    for (int n = 0; n < 2; ++n) { const f32x4 a1_ = IP_ACC(ai, 0, m, n, sar), a2_ = IP_ACC(ai, 1, m, n, sar);
#pragma unroll
                        for (int e = 0; e < 4; ++e) { float rev = pos * inv[n][e]; rev = rev - __builtin_floorf(rev);
                            const float sn = __builtin_amdgcn_sinf(rev) * sc, cs = __builtin_amdgcn_cosf(rev) * sc;
                            float x1 = a1_[e], x2 = a2_[e]; asm volatile("" : "+v"(x1), "+v"(x2));
                            v[0][n][e] = x1 * cs - x2 * sn; v[1][n][e] = x2 * cs + x1 * sn; } }
                    bf16_t* rp = outp + (size_t)(ai * HALF + m * 16) * pitch;
#pragma unroll
                    for (int bj = 0; bj < 2; ++bj) { const f32x4 v0 = v[bj][0], v1 = v[bj][1];
                        u32x4 w; w.x = cvt_pk_bf16(v0[0], v0[1]); w.y = cvt_pk_bf16(v0[2], v0[3]); w.z = cvt_pk_bf16(v1[0], v1[1]); w.w = cvt_pk_bf16(v1[2], v1[3]);
                        *(u32x4*)(rp + 8 * bj) = w; } }
        }
    }
#undef IP_ACC
};
typedef EpiInProjT<false> EpiInProj;
typedef EpiInProjT<true> EpiInProjI8;


template <class Epi, class Sched, bool ALIGN_EPI = false, bool SP2 = false, bool F8 = false, bool I8 = false>
__device__ __forceinline__ void gemm_phase(PG8_LAS unsigned char* lds, const Gemm g, const Sched& S, const Epi& E, int wave_in) {
    int tid_; asm volatile("v_mbcnt_lo_u32_b32 %0, -1, 0\n\tv_mbcnt_hi_u32_b32 %0, -1, %0" : "=v"(tid_)); tid_ += wave_in * 64;
    const int tid = tid_, wid = __builtin_amdgcn_readfirstlane(tid >> 6), lane = tid & 63, wr = wid >> 2, wc = wid & 3, fr = lane & 15, fq = lane >> 4;
    const int K = g.K, nt = K / BK;
    unsigned voffA, voffB;
    { int R, C; stage_rc(tid * 16, R, C); const int Rb = Epi::PERM ? ((R & ~31) + perm32(R & 31)) : R; voffA = (unsigned)(R * K + C) * 2u; voffB = (unsigned)(Rb * K + C) * 2u; }
    const size_t qstep = (size_t)64 * K * 2;
    const size_t kstep = (size_t)(BK * 2);
    const size_t hstep = (size_t)HALF * K * 2;
    const size_t tstep = 2 * hstep;
    const unsigned ldsw = (unsigned)wid * 1024u;
    const int aoff = F8 ? lds_byte(wr * 64 + fr, fq * 16) : lds_byte(wr * 64 + fr, fq * 8), boff = F8 ? lds_byte(wc * 32 + fr, fq * 16) : lds_byte(wc * 32 + fr, fq * 8);
#define PG8_SA(b, h) (((b) * 2 + (h)) * HTB)
#define PG8_SB(b, h) ((4 + (b) * 2 + (h)) * HTB)
#define PG8_STAGE(bufoff, gbase, voff) do { _Pragma("unroll") for (int _i = 0; _i < 2; ++_i) \
        __builtin_amdgcn_global_load_lds((const unsigned*)((const char*)(gbase) + _i * qstep + (voff)), (PG8_LAS unsigned*)(lds + (bufoff) + ldsw + _i * 8192), 16, 0, 0); } while (0)
#define PG8_LDF(off) (*(const PG8_LAS bf16x8*)(lds + (off)))
#define PG8_LDA(dst, b, h) do { if constexpr (!F8) { _Pragma("unroll") for (int m = 0; m < 4; ++m) _Pragma("unroll") for (int k = 0; k < 2; ++k) dst[m][k] = PG8_LDF(PG8_SA(b, h) + aoff + m * 2048 + k * 1024); } \
        else { _Pragma("unroll") for (int m = 0; m < 4; ++m) dst##8[m] = *(const PG8_LAS i32x8*)(lds + PG8_SA(b, h) + aoff + m * 2048); } } while (0)
#define PG8_LDB(dst, b, h) do { if constexpr (!F8) { _Pragma("unroll") for (int n = 0; n < 2; ++n) _Pragma("unroll") for (int k = 0; k < 2; ++k) dst[n][k] = PG8_LDF(PG8_SB(b, h) + boff + n * 2048 + k * 1024); } \
        else { _Pragma("unroll") for (int n = 0; n < 2; ++n) dst##8[n] = *(const PG8_LAS i32x8*)(lds + PG8_SB(b, h) + boff + n * 2048); } } while (0)
#define PG8_MMA(ai, bj, At, Bt) do { __builtin_amdgcn_s_setprio(1); if constexpr (!F8) { _Pragma("unroll") for (int m = 0; m < 4; ++m) _Pragma("unroll") for (int n = 0; n < 2; ++n) _Pragma("unroll") for (int k = 0; k < 2; ++k) \
        { if constexpr (I8) acc[ai][bj][m][n] = __builtin_bit_cast(f32x4, __builtin_amdgcn_mfma_i32_16x16x64_i8(__builtin_bit_cast(i32x4, Bt[n][k]), __builtin_bit_cast(i32x4, At[m][k]), __builtin_bit_cast(i32x4, acc[ai][bj][m][n]), 0, 0, 0)); \
          else acc[ai][bj][m][n] = __builtin_amdgcn_mfma_f32_16x16x32_bf16(Bt[n][k], At[m][k], acc[ai][bj][m][n], 0, 0, 0); } } else { \
        _Pragma("unroll") for (int m = 0; m < 4; ++m) _Pragma("unroll") for (int n = 0; n < 2; ++n) \
        asm volatile("v_mfma_scale_f32_16x16x128_f8f6f4 %0, %1, %2, %0, %3, %3 op_sel_hi:[0,0,0]" : "+v"(acc[ai][bj][m][n]) : "v"(Bt##8[n]), "v"(At##8[m]), "v"(f8scale)); } \
        __builtin_amdgcn_s_setprio(0); } while (0)
#define PG8_CAT(x, y) __builtin_shufflevector(__builtin_bit_cast(i32x4, x), __builtin_bit_cast(i32x4, y), 0, 1, 2, 3, 4, 5, 6, 7)
#define PG8_WAIT_V(n) asm volatile("s_waitcnt vmcnt(" #n ")" ::: "memory")
#define PG8_WAIT_L(n) asm volatile("s_waitcnt lgkmcnt(" #n ")" ::: "memory")
#define PG8_BAR __builtin_amdgcn_s_barrier()
#define PG8_SCHED __builtin_amdgcn_sched_barrier(0)
    Unit cur, nxt; int ui = 0;
    if (!S.next(0, cur)) return;
    f32x4 acc[2][2][4][2];
#pragma unroll
    for (int a = 0; a < 2; ++a)
#pragma unroll
        for (int b = 0; b < 2; ++b)
#pragma unroll
            for (int m = 0; m < 4; ++m)
#pragma unroll
                for (int n = 0; n < 2; ++n) acc[a][b][m][n] = (f32x4){0.f, 0.f, 0.f, 0.f};
    const int f8scale = 0x7f7f7f7f;
    bf16x8 At[4][2], B0[2][2], B1[2][2]; i32x8 At8[4], B08[2], B18[2];
    const char* cA = (const char*)g.A + (size_t)cur.pm * tstep; const char* cB = (const char*)g.Bt + S.bofs(cur) + (size_t)cur.pn * tstep;
    S.a_ready(cur);
    if constexpr (SP2) {
        PG8_STAGE(PG8_SB(0, 0), cB, voffB); PG8_STAGE(PG8_SB(0, 1), cB + hstep, voffB); PG8_STAGE(PG8_SA(0, 0), cA, voffA); PG8_STAGE(PG8_SA(0, 1), cA + hstep, voffA);
        if (wr == 1) PG8_BAR;
        PG8_WAIT_V(2); PG8_BAR;
        PG8_STAGE(PG8_SB(1, 0), cB + kstep, voffB); PG8_STAGE(PG8_SA(1, 0), cA + kstep, voffA); PG8_STAGE(PG8_SB(1, 1), cB + hstep + kstep, voffB);
        PG8_WAIT_V(6); PG8_BAR;
    } else {
        PG8_STAGE(PG8_SB(0, 0), cB, voffB); PG8_STAGE(PG8_SA(0, 0), cA, voffA); PG8_STAGE(PG8_SB(0, 1), cB + hstep, voffB); PG8_STAGE(PG8_SA(0, 1), cA + hstep, voffA);
        if (wr == 1) PG8_BAR;
        PG8_WAIT_V(4); PG8_BAR;
        PG8_STAGE(PG8_SB(1, 0), cB + kstep, voffB); PG8_STAGE(PG8_SA(1, 0), cA + kstep, voffA); PG8_STAGE(PG8_SB(1, 1), cB + hstep + kstep, voffB);
        PG8_WAIT_V(6); PG8_BAR;
    }
    for (;;) {
        const bool has_next = S.next(ui + 1, nxt);
        const char* nA = has_next ? (const char*)g.A + (size_t)nxt.pm * tstep : cA; const char* nB = has_next ? (const char*)g.Bt + S.bofs(nxt) + (size_t)nxt.pn * tstep : cB;
#pragma nounroll
        for (int t = 0; t < nt; t += 2) {
            const bool last = (t == nt - 2);
            const char* a1 = cA + (size_t)(t + 1) * kstep;
            const char* a2 = last ? nA : cA + (size_t)(t + 2) * kstep; const char* b2 = last ? nB : cB + (size_t)(t + 2) * kstep;
            const char* a3 = a2 + kstep; const char* b3 = b2 + kstep;
            if (last && has_next) S.a_ready(nxt);
            if constexpr (SP2) {
            PG8_LDB(B0, 0, 0); PG8_LDB(B1, 0, 1); PG8_SCHED; PG8_LDA(At, 0, 0); PG8_STAGE(PG8_SA(1, 1), a1 + hstep, voffA);
            PG8_WAIT_V(8); PG8_WAIT_L(0); PG8_BAR; PG8_MMA(0, 0, At, B0); PG8_MMA(0, 1, At, B1); PG8_BAR; PG8_SCHED;
            PG8_LDA(At, 0, 1); PG8_STAGE(PG8_SB(0, 0), b2, voffB); PG8_STAGE(PG8_SB(0, 1), b2 + hstep, voffB); PG8_STAGE(PG8_SA(0, 0), a2, voffA);
            PG8_WAIT_V(8); PG8_WAIT_L(0); PG8_BAR; PG8_MMA(1, 0, At, B0); PG8_MMA(1, 1, At, B1); PG8_BAR; PG8_SCHED;
            PG8_LDB(B0, 1, 0); PG8_LDB(B1, 1, 1); PG8_SCHED; PG8_LDA(At, 1, 0); PG8_STAGE(PG8_SA(0, 1), a2 + hstep, voffA);
            PG8_WAIT_V(8); PG8_WAIT_L(0); PG8_BAR; PG8_MMA(0, 0, At, B0); PG8_MMA(0, 1, At, B1); PG8_BAR; PG8_SCHED;
            PG8_LDA(At, 1, 1); PG8_STAGE(PG8_SB(1, 0), b3, voffB); PG8_STAGE(PG8_SB(1, 1), b3 + hstep, voffB); PG8_STAGE(PG8_SA(1, 0), a3, voffA);
            PG8_WAIT_V(8); PG8_WAIT_L(0); PG8_BAR; PG8_MMA(1, 0, At, B0); PG8_MMA(1, 1, At, B1); PG8_BAR; PG8_SCHED;
            } else {
            PG8_LDB(B0, 0, 0); PG8_SCHED; PG8_LDA(At, 0, 0); PG8_STAGE(PG8_SA(1, 1), a1 + hstep, voffA);
            PG8_WAIT_L(8); PG8_BAR; PG8_WAIT_L(0); PG8_MMA(0, 0, At, B0); PG8_BAR; PG8_SCHED;
            PG8_LDB(B1, 0, 1); PG8_STAGE(PG8_SB(0, 0), b2, voffB);
            PG8_BAR; PG8_WAIT_L(0); PG8_MMA(0, 1, At, B1); PG8_BAR;
            PG8_LDA(At, 0, 1); PG8_STAGE(PG8_SA(0, 0), a2, voffA);
            PG8_BAR; PG8_WAIT_L(0); PG8_MMA(1, 0, At, B0); PG8_BAR; PG8_SCHED;
            PG8_STAGE(PG8_SB(0, 1), b2 + hstep, voffB);
            PG8_WAIT_V(6); PG8_BAR; PG8_MMA(1, 1, At, B1); PG8_BAR;
            PG8_LDB(B0, 1, 0); PG8_SCHED; PG8_LDA(At, 1, 0); PG8_STAGE(PG8_SA(0, 1), a2 + hstep, voffA);
            PG8_WAIT_L(8); PG8_BAR; PG8_WAIT_L(0); PG8_MMA(0, 0, At, B0); PG8_BAR; PG8_SCHED;
            PG8_LDB(B1, 1, 1); PG8_STAGE(PG8_SB(1, 0), b3, voffB);
            PG8_BAR; PG8_WAIT_L(0); PG8_MMA(0, 1, At, B1); PG8_BAR;
            PG8_LDA(At, 1, 1); PG8_STAGE(PG8_SA(1, 0), a3, voffA);
            PG8_BAR; PG8_WAIT_L(0); PG8_MMA(1, 0, At, B0); PG8_BAR; PG8_SCHED;
            PG8_STAGE(PG8_SB(1, 1), b3 + hstep, voffB);
            PG8_WAIT_V(6); PG8_BAR; PG8_MMA(1, 1, At, B1); PG8_BAR;
            }
        }
        if constexpr (F8) { asm volatile("s_nop 15\n\ts_nop 15\n\ts_nop 15\n\ts_nop 15" ::: "memory");
            _Pragma("unroll") for (int m = 0; m < 4; ++m) asm volatile("" :: "v"(At8[m]));
            _Pragma("unroll") for (int n = 0; n < 2; ++n) asm volatile("" :: "v"(B08[n]), "v"(B18[n])); }
        if constexpr (ALIGN_EPI) { if (wr == 0) PG8_BAR; }
        if constexpr (!Epi::AFTER_DRAIN) { E(acc, cur, wr, wc, fr, fq); S.done(cur); }
        if (!has_next) break;
#pragma unroll
        for (int a = 0; a < 2; ++a)
#pragma unroll
            for (int b = 0; b < 2; ++b)
#pragma unroll
                for (int m = 0; m < 4; ++m)
#pragma unroll
                    for (int n = 0; n < 2; ++n) acc[a][b][m][n] = (f32x4){0.f, 0.f, 0.f, 0.f};
        cur = nxt; cA = nA; cB = nB; ++ui;
        if constexpr (ALIGN_EPI) { if (wr == 1) PG8_BAR; }
    }
    PG8_WAIT_V(0);
    if constexpr (!ALIGN_EPI) { if (wr == 0) PG8_BAR; }
    PG8_BAR;
    if constexpr (Epi::AFTER_DRAIN) { E.fused(acc, cur, wr, wc, fr, fq, lds, wid, lane); S.done(cur); }
#undef PG8_SA
#undef PG8_SB
#undef PG8_STAGE
#undef PG8_LDA
#undef PG8_LDF
#undef PG8_LDB
#undef PG8_MMA
#undef PG8_CAT
#undef PG8_WAIT_V
#undef PG8_WAIT_L
#undef PG8_BAR
#undef PG8_SCHED
}
}
namespace attn_body {
using bf16=__hip_bfloat16;
using bf16x8=__attribute__((ext_vector_type(8)))short;
using s16x4=__attribute__((ext_vector_type(4)))short;
using f32x16=__attribute__((ext_vector_type(16)))float;
using u32x4=__attribute__((ext_vector_type(4)))unsigned;
constexpr int SEQ=8192,D=64;
constexpr int NW=8,QBLK=32,QB=QBLK*NW,KVBLK=64,NQB=SEQ/QB;
constexpr int ATTN_UNIT_ROWS=QB;
__device__ __forceinline__ int crow(int r,int hi){return (r&3)+8*(r>>2)+4*hi;}
#define SBAR() __builtin_amdgcn_sched_barrier(0)
__device__ __forceinline__ void cmask(f32x16&p0,f32x16&p1,int jb,int qrel,int hi){
  const float NEG=-INFINITY; int kb=64*jb+4*hi;
  #pragma unroll
  for(int r=0;r<16;++r){int kv=kb+(r&3)+8*(r>>2); if(kv>qrel)p0[r]=NEG; if(kv+32>qrel)p1[r]=NEG;}
}

constexpr int NSLOT=3, SLOTB=8192;
constexpr int LDS_K=0, LDS_V=NSLOT*SLOTB, LDS_WS=LDS_V+NSLOT*2*SLOTB, LDS_OST=LDS_WS+NW*64*4, LDS_BYTES=LDS_OST+NW*4096;
constexpr float C2=0.125f*1.4426950408889634f;
__device__ __forceinline__ void glds16(const void*gsrc,unsigned lds_dst){unsigned keep;
  asm volatile("s_mov_b32 %0, m0\n\ts_mov_b32 m0, %2\n\ts_nop 0\n\tglobal_load_lds_dwordx4 %1, off\n\ts_mov_b32 m0, %0":"=&s"(keep):"v"(gsrc),"s"(lds_dst):"memory");}
__device__ __forceinline__ float max3f(float a,float b,float c){float r;asm("v_max3_f32 %0, %1, %2, %3":"=v"(r):"v"(a),"v"(b),"v"(c));return r;}
__device__ __forceinline__ float max2f(float a,float b){float r;asm("v_max_f32_e32 %0, %1, %2":"=v"(r):"v"(a),"v"(b));return r;}
__device__ __forceinline__ float fadd_s(float a,float b){float r;asm("v_add_f32_e32 %0, %1, %2":"=v"(r):"v"(a),"v"(b));return r;}
__device__ __forceinline__ float fsub_s(float a,float b){float r;asm("v_sub_f32_e32 %0, %1, %2":"=v"(r):"v"(a),"v"(b));return r;}
typedef float f32x2_t __attribute__((ext_vector_type(2))); typedef __bf16 bf16x2_t __attribute__((ext_vector_type(2)));
__device__ __forceinline__ unsigned cvtpk_s(float lo,float hi){f32x2_t v={lo,hi};bf16x2_t b=__builtin_convertvector(v,bf16x2_t);return __builtin_bit_cast(unsigned,b);}
#define WAIT_BAR(N) asm volatile("s_waitcnt vmcnt(" #N ") lgkmcnt(0)\n\ts_barrier":::"memory")

__device__ __forceinline__ void qkt(f32x16&p0,f32x16&p1,const char*Kslot,const bf16x8*qr,const f32x16&negm,int r32,int hi){
  const char*kb=Kslot+hi*1024+r32*16;
  #pragma unroll
  for(int d0=0;d0<4;++d0){
    const bf16x8 b0=*reinterpret_cast<const bf16x8*>(kb+d0*2048);
    const bf16x8 b1=*reinterpret_cast<const bf16x8*>(kb+d0*2048+512);
    if(d0==0){p0=__builtin_amdgcn_mfma_f32_32x32x16_bf16(b0,qr[0],negm,0,0,0);p1=__builtin_amdgcn_mfma_f32_32x32x16_bf16(b1,qr[0],negm,0,0,0);}
    else{p0=__builtin_amdgcn_mfma_f32_32x32x16_bf16(b0,qr[d0],p0,0,0,0);p1=__builtin_amdgcn_mfma_f32_32x32x16_bf16(b1,qr[d0],p1,0,0,0);}}
}
typedef __attribute__((address_space(3))) const char* lds_cptr;
typedef short v4i16_t __attribute__((ext_vector_type(4)));
__device__ __forceinline__ void kload8(bf16x8*kf,lds_cptr kp){
  kf[0]=*(const __attribute__((address_space(3))) bf16x8*)(kp);      kf[1]=*(const __attribute__((address_space(3))) bf16x8*)(kp+512);
  kf[2]=*(const __attribute__((address_space(3))) bf16x8*)(kp+2048); kf[3]=*(const __attribute__((address_space(3))) bf16x8*)(kp+2560);
  kf[4]=*(const __attribute__((address_space(3))) bf16x8*)(kp+4096); kf[5]=*(const __attribute__((address_space(3))) bf16x8*)(kp+4608);
  kf[6]=*(const __attribute__((address_space(3))) bf16x8*)(kp+6144); kf[7]=*(const __attribute__((address_space(3))) bf16x8*)(kp+6656);
}
__device__ __forceinline__ void kload2(bf16x8*kf,lds_cptr kp,int j){ kf[2*j]=*(const __attribute__((address_space(3))) bf16x8*)(kp+j*2048); kf[2*j+1]=*(const __attribute__((address_space(3))) bf16x8*)(kp+j*2048+512); }
__device__ __forceinline__ s16x4 vtr(lds_cptr p){ return __builtin_bit_cast(s16x4,__builtin_amdgcn_ds_read_tr16_b64_v4i16((__attribute__((address_space(3))) v4i16_t*)p)); }
__device__ __forceinline__ float rowmax(const f32x16&p0,const f32x16&p1){
  float a=max3f(p0[0],p0[1],p1[0]),b=max3f(p0[2],p0[3],p1[1]);a=max3f(a,p1[2],p1[3]);
  #pragma unroll
  for(int r=4;r<16;r+=4){a=max3f(a,p0[r],p0[r+1]);b=max3f(b,p0[r+2],p0[r+3]);a=max3f(a,p1[r],p1[r+1]);b=max3f(b,p1[r+2],p1[r+3]);}
  const float m=max2f(a,b);
  auto rr=__builtin_amdgcn_permlane32_swap(__float_as_uint(m),__float_as_uint(m),false,false);
  return max2f(__uint_as_float(rr[0]),__uint_as_float(rr[1]));
}
template<int NOB> __device__ __forceinline__ void pv(f32x16*o,int vb,bf16x8 pa0,bf16x8 pa1,bf16x8 pa2,bf16x8 pa3){
  #pragma unroll
  for(int d0=0;d0<NOB;++d0){s16x4 lo[4],hi[4];
    #pragma unroll
    for(int ks=0;ks<4;++ks){
      asm volatile("ds_read_b64_tr_b16 %0,%1 offset:%c2":"=&v"(lo[ks]):"v"(vb),"i"(d0*4096+ks*1024):"memory");
      asm volatile("ds_read_b64_tr_b16 %0,%1 offset:%c2":"=&v"(hi[ks]):"v"(vb),"i"(d0*4096+ks*1024+512):"memory");}
    asm volatile("s_waitcnt lgkmcnt(0)":::"memory");SBAR();
    #define PK(k) (bf16x8){lo[k][0],lo[k][1],lo[k][2],lo[k][3],hi[k][0],hi[k][1],hi[k][2],hi[k][3]}
    o[d0]=__builtin_amdgcn_mfma_f32_32x32x16_bf16(pa0,PK(0),o[d0],0,0,0);
    o[d0]=__builtin_amdgcn_mfma_f32_32x32x16_bf16(pa1,PK(1),o[d0],0,0,0);
    o[d0]=__builtin_amdgcn_mfma_f32_32x32x16_bf16(pa2,PK(2),o[d0],0,0,0);
    o[d0]=__builtin_amdgcn_mfma_f32_32x32x16_bf16(pa3,PK(3),o[d0],0,0,0);
    #undef PK
  }
}

#ifndef ATTN_STORE16
#define ATTN_STORE16(p,v) (*(u32x4*)(p)=(v))
#endif
template<int THRL,int DV> __device__ __forceinline__ void attn_unit(const bf16*Qu,int QP,const bf16*__restrict__ Kh,int KP,const bf16*__restrict__ Vh,int VP,bf16*Ou,int OP,char*shm,int wave_in){
  int tid_; asm volatile("v_mbcnt_lo_u32_b32 %0, -1, 0\n\tv_mbcnt_hi_u32_b32 %0, -1, %0":"=v"(tid_)); tid_+=wave_in*64; const int tid=tid_,lane=tid&63,r32=lane&31,hi=lane>>5; const int wid=__builtin_amdgcn_readfirstlane(tid>>6);
  const bf16*Qw=Qu+(long)(wid*QBLK)*QP;
  constexpr int VS=DV/64, NOB=DV/32;
  const unsigned lds0=(unsigned)(uintptr_t)shm;
  float*wsf=(float*)(shm+LDS_WS)+wid*64;
  const bf16*ksrc=Kh+(long)lane*KP+wid*8;
  const bf16*vsrc=Vh+(long)(16*(wid&3)+(lane>>2))*VP+(wid>>2)*32+(lane&3)*8;
  const unsigned kdst=lds0+LDS_K+wid*1024, vdst=lds0+LDS_V+wid*1024;
  #define DMA_K(t,slot) glds16(ksrc+(long)(t)*KVBLK*KP,(unsigned)__builtin_amdgcn_readfirstlane(kdst+(slot)))
  #define DMA_V(t,slot) do{ glds16(vsrc+(long)(t)*KVBLK*VP,(unsigned)__builtin_amdgcn_readfirstlane(vdst+VS*(slot))); if constexpr(VS==2) glds16(vsrc+(long)(t)*KVBLK*VP+64,(unsigned)__builtin_amdgcn_readfirstlane(vdst+VS*(slot)+8192)); }while(0)
  const int vb0=(int)(lds0+LDS_V)+((lane>>4)&1)*32+(lane&3)*8+(4*hi+((lane&15)>>2))*64;
  const char*Kbase=shm+LDS_K; bf16x8 kf[8];
  const lds_cptr shm3=(lds_cptr)shm; const lds_cptr kp0=shm3+LDS_K+hi*1024+r32*16; const lds_cptr vp0=shm3+LDS_V+((lane>>4)&1)*32+(lane&3)*8+(4*hi+((lane&15)>>2))*64;
  constexpr int NT=SEQ/KVBLK;
  DMA_K(0,0);DMA_V(0,0);DMA_K(1,SLOTB);
  bf16x8 qr[4];
  #pragma unroll
  for(int d0=0;d0<4;++d0)qr[d0]=*reinterpret_cast<const bf16x8*>(&Qw[(long)r32*QP+d0*16+hi*8]);
  float mhat=0.f,l_reg=0.f;f32x16 o[NOB];
  #pragma unroll
  for(int d_=0;d_<NOB;++d_)o[d_]=f32x16{};
  f32x16 negm=f32x16{};asm volatile("":"+v"(negm));
  #define CMASK(P0,P1,t) do{}while(0)
  bool resc=false;
  #define START(P0,P1) do{ const float rm=rowmax(P0,P1); resc=false; \
    { const float dl=rm; mhat=fadd_s(mhat,dl); \
      _Pragma("unroll") for(int r=0;r<16;++r){P0[r]=fsub_s(P0[r],dl);P1[r]=fsub_s(P1[r],dl);} \
      _Pragma("unroll") for(int r=0;r<16;++r)negm[r]=-mhat; asm volatile("":"+v"(negm)); } \
    _Pragma("unroll") for(int r=0;r<16;++r)P0[r]=__builtin_amdgcn_exp2f(P0[r]); }while(0)
  #define RESC() do{ if(resc){ asm volatile("s_waitcnt lgkmcnt(0)":::"memory"); \
      _Pragma("unroll") for(int d_=0;d_<NOB;++d_) _Pragma("unroll") for(int r=0;r<16;++r)o[d_][r]*=wsf[crow(r,hi)]; } }while(0)
  f32x16 pA0,pA1,pB0,pB1;
  int sl_prev=0,sl_cur=0,sl_next=SLOTB;
  #define ROT() do{sl_prev=sl_cur;sl_cur=sl_next;sl_next=(sl_next==(NSLOT-1)*SLOTB)?0:sl_next+SLOTB;}while(0)
  #define WBV(N,N2) do{ if constexpr(VS==2){WAIT_BAR(N2);} else {WAIT_BAR(N);} }while(0)
  DMA_K(2,2*SLOTB);
  WAIT_BAR(3);
  qkt(pA0,pA1,Kbase,qr,negm,r32,hi);asm volatile("s_nop 15\n\ts_nop 7":"+v"(pA0),"+v"(pA1));CMASK(pA0,pA1,0);
  START(pA0,pA1);
  _Pragma("unroll") for(int r=0;r<16;++r)pA1[r]=__builtin_amdgcn_exp2f(pA1[r]);
  WAIT_BAR(0);
  DMA_K(3,0);DMA_V(1,SLOTB);
  ROT();
  kload8(kf,kp0+sl_cur);
  WBV(2,3);
  s16x4 vlo[8],vhi[8]; u32x4 pw0,pw1,pw2,pw3;
  #define PKW(P,B) cvtpk_s(P[B],P[B+1])
  #define PAF(k) __builtin_bit_cast(bf16x8,pw##k)
  #define VFR(i) (bf16x8){vlo[i][0],vlo[i][1],vlo[i][2],vlo[i][3],vhi[i][0],vhi[i][1],vhi[i][2],vhi[i][3]}
  #define PIN(x) asm volatile("":"+v"(x))
  #define MX3(a,b,c) __builtin_fmaxf(__builtin_fmaxf((a),(b)),(c))
  #define GAPA(MF,A0,A1,A2,A3,W0,W1,PW) do{ MF; sacc+=A0; sacc+=A1; sacc+=A2; sacc+=A3; PIN(sacc); W0; W1; PIN(PW); SBAR(); }while(0)
  #define EX(v) __builtin_amdgcn_exp2f(v)
  #define GAPB(MF,X,B) do{ MF; X[B]=EX(X[B]); X[B+1]=EX(X[B+1]); X[B+2]=EX(X[B+2]); X[B+3]=EX(X[B+3]); PIN(X); SBAR(); }while(0)
  #define GAPB2(MF,RD,X,B) do{ MF; RD; X[B]=EX(X[B]); X[B+1]=EX(X[B+1]); PIN(X); SBAR(); }while(0)
  #define VRD2(i) do{ vlo[i]=vtr(vp_+(8192+((i)>>2)*4096+((i)&3)*1024)); vhi[i]=vtr(vp_+(8192+((i)>>2)*4096+((i)&3)*1024+512)); }while(0)
  #define VRD(i) do{ vlo[i]=vtr(vp_+(((i)>>2)*4096+((i)&3)*1024)); vhi[i]=vtr(vp_+(((i)>>2)*4096+((i)&3)*1024+512)); }while(0)
  #define KRD(G,j) do{ if(G){ kload2(kf,kp0+sl_next,j); SBAR(); } }while(0)
  #define STEP(C0,C1,P0,P1,t,GK,GV,GL) do{ SBAR(); \
    const lds_cptr vp_=vp0+VS*sl_prev; \
    VRD(0); SBAR(); float sacc=(P0[0]+P0[1]); \
    GAPA(C0=__builtin_amdgcn_mfma_f32_32x32x16_bf16(kf[0],qr[0],negm,0,0,0), P0[2],P0[3],P0[4],P0[5],     pw0[0]=PKW(P0,0), pw0[1]=PKW(P0,2), pw0); \
    VRD(4); SBAR(); GAPA(C1=__builtin_amdgcn_mfma_f32_32x32x16_bf16(kf[1],qr[0],negm,0,0,0), P0[6],P0[7],P0[8],P0[9],     pw0[2]=PKW(P0,4), pw0[3]=PKW(P0,6), pw0); \
    VRD(1); SBAR(); GAPA(C0=__builtin_amdgcn_mfma_f32_32x32x16_bf16(kf[2],qr[1],C0,0,0,0),   P0[10],P0[11],P0[12],P0[13], pw1[0]=PKW(P0,8), pw1[1]=PKW(P0,10), pw1); \
    VRD(5); SBAR(); GAPA(C1=__builtin_amdgcn_mfma_f32_32x32x16_bf16(kf[3],qr[1],C1,0,0,0),   P0[14],P0[15],P1[0],P1[1],   pw1[2]=PKW(P0,12),pw1[3]=PKW(P0,14), pw1); \
    VRD(2); SBAR(); GAPA(C0=__builtin_amdgcn_mfma_f32_32x32x16_bf16(kf[4],qr[2],C0,0,0,0),   P1[2],P1[3],P1[4],P1[5],     pw2[0]=PKW(P1,0), pw2[1]=PKW(P1,2), pw2); \
    VRD(6); SBAR(); GAPA(C1=__builtin_amdgcn_mfma_f32_32x32x16_bf16(kf[5],qr[2],C1,0,0,0),   P1[6],P1[7],P1[8],P1[9],     pw2[2]=PKW(P1,4), pw2[3]=PKW(P1,6), pw2); \
    VRD(3); SBAR(); GAPA(C0=__builtin_amdgcn_mfma_f32_32x32x16_bf16(kf[6],qr[3],C0,0,0,0),   P1[10],P1[11],P1[12],P1[13], pw3[0]=PKW(P1,8), pw3[1]=PKW(P1,10), pw3); \
    VRD(7); SBAR(); GAPA(C1=__builtin_amdgcn_mfma_f32_32x32x16_bf16(kf[7],qr[3],C1,0,0,0),   P1[14],P1[15],0.f,0.f,       pw3[2]=PKW(P1,12),pw3[3]=PKW(P1,14), pw3); \
    l_reg+=sacc; \
    if(GK){DMA_K((t)+3,sl_cur);} if(GV){DMA_V((t)+1,sl_next);} \
    CMASK(C0,C1,t); \
    { float a=MX3(C0[0],C0[1],C1[0]),b=MX3(C0[2],C0[3],C1[1]); a=MX3(a,C1[2],C1[3]); \
      _Pragma("unroll") for(int r=4;r<16;r+=4){a=MX3(a,C0[r],C0[r+1]);b=MX3(b,C0[r+2],C0[r+3]);a=MX3(a,C1[r],C1[r+1]);b=MX3(b,C1[r+2],C1[r+3]);} \
      float rm=__builtin_fmaxf(a,b); { auto rr=__builtin_amdgcn_permlane32_swap(__float_as_uint(rm),__float_as_uint(rm),false,false); rm=__builtin_fmaxf(__uint_as_float(rr[0]),__uint_as_float(rr[1])); } \
      resc=false; \
      if(__builtin_expect(__any(rm>(float)THRL),0)){ const float dl=__builtin_fmaxf(rm,0.f); mhat+=dl; \
        _Pragma("unroll") for(int r=0;r<16;++r){C0[r]-=dl;C1[r]-=dl;} \
        _Pragma("unroll") for(int r=0;r<16;++r)negm[r]=-mhat; asm volatile("":"+v"(negm)); \
        const float f=__builtin_amdgcn_exp2f(-dl); l_reg*=f; if(hi==0)wsf[r32]=f; resc=true; } } \
    SBAR(); \
    if constexpr(VS==1){ \
    GAPB(o[0]=__builtin_amdgcn_mfma_f32_32x32x16_bf16(PAF(0),VFR(0),o[0],0,0,0), C0,0); \
    GAPB(o[1]=__builtin_amdgcn_mfma_f32_32x32x16_bf16(PAF(0),VFR(4),o[1],0,0,0), C0,4); \
    KRD(GL,0); GAPB(o[0]=__builtin_amdgcn_mfma_f32_32x32x16_bf16(PAF(1),VFR(1),o[0],0,0,0), C0,8); \
    KRD(GL,1); GAPB(o[1]=__builtin_amdgcn_mfma_f32_32x32x16_bf16(PAF(1),VFR(5),o[1],0,0,0), C0,12); \
    KRD(GL,2); GAPB(o[0]=__builtin_amdgcn_mfma_f32_32x32x16_bf16(PAF(2),VFR(2),o[0],0,0,0), C1,0); \
    KRD(GL,3); GAPB(o[1]=__builtin_amdgcn_mfma_f32_32x32x16_bf16(PAF(2),VFR(6),o[1],0,0,0), C1,4); \
    GAPB(o[0]=__builtin_amdgcn_mfma_f32_32x32x16_bf16(PAF(3),VFR(3),o[0],0,0,0), C1,8); \
    GAPB(o[1]=__builtin_amdgcn_mfma_f32_32x32x16_bf16(PAF(3),VFR(7),o[1],0,0,0), C1,12); \
    } else { \
    GAPB2(o[0]=__builtin_amdgcn_mfma_f32_32x32x16_bf16(PAF(0),VFR(0),o[0],0,0,0), VRD2(0), C0,0); \
    GAPB2(o[1]=__builtin_amdgcn_mfma_f32_32x32x16_bf16(PAF(0),VFR(4),o[1],0,0,0), VRD2(4), C0,2); \
    GAPB2(o[0]=__builtin_amdgcn_mfma_f32_32x32x16_bf16(PAF(1),VFR(1),o[0],0,0,0), VRD2(1), C0,4); \
    GAPB2(o[1]=__builtin_amdgcn_mfma_f32_32x32x16_bf16(PAF(1),VFR(5),o[1],0,0,0), VRD2(5), C0,6); \
    GAPB2(o[0]=__builtin_amdgcn_mfma_f32_32x32x16_bf16(PAF(2),VFR(2),o[0],0,0,0), VRD2(2), C0,8); \
    GAPB2(o[1]=__builtin_amdgcn_mfma_f32_32x32x16_bf16(PAF(2),VFR(6),o[1],0,0,0), VRD2(6), C0,10); \
    GAPB2(o[0]=__builtin_amdgcn_mfma_f32_32x32x16_bf16(PAF(3),VFR(3),o[0],0,0,0), VRD2(3), C0,12); \
    GAPB2(o[1]=__builtin_amdgcn_mfma_f32_32x32x16_bf16(PAF(3),VFR(7),o[1],0,0,0), VRD2(7), C0,14); \
    GAPB2(o[2]=__builtin_amdgcn_mfma_f32_32x32x16_bf16(PAF(0),VFR(0),o[2],0,0,0), (void)0, C1,0); \
    GAPB2(o[3]=__builtin_amdgcn_mfma_f32_32x32x16_bf16(PAF(0),VFR(4),o[3],0,0,0), (void)0, C1,2); \
    KRD(GL,0); GAPB2(o[2]=__builtin_amdgcn_mfma_f32_32x32x16_bf16(PAF(1),VFR(1),o[2],0,0,0), (void)0, C1,4); \
    KRD(GL,1); GAPB2(o[3]=__builtin_amdgcn_mfma_f32_32x32x16_bf16(PAF(1),VFR(5),o[3],0,0,0), (void)0, C1,6); \
    KRD(GL,2); GAPB2(o[2]=__builtin_amdgcn_mfma_f32_32x32x16_bf16(PAF(2),VFR(2),o[2],0,0,0), (void)0, C1,8); \
    KRD(GL,3); GAPB2(o[3]=__builtin_amdgcn_mfma_f32_32x32x16_bf16(PAF(2),VFR(6),o[3],0,0,0), (void)0, C1,10); \
    GAPB2(o[2]=__builtin_amdgcn_mfma_f32_32x32x16_bf16(PAF(3),VFR(3),o[2],0,0,0), (void)0, C1,12); \
    GAPB2(o[3]=__builtin_amdgcn_mfma_f32_32x32x16_bf16(PAF(3),VFR(7),o[3],0,0,0), (void)0, C1,14); \
    } \
    }while(0)
  int t=1;
  for(;t+5<NT;t+=2){
    STEP(pB0,pB1,pA0,pA1,t,true,true,true);     WBV(2,3); RESC(); ROT();
    STEP(pA0,pA1,pB0,pB1,t+1,true,true,true);   WBV(2,3); RESC(); ROT();
  }
  #define ENDW(tt) do{ if((tt)+3<NT){WBV(2,3);} else if((tt)+2<NT){WBV(1,2);} else {WAIT_BAR(0);} }while(0)
  for(;t+1<NT;t+=2){
    STEP(pB0,pB1,pA0,pA1,t,(t+3<NT),(t+1<NT),(t+1<NT));       ENDW(t);   RESC(); ROT();
    STEP(pA0,pA1,pB0,pB1,t+1,(t+4<NT),(t+2<NT),(t+2<NT));     ENDW(t+1); RESC(); ROT();
  }
  STEP(pB0,pB1,pA0,pA1,NT-1,false,false,false); RESC();
  { float sacc=pB0[0]+pB0[1]; _Pragma("unroll") for(int r=2;r<16;++r)sacc+=pB0[r]; _Pragma("unroll") for(int r=0;r<16;++r)sacc+=pB1[r]; l_reg+=sacc;
    pw0=(u32x4){PKW(pB0,0),PKW(pB0,2),PKW(pB0,4),PKW(pB0,6)};pw1=(u32x4){PKW(pB0,8),PKW(pB0,10),PKW(pB0,12),PKW(pB0,14)};pw2=(u32x4){PKW(pB1,0),PKW(pB1,2),PKW(pB1,4),PKW(pB1,6)};pw3=(u32x4){PKW(pB1,8),PKW(pB1,10),PKW(pB1,12),PKW(pB1,14)};
    SBAR(); pv<NOB>(o,vb0+VS*sl_cur,PAF(0),PAF(1),PAF(2),PAF(3)); }
  #undef PKW
  #undef PAF
  #undef VFR
  #undef PIN
  #undef MX3
  #undef GAPA
  #undef GAPB
  #undef GAPB2
  #undef VRD2
  #undef WBV
  #undef EX
  #undef VRD
  #undef KRD
  #undef STEP
  #undef ENDW
  {auto rr=__builtin_amdgcn_permlane32_swap(__float_as_uint(l_reg),__float_as_uint(l_reg),false,false);l_reg=__uint_as_float(rr[0])+__uint_as_float(rr[1]);}
  if(hi==0)wsf[32+r32]=l_reg;asm volatile("s_waitcnt lgkmcnt(0)":::"memory");
  float rli[16];
  #pragma unroll
  for(int r=0;r<16;++r)rli[r]=__builtin_amdgcn_rcpf(wsf[32+crow(r,hi)]);
  bf16*Ow=Ou+(long)(wid*QBLK)*OP;
  { bf16*stg=(bf16*)(shm+LDS_OST)+wid*2048;
    #pragma unroll
    for(int ps=0;ps<VS;++ps){
    #pragma unroll
    for(int r=0;r<16;++r){const int orow=crow(r,hi);
      #pragma unroll
      for(int d0=0;d0<2;++d0)stg[orow*64+d0*32+r32]=__float2bfloat16(o[2*ps+d0][r]*rli[r]);}
    asm volatile("s_waitcnt lgkmcnt(0)":::"memory");
    #pragma unroll
    for(int i=0;i<4;++i){const int row=i*8+(lane>>3),ch=lane&7; const u32x4 v=*(const u32x4*)(stg+row*64+ch*8); ATTN_STORE16(Ow+(long)row*OP+ps*64+ch*8,v);}
    asm volatile("s_waitcnt lgkmcnt(0)":::"memory"); } }
  asm volatile("s_waitcnt lgkmcnt(0)\n\ts_barrier":::"memory");
  #undef DMA_K
  #undef DMA_V
  #undef CMASK
  #undef START
  #undef RESC
  #undef ROT
}
constexpr float V8SCALE=8.f, P8BIAS=2.f;
template<int DV> __device__ __forceinline__ void attn_unit8(const bf16*Qu,int QP,const bf16*__restrict__ Kh,int KP,const unsigned char*__restrict__ Vt,bf16*Ou,int OP,char*shm,int wave_in){
  int tid_; asm volatile("v_mbcnt_lo_u32_b32 %0, -1, 0\n\tv_mbcnt_hi_u32_b32 %0, -1, %0":"=v"(tid_)); tid_+=wave_in*64; const int tid=tid_,lane=tid&63,r32=lane&31,hi=lane>>5; const int wid=__builtin_amdgcn_readfirstlane(tid>>6);
  const bf16*Qw=Qu+(long)(wid*QBLK)*QP;
  constexpr int VS=DV/64, NOB=DV/32;
  const unsigned lds0=(unsigned)(uintptr_t)shm;
  constexpr int NKS=4, L8_K=0, L8_V=NKS*SLOTB, L8_WS=L8_V+4*8192, L8_OST=L8_WS+NW*64*4;
  static_assert(L8_OST+NW*4096<=131072,"attn_unit8 LDS");
  float*wsf=(float*)(shm+L8_WS)+wid*64;
  const bf16*ksrc=Kh+(long)lane*KP+wid*8;
  const int vgrp=(DV==128)?(wid>>2):0;
  const unsigned char*vsrc=Vt+(64*vgrp+lane)*64+(wid&3)*16;
  const unsigned kdst=lds0+L8_K+wid*1024, vdst=lds0+L8_V+(wid&3)*(DV*16)+vgrp*1024;
  #define DMA_K(t,slot) glds16(ksrc+(long)(t)*KVBLK*KP,(unsigned)__builtin_amdgcn_readfirstlane(kdst+(slot)))
  #define VSL(t) ((((t))&3)*8192)
  #define DMA_V(t) glds16(vsrc+(long)(t)*(DV*64),(unsigned)__builtin_amdgcn_readfirstlane(vdst+VSL(t)))
  const char*Kbase=shm+L8_K; bf16x8 kf[8];
  const lds_cptr shm3=(lds_cptr)shm; const lds_cptr kp0=shm3+L8_K+hi*1024+r32*16; const lds_cptr vp0=shm3+L8_V+(2*hi)*(DV*16)+r32*16;
  constexpr int NT=SEQ/KVBLK;
  DMA_K(0,0);DMA_V(0);DMA_K(1,SLOTB);
  bf16x8 qr[4];
  #pragma unroll
  for(int d0=0;d0<4;++d0)qr[d0]=*reinterpret_cast<const bf16x8*>(&Qw[(long)r32*QP+d0*16+hi*8]);
  float mhat=0.f,l_reg=0.f;f32x16 o[NOB];
  #pragma unroll
  for(int d_=0;d_<NOB;++d_)o[d_]=f32x16{};
  f32x16 negm=f32x16{};asm volatile("":"+v"(negm));
  typedef int i32x8_t __attribute__((ext_vector_type(8))); i32x8_t v8[NOB]; i32x8_t p8={0,0,0,0,0,0,0,0}; const int one8=0x7f7f7f7f; f32x16 osum=f32x16{}; i32x8_t ones8={0x38383838,0x38383838,0x38383838,0x38383838,0x38383838,0x38383838,0x38383838,0x38383838}; if constexpr(NOB==2) asm volatile("":"+v"(ones8));
  typedef int i32x4_t __attribute__((ext_vector_type(4)));
  #define PK8(g,P,B) do{ int w_=p8[g]; w_=__builtin_amdgcn_cvt_pk_fp8_f32(P[B],P[(B)+1],w_,false); w_=__builtin_amdgcn_cvt_pk_fp8_f32(P[(B)+2],P[(B)+3],w_,true); p8[g]=w_; }while(0)
  #define PS8() asm volatile("v_mfma_scale_f32_32x32x64_f8f6f4 %0, %1, %2, %0, %3, %3 op_sel_hi:[0,0,0]":"+v"(osum):"v"(p8),"v"(ones8),"v"(one8))
  #define PV8(db) asm volatile("v_mfma_scale_f32_32x32x64_f8f6f4 %0, %1, %2, %0, %3, %3 op_sel_hi:[0,0,0]":"+v"(o[db]):"v"(p8),"v"(v8[db]),"v"(one8))
  #define VRD8(db) do{ const i32x4_t lo_=*(const __attribute__((address_space(3))) i32x4_t*)(vp_+(db)*512), hi_=*(const __attribute__((address_space(3))) i32x4_t*)(vp_+(db)*512+DV*16); v8[db]=__builtin_shufflevector(lo_,hi_,0,1,2,3,4,5,6,7); }while(0)
  #define MX3(a,b,c) __builtin_fmaxf(__builtin_fmaxf((a),(b)),(c))
  #define MF(A,B,C) __builtin_amdgcn_mfma_f32_32x32x16_bf16(A,B,C,0,0,0)
  #define WAIT_Y() asm volatile("s_waitcnt lgkmcnt(0)\n\ts_barrier":::"memory")
  DMA_K(2,2*SLOTB);DMA_K(3,3*SLOTB);
  WAIT_BAR(4);
  f32x16 C0,C1;
  qkt(C0,C1,Kbase,qr,negm,r32,hi);asm volatile("s_nop 15\n\ts_nop 7":"+v"(C0),"+v"(C1));
  { const float rm=rowmax(C0,C1); const float dl=rm-P8BIAS; mhat=fadd_s(mhat,dl);
    _Pragma("unroll") for(int r=0;r<16;++r){C0[r]=fsub_s(C0[r],dl);C1[r]=fsub_s(C1[r],dl);}
    _Pragma("unroll") for(int r=0;r<16;++r)negm[r]=-mhat; asm volatile("":"+v"(negm));
    _Pragma("unroll") for(int r=0;r<16;++r){C0[r]=__builtin_amdgcn_exp2f(C0[r]);C1[r]=__builtin_amdgcn_exp2f(C1[r]);}
    if constexpr(NOB==4){ float sacc=C0[0]+C0[1]; _Pragma("unroll") for(int r=2;r<16;++r)sacc+=C0[r]; _Pragma("unroll") for(int r=0;r<16;++r)sacc+=C1[r]; l_reg=sacc; }
    PK8(0,C0,0);PK8(1,C0,4);PK8(2,C0,8);PK8(3,C0,12);PK8(4,C1,0);PK8(5,C1,4);PK8(6,C1,8);PK8(7,C1,12); }
  WAIT_BAR(0);
  DMA_V(1);DMA_K(4,0);DMA_V(2);
  int sl_cur=SLOTB,sl_next=2*SLOTB;
  kload8(kf,kp0+sl_cur);
  WAIT_BAR(3);
  if(wid>=4) asm volatile("s_barrier":::"memory");
  #define AMX3(d,x,y,z) asm("v_max3_f32 %0, %1, %2, %3":"=v"(d):"v"(x),"v"(y),"v"(z))
  #define BODY(GK,GV,GW) do{ \
    SBAR(); \
    __builtin_amdgcn_s_setprio(1); \
    { const lds_cptr vp_=vp0+VSL(t-1); \
      _Pragma("unroll") for(int db=0;db<NOB;++db)VRD8(db); } \
    SBAR(); \
    C0=MF(kf[0],qr[0],negm); asm volatile("":"+v"(C0)); C1=MF(kf[1],qr[0],negm); asm volatile("":"+v"(C1)); SBAR(); kload2(kf,kp0+sl_next,0); SBAR(); \
    C0=MF(kf[2],qr[1],C0); asm volatile("":"+v"(C0)); C1=MF(kf[3],qr[1],C1); asm volatile("":"+v"(C1)); SBAR(); kload2(kf,kp0+sl_next,1); SBAR(); \
    C0=MF(kf[4],qr[2],C0); asm volatile("":"+v"(C0)); C1=MF(kf[5],qr[2],C1); asm volatile("":"+v"(C1)); SBAR(); kload2(kf,kp0+sl_next,2); SBAR(); \
    C0=MF(kf[6],qr[3],C0); asm volatile("":"+v"(C0)); C1=MF(kf[7],qr[3],C1); asm volatile("":"+v"(C1)); SBAR(); kload2(kf,kp0+sl_next,3); SBAR(); \
    if constexpr(NOB==2){ PS8(); SBAR(); if(GK){DMA_K(t+4,sl_cur);} SBAR(); PV8(0); SBAR(); if(GV){DMA_V(t+2);} SBAR(); PV8(1); } \
    else { PV8(0); SBAR(); if(GK){DMA_K(t+4,sl_cur);} SBAR(); PV8(1); SBAR(); if(GV){DMA_V(t+2);} SBAR(); PV8(2); PV8(3); } \
    __builtin_amdgcn_s_setprio(0); \
    SBAR(); \
    if(GW){WAIT_BAR(4);} else {WAIT_BAR(0);} \
    SBAR(); \
    _Pragma("unroll") for(int db=0;db<NOB;++db) asm volatile(""::"v"(v8[db]),"v"(p8)); \
    asm volatile("":"+v"(C0),"+v"(C1)); \
    { float a,b; \
      asm("v_max3_f32 %0, %2, %3, %4\n\tv_max3_f32 %1, %5, %6, %7\n\tv_max3_f32 %0, %0, %8, %9":"=&v"(a),"=&v"(b):"v"(C0[0]),"v"(C0[1]),"v"(C1[0]),"v"(C0[2]),"v"(C0[3]),"v"(C1[1]),"v"(C1[2]),"v"(C1[3])); \
      asm("v_max3_f32 %0, %0, %2, %3\n\tv_max3_f32 %1, %1, %4, %5\n\tv_max3_f32 %0, %0, %6, %7\n\tv_max3_f32 %1, %1, %8, %9":"+v"(a),"+v"(b):"v"(C0[4]),"v"(C0[5]),"v"(C0[6]),"v"(C0[7]),"v"(C1[4]),"v"(C1[5]),"v"(C1[6]),"v"(C1[7])); \
      asm("v_max3_f32 %0, %0, %2, %3\n\tv_max3_f32 %1, %1, %4, %5\n\tv_max3_f32 %0, %0, %6, %7\n\tv_max3_f32 %1, %1, %8, %9":"+v"(a),"+v"(b):"v"(C0[8]),"v"(C0[9]),"v"(C0[10]),"v"(C0[11]),"v"(C1[8]),"v"(C1[9]),"v"(C1[10]),"v"(C1[11])); \
      float rm; \
      asm("v_max3_f32 %0, %0, %3, %4\n\tv_max3_f32 %1, %1, %5, %6\n\tv_max3_f32 %0, %0, %7, %8\n\tv_max3_f32 %1, %1, %9, %10\n\tv_max_f32 %2, %0, %1":"+v"(a),"+v"(b),"=&v"(rm):"v"(C0[12]),"v"(C0[13]),"v"(C0[14]),"v"(C0[15]),"v"(C1[12]),"v"(C1[13]),"v"(C1[14]),"v"(C1[15])); \
      if(__builtin_expect(__any(rm>8.0f),0)){ { auto rr=__builtin_amdgcn_permlane32_swap(__float_as_uint(rm),__float_as_uint(rm),false,false); rm=__builtin_fmaxf(__uint_as_float(rr[0]),__uint_as_float(rr[1])); } \
        const float dl=__builtin_fmaxf(rm-P8BIAS,0.f); mhat+=dl; \
        _Pragma("unroll") for(int r=0;r<16;++r){C0[r]-=dl;C1[r]-=dl;} \
        _Pragma("unroll") for(int r=0;r<16;++r)negm[r]=-mhat; asm volatile("":"+v"(negm)); \
        const float f=__builtin_amdgcn_exp2f(-dl); l_reg*=f; if(hi==0)wsf[r32]=f; \
        asm volatile("s_nop 15\n\ts_nop 15\n\ts_nop 15\n\ts_nop 15\n\ts_nop 15\n\ts_nop 15\n\ts_waitcnt lgkmcnt(0)":::"memory"); \
        _Pragma("unroll") for(int d_=0;d_<NOB;++d_) _Pragma("unroll") for(int r=0;r<16;++r)o[d_][r]*=wsf[crow(r,hi)]; \
        if constexpr(NOB==2){ _Pragma("unroll") for(int r=0;r<16;++r)osum[r]*=wsf[crow(r,hi)]; } } } \
    _Pragma("unroll") for(int r=0;r<16;++r){C0[r]=__builtin_amdgcn_exp2f(C0[r]);C1[r]=__builtin_amdgcn_exp2f(C1[r]);} \
    if constexpr(NOB==4){ float sacc=C0[0]+C0[1]; _Pragma("unroll") for(int r=2;r<16;++r)sacc+=C0[r]; _Pragma("unroll") for(int r=0;r<16;++r)sacc+=C1[r]; l_reg+=sacc; } \
    PK8(0,C0,0);PK8(1,C0,4);PK8(2,C0,8);PK8(3,C0,12);PK8(4,C1,0);PK8(5,C1,4);PK8(6,C1,8);PK8(7,C1,12); \
    asm volatile("":"+v"(p8)); asm volatile("":"+v"(l_reg)); \
    SBAR(); \
    WAIT_Y(); \
    SBAR(); \
    sl_cur=sl_next; sl_next=(sl_next==(NKS-1)*SLOTB)?0:sl_next+SLOTB; \
  }while(0)
  int t=1;
  #pragma nounroll
  for(;t+4<NT;++t) BODY(true,true,true);
  #pragma nounroll
  for(;t<NT;++t) BODY((t+4<NT),(t+2<NT),(t+4<NT));
  #undef BODY
  #undef AMX3
  if(wid<4) asm volatile("s_barrier":::"memory");
  { SBAR(); { const lds_cptr vp_=vp0+VSL(NT-1);
      #pragma unroll
      for(int db=0;db<NOB;++db)VRD8(db);
      if constexpr(NOB==2) PS8();
      #pragma unroll
      for(int db=0;db<NOB;++db)PV8(db);
      asm volatile("s_nop 15\n\ts_nop 15\n\ts_nop 15\n\ts_nop 15\n\ts_nop 15\n\ts_nop 15\n\ts_nop 15\n\ts_nop 15\n\ts_nop 15\n\ts_nop 15":::"memory");
      #pragma unroll
      for(int db=0;db<NOB;++db) asm volatile("":"+v"(o[db]):"v"(v8[db]),"v"(p8));
      if constexpr(NOB==2) asm volatile("":"+v"(osum):"v"(ones8),"v"(p8)); } }
  #undef PK8
  #undef PV8
  #undef PS8
  #undef VRD8
  #undef MX3
  #undef MF
  #undef WAIT_Y
  float rli[16];
  if constexpr(NOB==2){
    #pragma unroll
    for(int r=0;r<16;++r)rli[r]=__builtin_amdgcn_rcpf(osum[r])*(1.0f/V8SCALE);
  } else {
    {auto rr=__builtin_amdgcn_permlane32_swap(__float_as_uint(l_reg),__float_as_uint(l_reg),false,false);l_reg=__uint_as_float(rr[0])+__uint_as_float(rr[1]);}
    if(hi==0)wsf[32+r32]=l_reg;asm volatile("s_waitcnt lgkmcnt(0)":::"memory");
    #pragma unroll
    for(int r=0;r<16;++r)rli[r]=__builtin_amdgcn_rcpf(wsf[32+crow(r,hi)])*(1.0f/V8SCALE);
  }
  bf16*Ow=Ou+(long)(wid*QBLK)*OP;
  { bf16*stg=(bf16*)(shm+L8_OST)+wid*2048;
    #pragma unroll
    for(int ps=0;ps<VS;++ps){
    #pragma unroll
    for(int r=0;r<16;++r){const int orow=crow(r,hi);
      #pragma unroll
      for(int d0=0;d0<2;++d0)stg[orow*64+d0*32+r32]=__float2bfloat16(o[2*ps+d0][r]*rli[r]);}
    asm volatile("s_waitcnt lgkmcnt(0)":::"memory");
    #pragma unroll
    for(int i=0;i<4;++i){const int row=i*8+(lane>>3),ch=lane&7; const u32x4 v=*(const u32x4*)(stg+row*64+ch*8); ATTN_STORE16(Ow+(long)row*OP+ps*64+ch*8,v);}
    asm volatile("s_waitcnt lgkmcnt(0)":::"memory"); } }
  asm volatile("s_waitcnt lgkmcnt(0)\n\ts_barrier":::"memory");
  #undef DMA_K
  #undef DMA_V
  #undef VSL
}

constexpr int ATTN_LDS_BYTES=LDS_BYTES;
#undef SBAR
#undef WAIT_BAR
}
constexpr int NWAVES = 8;
constexpr int NTOK = 65536, SEQL = 8192, DM = 1024, INW = 2304, DFF = 3584, NEXP = 8, NLAYER = 2;
constexpr float EPS = 1e-6f;
constexpr size_t MiB = 1u << 20;
constexpr size_t WS_CTL = 0, CTL_ZERO_BYTES = 128 * 1024;
constexpr size_t WS_WIN = 1 * MiB;
constexpr size_t WS_WOUT = 10 * MiB;
constexpr size_t WS_WGU_D = 14 * MiB;
constexpr size_t WS_WDN_D = 28 * MiB;
constexpr size_t WS_WGU_M = 35 * MiB;
constexpr size_t WS_WDN_M = 91 * MiB;
constexpr size_t WS_HN = 203 * MiB;
constexpr size_t WS_QA = 331 * MiB, WS_QB = 395 * MiB, WS_KA = 459 * MiB, WS_VA = 475 * MiB, WS_KB = 491 * MiB, WS_VB = 555 * MiB;
constexpr size_t WS_OA = 619 * MiB, WS_OB = 683 * MiB;
constexpr size_t WS_AO = 331 * MiB;
constexpr size_t WS_MIX = 491 * MiB;
constexpr size_t WS_XS = 331 * MiB;
constexpr size_t WS_YS = 463 * MiB;
constexpr size_t WS_ACT8 = 727 * MiB;
constexpr float A8SCALE = 16.f, W8SCALE = 256.f, H8SCALE = 8.f;
constexpr size_t WS_ACT = 595 * MiB;
constexpr size_t WS_F = 819 * MiB;
constexpr size_t WS_VT8 = WS_F;
constexpr size_t WS_TOK = 947 * MiB;
constexpr size_t WS_WGB = 948 * MiB;
constexpr size_t WS_END = 949 * MiB;
#ifndef PROJ_I8
#define PROJ_I8 1
#endif
#define PROJ_I8_IN ((PROJ_I8 & 1) != 0)
#define PROJ_I8_OUT ((PROJ_I8 & 2) != 0)
#ifndef DENSE_I8
#define DENSE_I8 1
#endif
#ifndef DENSE_F8
#define DENSE_F8 0
#endif
constexpr int CHUNK_TILES = 128;
constexpr int CW_TMO = 0, CW_CODE = 1, CW_BAR = 4096, CW_CNT = 8192, CW_CMAX = 9000;
constexpr int CW_CMAX_IN = 16384, CW_CMAX_OUT = 21000;
constexpr size_t WS_SWIN = WS_WIN + 5 * MiB, WS_SWOUT = WS_WOUT + 3 * MiB;
constexpr size_t WS_SA2 = WS_AO + 64 * MiB;
constexpr size_t WS_SWGU = WS_WGU_D + 8 * MiB;
constexpr size_t WS_SA = WS_HN + 64 * MiB;
constexpr int RING_OFF = 0, RING_BYTES = 131072;
constexpr int LDSCTL_OFF = RING_BYTES, MISC_OFF = LDSCTL_OFF + 320;
constexpr int LDS_BYTES = 147456;
#define GAS __attribute__((address_space(1)))
#define LAS __attribute__((address_space(3)))
typedef unsigned short bf16;
typedef unsigned v4u __attribute__((ext_vector_type(4)));
typedef float f32x4 __attribute__((ext_vector_type(4)));
typedef short bf16x8 __attribute__((ext_vector_type(8)));
typedef GAS unsigned gu32;
typedef GAS unsigned long long gu64;
#define RLX_AGENT __ATOMIC_RELAXED, __HIP_MEMORY_SCOPE_AGENT
#define LDS_WAIT() asm volatile("s_waitcnt lgkmcnt(0)" ::: "memory")
#define VM_WAIT() asm volatile("s_waitcnt vmcnt(0)" ::: "memory")
__device__ __forceinline__ unsigned long long rt() { return __builtin_amdgcn_s_memrealtime(); }
__device__ __forceinline__ unsigned f2bf(float f) { unsigned u = __builtin_bit_cast(unsigned, f); return (u + 0x7fffu + ((u >> 16) & 1u)) >> 16; }
__device__ __forceinline__ unsigned pk2(float lo, float hi) { return f2bf(lo) | (f2bf(hi) << 16); }

#define XB_TMO      128
#define XB_XCNT(j)  (256  + 64 * (j))
#define XB_XSUB(j)  (1280 + 64 * (j))
#define XB_XGEN(j)  (2304 + 64 * (j))
#define XB_TOP      3328
#define XB_TOPGEN   3392
#define XCD_BAR_WORDS 3456
#define XB_SPIN_CAP (1u << 18)

__device__ __forceinline__ unsigned xb_ld(unsigned* p)              { return __hip_atomic_load(p, __ATOMIC_RELAXED, __HIP_MEMORY_SCOPE_AGENT); }
__device__ __forceinline__ unsigned xb_add(unsigned* p, unsigned v) { return __hip_atomic_fetch_add(p, v, __ATOMIC_RELAXED, __HIP_MEMORY_SCOPE_AGENT); }
__device__ __forceinline__ unsigned xb_xcc_id() { return (unsigned)__builtin_amdgcn_s_getreg((3 << 11) | 20) & 0xFu; }
#define XB_SPIN(cond, bar) do { unsigned _sp = 0; while (cond) { __builtin_amdgcn_s_sleep(1); \
    if ((++_sp & 255u) == 0u) { if (xb_ld(&(bar)[XB_TMO])) break; if (_sp > XB_SPIN_CAP) { atomicAdd(&(bar)[XB_TMO], 1u); break; } } } } while (0)

struct XcdBarrier {
    unsigned* bar; unsigned x;
    volatile LAS unsigned* st;
};

__device__ __forceinline__ XcdBarrier xcd_barrier_post(unsigned* bar, volatile LAS unsigned* st) {
    XcdBarrier b; b.bar = bar; b.x = xb_xcc_id(); b.st = st;
    if (threadIdx.x == 0) (void)xb_add(&bar[XB_XCNT(b.x)], 1u);
    return b;
}
__device__ __forceinline__ void xcd_barrier_complete(unsigned* bar, unsigned x, unsigned& nloc, unsigned& nx) {
    const unsigned G = gridDim.x * gridDim.y * gridDim.z;
    unsigned sum, cnt, mine, sp = 0u;
    for (;;) {
        sum = 0u; cnt = 0u; mine = 0u;
#pragma unroll
        for (unsigned j = 0; j < 16; ++j) { const unsigned c = xb_ld(&bar[XB_XCNT(j)]); sum += c; cnt += (c > 0u) ? 1u : 0u; mine = (j == x) ? c : mine; }
        if (sum == G) break;
        __builtin_amdgcn_s_sleep(1);
        if ((++sp & 255u) == 0u) { if (xb_ld(&bar[XB_TMO])) break; if (sp > XB_SPIN_CAP) { atomicAdd(&bar[XB_TMO], 1u); break; } }
    }
    nloc = mine > 0u ? mine : 1u; nx = cnt > 0u ? cnt : 1u;
}

__device__ __forceinline__ void xcd_barrier(const XcdBarrier& b) {
    asm volatile("s_waitcnt vmcnt(0)" ::: "memory");
    __syncthreads();
    if (threadIdx.x == 0) {
        unsigned* bar = b.bar;
        __builtin_amdgcn_s_waitcnt(0);
        unsigned nloc = b.st[0], nx = b.st[1];
        if (nloc == 0u) { xcd_barrier_complete(bar, b.x, nloc, nx); b.st[0] = nloc; b.st[1] = nx; }
        const unsigned old = xb_add(&bar[XB_XSUB(b.x)], 1u);
        const unsigned gen = old / nloc;
        if (old + 1u == (gen + 1u) * nloc) {
            __builtin_amdgcn_fence(__ATOMIC_RELEASE, "agent");
            asm volatile("s_waitcnt vmcnt(0)" ::: "memory");
            const unsigned og = xb_add(&bar[XB_TOP], 1u);
            const unsigned tg = og / nx;
            if (og + 1u == (tg + 1u) * nx) xb_add(&bar[XB_TOPGEN], 1u);
            else XB_SPIN(xb_ld(&bar[XB_TOPGEN]) == tg, bar);
            __builtin_amdgcn_fence(__ATOMIC_ACQUIRE, "agent");
            xb_add(&bar[XB_XGEN(b.x)], 1u);
            asm volatile("s_waitcnt vmcnt(0)" ::: "memory");
        } else {
            XB_SPIN(xb_ld(&bar[XB_XGEN(b.x)]) == gen, bar);
            __builtin_amdgcn_fence(__ATOMIC_ACQUIRE, "agent");
            asm volatile("s_waitcnt vmcnt(0)" ::: "memory");
        }
    }
    __syncthreads();
}
typedef unsigned u32x2 __attribute__((ext_vector_type(2)));
__device__ __forceinline__ float wave_sum(float v) {
#pragma unroll
    for (int o = 1; o < 64; o <<= 1) v += __shfl_xor(v, o);
    return v;
}
__device__ __forceinline__ unsigned cvtpk(float lo, float hi) { return pg8::cvt_pk_bf16(lo, hi); }
__device__ __forceinline__ f32x4 unpack4(u32x2 w) { return (f32x4){__uint_as_float(w.x << 16), __uint_as_float(w.x & 0xffff0000u), __uint_as_float(w.y << 16), __uint_as_float(w.y & 0xffff0000u)}; }
__device__ __forceinline__ u32x2 pack4(f32x4 v) { u32x2 r; r.x = cvtpk(v[0], v[1]); r.y = cvtpk(v[2], v[3]); return r; }
__device__ __forceinline__ float sumsq4(f32x4 v) { return (v[0] * v[0] + v[1] * v[1]) + (v[2] * v[2] + v[3] * v[3]); }
__device__ __forceinline__ void ld_row_f32(const float* row, int lane, f32x4 (&v)[4]) {
#pragma unroll
    for (int j = 0; j < 4; ++j) v[j] = *(const GAS f32x4*)(row + 4 * lane + 256 * j);
}
__device__ __forceinline__ void st_row_f32(float* row, int lane, const f32x4 (&v)[4]) {
#pragma unroll
    for (int j = 0; j < 4; ++j) *(GAS f32x4*)(row + 4 * lane + 256 * j) = v[j];
}
__device__ __forceinline__ void ld_row_bf16(const bf16* row, int lane, f32x4 (&v)[4]) {
#pragma unroll
    for (int j = 0; j < 4; ++j) v[j] = unpack4(*(const GAS u32x2*)(row + 4 * lane + 256 * j));
}
__device__ __forceinline__ void st_row_bf16(bf16* row, int lane, const f32x4 (&v)[4]) {
#pragma unroll
    for (int j = 0; j < 4; ++j) *(GAS u32x2*)(row + 4 * lane + 256 * j) = pack4(v[j]);
}
__device__ __forceinline__ float rms_scale(const f32x4 (&v)[4]) {
    const float s = wave_sum((sumsq4(v[0]) + sumsq4(v[1])) + (sumsq4(v[2]) + sumsq4(v[3])));
    return 1.0f / sqrtf(s * (1.0f / DM) + EPS);
}

__device__ __forceinline__ int tau_in(int c) {
    int tile, wc, d, isv;
    if (c < 512) { const int hq = c >> 6; tile = hq >> 2; wc = hq & 3; isv = 0; }
    else if (c < 640) { tile = 2; wc = (c - 512) >> 6; isv = 0; }
    else if (c < 768) { tile = 2; wc = 2 + ((c - 640) >> 6); isv = 1; }
    else if (c < 1280) { const int j = (c - 768) >> 6; tile = 3 + (j >> 2); wc = j & 3; isv = 0; }
    else if (c < 1792) { const int j = (c - 1280) >> 6; tile = 5 + (j >> 2); wc = j & 3; isv = 0; }
    else { const int j = (c - 1792) >> 6; tile = 7 + (j >> 2); wc = j & 3; isv = 1; }
    d = c & 63;
    const int slot = isv ? (128 * ((d >> 3) & 1) + 32 * wc + 16 * ((d >> 2) & 1) + 4 * (d >> 4) + (d & 3)) : (128 * (d >> 5) + 32 * wc + (d & 31));
    return 256 * tile + slot;
}
__device__ __forceinline__ void conv_item(const float* W, int K, int N, bf16* WT, int mode, LAS float* scr, int item, int lane) {
    const int nblk = N / 32, kb = item / nblk, nb = item % nblk, k0 = 64 * kb, n0 = 32 * nb;
#pragma unroll 8
    for (int i = 0; i < 32; ++i) { const int kk = 2 * i + (lane >> 5); scr[kk * 33 + (lane & 31)] = W[(size_t)(k0 + kk) * N + n0 + (lane & 31)]; }
    LDS_WAIT(); asm volatile("" ::: "memory");
    const int c = lane & 7;
#pragma unroll
    for (int j = 0; j < 4; ++j) { const int n = (lane >> 3) + 8 * j; const LAS float* s = scr + (8 * c) * 33 + n; const int sn = n0 + n;
        const int dr = mode == 0 ? sn : mode == 1 ? tau_in(sn) : (256 * (sn >> 7) + (sn & 127) + (mode == 3 ? 128 : 0));
        v4u o; o.x = cvtpk(s[0 * 33], s[1 * 33]); o.y = cvtpk(s[2 * 33], s[3 * 33]); o.z = cvtpk(s[4 * 33], s[5 * 33]); o.w = cvtpk(s[6 * 33], s[7 * 33]);
        *(GAS v4u*)(WT + (size_t)dr * K + k0 + 8 * c) = o; }
    LDS_WAIT(); asm volatile("" ::: "memory");
}
__device__ __forceinline__ void conv_item8(const float* W, int K, int N, unsigned char* WT, int mode, float scale, LAS float* scr, int item, int lane) {
    const int nblk = N / 32, kb = item / nblk, nb = item % nblk, k0 = 64 * kb, n0 = 32 * nb;
#pragma unroll 8
    for (int i = 0; i < 32; ++i) { const int kk = 2 * i + (lane >> 5); scr[kk * 33 + (lane & 31)] = W[(size_t)(k0 + kk) * N + n0 + (lane & 31)]; }
    LDS_WAIT(); asm volatile("" ::: "memory");
    const int c = lane & 7;
#pragma unroll
    for (int j = 0; j < 4; ++j) { const int n = (lane >> 3) + 8 * j; const LAS float* s = scr + (8 * c) * 33 + n; const int sn = n0 + n;
        const int dr = mode == 0 ? sn : (256 * (sn >> 7) + (sn & 127) + (mode == 3 ? 128 : 0));
        u32x2 o; o.x = pg8::cvt4_fp8(s[0 * 33] * scale, s[1 * 33] * scale, s[2 * 33] * scale, s[3 * 33] * scale); o.y = pg8::cvt4_fp8(s[4 * 33] * scale, s[5 * 33] * scale, s[6 * 33] * scale, s[7 * 33] * scale);
        *(GAS u32x2*)(WT + (size_t)dr * K + k0 + 8 * c) = o; }
    LDS_WAIT(); asm volatile("" ::: "memory");
}
struct ConvDesc { const float* W; unsigned char* dst; int K, N, mode, f8; };
__device__ __forceinline__ void conv_load(const ConvDesc& d, int sub, int lane, f32x4 (&v)[8]) {
    const int nblk = d.N / 32, kb = sub / nblk, nb = sub % nblk, k0 = 64 * kb, n0 = 32 * nb;
#pragma unroll
    for (int u = 0; u < 8; ++u) v[u] = *(const GAS f32x4*)(d.W + (size_t)(k0 + 8 * u + (lane >> 3)) * d.N + n0 + 4 * (lane & 7));
}
__device__ __forceinline__ void conv_store(const ConvDesc& d, int sub, int lane, const f32x4 (&v)[8], LAS float* scr) {
    const int nblk = d.N / 32, kb = sub / nblk, nb = sub % nblk, k0 = 64 * kb, n0 = 32 * nb;
#pragma unroll
    for (int u = 0; u < 8; ++u)
#pragma unroll
        for (int e = 0; e < 4; ++e) scr[(8 * u + (lane >> 3)) * 33 + 4 * (lane & 7) + e] = v[u][e];
    LDS_WAIT(); asm volatile("" ::: "memory");
    const int c = lane & 7;
#pragma unroll
    for (int j = 0; j < 4; ++j) { const int n = (lane >> 3) + 8 * j; const LAS float* s = scr + (8 * c) * 33 + n; const int sn = n0 + n;
        const int dr = d.mode == 0 ? sn : d.mode == 1 ? tau_in(sn) : (256 * (sn >> 7) + (sn & 127) + (d.mode == 3 ? 128 : 0));
        if (d.f8) { u32x2 o; o.x = pg8::cvt4_fp8(s[0 * 33] * W8SCALE, s[1 * 33] * W8SCALE, s[2 * 33] * W8SCALE, s[3 * 33] * W8SCALE); o.y = pg8::cvt4_fp8(s[4 * 33] * W8SCALE, s[5 * 33] * W8SCALE, s[6 * 33] * W8SCALE, s[7 * 33] * W8SCALE);
            *(GAS u32x2*)(d.dst + (size_t)dr * d.K + k0 + 8 * c) = o; }
        else { v4u o; o.x = cvtpk(s[0 * 33], s[1 * 33]); o.y = cvtpk(s[2 * 33], s[3 * 33]); o.z = cvtpk(s[4 * 33], s[5 * 33]); o.w = cvtpk(s[6 * 33], s[7 * 33]);
            *(GAS v4u*)((bf16*)d.dst + (size_t)dr * d.K + k0 + 8 * c) = o; } }
    LDS_WAIT(); asm volatile("" ::: "memory");
}
__device__ __forceinline__ void conv_colmax(const ConvDesc& d, int sub, int lane, const f32x4 (&v)[8], gu32* cmax) {
    const int nblk = d.N / 32, nb = sub % nblk, n0 = 32 * nb;
    f32x4 m = (f32x4){0.f, 0.f, 0.f, 0.f};
#pragma unroll
    for (int u = 0; u < 8; ++u)
#pragma unroll
        for (int e = 0; e < 4; ++e) m[e] = fmaxf(m[e], fabsf(v[u][e]));
#pragma unroll
    for (int e = 0; e < 4; ++e) { m[e] = fmaxf(m[e], __shfl_xor(m[e], 8)); m[e] = fmaxf(m[e], __shfl_xor(m[e], 16)); m[e] = fmaxf(m[e], __shfl_xor(m[e], 32)); }
    if (lane < 8) {
#pragma unroll
        for (int e = 0; e < 4; ++e) __hip_atomic_fetch_max(cmax + n0 + 4 * lane + e, __float_as_uint(m[e]), __ATOMIC_RELAXED, __HIP_MEMORY_SCOPE_AGENT); }
}
__device__ __forceinline__ unsigned pack4_i8(float a, float b, float c, float d) {
    const int ia = (int)__builtin_amdgcn_fmed3f(__builtin_rintf(a), -127.f, 127.f), ib = (int)__builtin_amdgcn_fmed3f(__builtin_rintf(b), -127.f, 127.f), ic = (int)__builtin_amdgcn_fmed3f(__builtin_rintf(c), -127.f, 127.f), id = (int)__builtin_amdgcn_fmed3f(__builtin_rintf(d), -127.f, 127.f);
    return (unsigned)(ia & 255) | ((unsigned)(ib & 255) << 8) | ((unsigned)(ic & 255) << 16) | ((unsigned)id << 24);
}
__device__ __forceinline__ void conv_store_i8(const ConvDesc& d, int sub, int lane, const f32x4 (&v)[8], LAS float* scr, gu32* cmax, float* swout) {
    const int nblk = d.N / 32, kb = sub / nblk, nb = sub % nblk, k0 = 64 * kb, n0 = 32 * nb;
#pragma unroll
    for (int u = 0; u < 8; ++u)
#pragma unroll
        for (int e = 0; e < 4; ++e) scr[(8 * u + (lane >> 3)) * 33 + 4 * (lane & 7) + e] = v[u][e];
    LDS_WAIT(); asm volatile("" ::: "memory");
    const int c = lane & 7;
#pragma unroll
    for (int j = 0; j < 4; ++j) { const int n = (lane >> 3) + 8 * j; const LAS float* s = scr + (8 * c) * 33 + n; const int sn = n0 + n;
        const int dr = d.mode == 0 ? sn : d.mode == 1 ? tau_in(sn) : (256 * (sn >> 7) + (sn & 127) + (d.mode == 3 ? 128 : 0));
        const float cm = __uint_as_float(__hip_atomic_load(cmax + sn, RLX_AGENT)); const float q = cm > 0.f ? 127.0f / cm : 0.f;
        u32x2 o; o.x = pack4_i8(s[0 * 33] * q, s[1 * 33] * q, s[2 * 33] * q, s[3 * 33] * q); o.y = pack4_i8(s[4 * 33] * q, s[5 * 33] * q, s[6 * 33] * q, s[7 * 33] * q);
        *(GAS u32x2*)(d.dst + (size_t)dr * d.K + k0 + 8 * c) = o;
        if (k0 == 0 && c == 0) swout[dr] = cm * (1.0f / 127.0f); }
    LDS_WAIT(); asm volatile("" ::: "memory");
}
__device__ __forceinline__ void st_row_i8(unsigned char* rowp, float* sap, int lane, const f32x4 (&v)[4]) {
    float am = 0.f;
#pragma unroll
    for (int j = 0; j < 4; ++j) am = fmaxf(fmaxf(fmaxf(am, fabsf(v[j][0])), fmaxf(fabsf(v[j][1]), fabsf(v[j][2]))), fabsf(v[j][3]));
#pragma unroll
    for (int o = 1; o < 64; o <<= 1) am = fmaxf(am, __shfl_xor(am, o));
    const float q = am > 0.f ? 127.0f / am : 0.f;
#pragma unroll
    for (int j = 0; j < 4; ++j) *(GAS unsigned*)(rowp + 4 * lane + 256 * j) = pack4_i8(v[j][0] * q, v[j][1] * q, v[j][2] * q, v[j][3] * q);
    if (lane == 0) *sap = am * (1.0f / 127.0f);
}
struct Args { const float* in[19]; float* out; unsigned char* ws; int ph_lo, ph_hi; };
typedef const __attribute__((address_space(4))) Args* KArgs;
__device__ __forceinline__ KArgs kargs() { KArgs p = (KArgs)__builtin_amdgcn_kernarg_segment_ptr(); asm volatile("" : "+s"(p)); return p; }
__device__ __forceinline__ void phase_prologue(KArgs A, LAS unsigned char* L, int gw, int NGW, int wave, int lane) {
    unsigned char* ws = A->ws;
    LAS float* scr = (LAS float*)(L + RING_OFF + wave * 16384);
    constexpr int I_IN = (DM / 64) * (INW / 32), I_OUT = (DM / 64) * (DM / 32), I_FF = (DM / 64) * (DFF / 32);
    static_assert((DFF / 64) * (DM / 32) == I_FF, "item counts");
    constexpr int NITEMS = 2 * I_IN + 2 * I_OUT + 27 * I_FF;
    auto desc = [&](int it, ConvDesc& d, int& sub) {
        int r = it;
        if (r < 2 * I_IN) { const int l = r / I_IN; d = ConvDesc{A->in[1] + (size_t)l * DM * INW, ws + WS_WIN + (size_t)l * INW * DM * 2, DM, INW, 1, PROJ_I8_IN ? 3 : 0}; sub = r % I_IN; return; } r -= 2 * I_IN;
        if (r < 2 * I_OUT) { const int l = r / I_OUT; d = ConvDesc{A->in[2] + (size_t)l * DM * DM, ws + WS_WOUT + (size_t)l * DM * DM * 2, DM, DM, 0, PROJ_I8_OUT ? 3 : 0}; sub = r % I_OUT; return; } r -= 2 * I_OUT;
        const int mtx = r / I_FF; sub = r % I_FF;
        if (mtx == 0) d = ConvDesc{A->in[12], ws + WS_WGU_D, DM, DFF, 2, DENSE_I8 ? 3 : DENSE_F8};
        else if (mtx == 1) d = ConvDesc{A->in[13], ws + WS_WGU_D, DM, DFF, 3, DENSE_I8 ? 3 : DENSE_F8};
        else if (mtx == 2) d = ConvDesc{A->in[14], ws + WS_WDN_D, DFF, DM, 0, DENSE_F8};
        else if (mtx < 11) { const int e = mtx - 3; d = ConvDesc{A->in[16] + (size_t)e * DM * DFF, ws + WS_WGU_M + (size_t)e * 2 * DFF * DM, DM, DFF, 2, 1}; }
        else if (mtx < 19) { const int e = mtx - 11; d = ConvDesc{A->in[17] + (size_t)e * DM * DFF, ws + WS_WGU_M + (size_t)e * 2 * DFF * DM, DM, DFF, 3, 1}; }
        else { const int e = mtx - 19; d = ConvDesc{A->in[18] + (size_t)e * DFF * DM, ws + WS_WDN_M + (size_t)e * DM * DFF, DFF, DM, 0, 1}; }
    };
    {
        ConvDesc dA{}, dB{}; int sA = 0, sB = 0; f32x4 vA[8], vB[8];
        int it = gw;
        if (it < NITEMS) { desc(it, dA, sA); if (dA.f8 != 3) conv_load(dA, sA, lane, vA); }
        for (; it < NITEMS; it += 2 * NGW) {
            const bool hasB = it + NGW < NITEMS;
            if (hasB) { desc(it + NGW, dB, sB); if (dB.f8 != 3) conv_load(dB, sB, lane, vB); }
            if (dA.f8 != 3) conv_store(dA, sA, lane, vA, scr);
            if (it + 2 * NGW < NITEMS) { desc(it + 2 * NGW, dA, sA); if (dA.f8 != 3) conv_load(dA, sA, lane, vA); }
            if (hasB && dB.f8 != 3) conv_store(dB, sB, lane, vB, scr);
        }
    }
    if (PROJ_I8) {
        for (int it = gw; it < 2 * I_IN + 2 * I_OUT; it += NGW) { f32x4 v[8];
            if (it < 2 * I_IN) { if (!PROJ_I8_IN) continue; const int l = it / I_IN, sub = it % I_IN; ConvDesc d{A->in[1] + (size_t)l * DM * INW, nullptr, DM, INW, 1, 0}; conv_load(d, sub, lane, v); conv_colmax(d, sub, lane, v, (gu32*)(ws + WS_CTL) + CW_CMAX_IN + l * INW); }
            else { if (!PROJ_I8_OUT) continue; const int r = it - 2 * I_IN, l = r / I_OUT, sub = r % I_OUT; ConvDesc d{A->in[2] + (size_t)l * DM * DM, nullptr, DM, DM, 0, 0}; conv_load(d, sub, lane, v); conv_colmax(d, sub, lane, v, (gu32*)(ws + WS_CTL) + CW_CMAX_OUT + l * DM); } }
    }
    if (DENSE_I8) {
        for (int it = gw; it < 2 * I_FF; it += NGW) { const int mtx = it / I_FF, sub = it % I_FF; ConvDesc d{A->in[12 + mtx], nullptr, DM, DFF, 2 + mtx, 0}; f32x4 v[8];
            conv_load(d, sub, lane, v); conv_colmax(d, sub, lane, v, (gu32*)(ws + WS_CTL) + CW_CMAX + mtx * DFF); }
    }
    const float* x = A->in[0]; const float* g = A->in[3]; bf16* HN = (bf16*)(ws + WS_HN);
    f32x4 gv[4];
#pragma unroll
    for (int j = 0; j < 4; ++j) gv[j] = *(const GAS f32x4*)(g + 4 * lane + 256 * j);
#define P0_ROW(V, m_) do { const float r_ = rms_scale(V); _Pragma("unroll") for (int j = 0; j < 4; ++j) V[j] = V[j] * r_ * gv[j]; \
        if (PROJ_I8_IN) st_row_i8((unsigned char*)HN + (size_t)(m_) * DM, (float*)(ws + WS_SA) + (m_), lane, V); else st_row_bf16(HN + (size_t)(m_) * DM, lane, V); } while (0)
    { f32x4 vA[4], vB[4]; int m = gw;
      if (m < NTOK) ld_row_f32(x + (size_t)m * DM, lane, vA);
      for (; m < NTOK; m += 2 * NGW) { const bool hasB = m + NGW < NTOK;
          if (hasB) ld_row_f32(x + (size_t)(m + NGW) * DM, lane, vB);
          P0_ROW(vA, m);
          if (m + 2 * NGW < NTOK) ld_row_f32(x + (size_t)(m + 2 * NGW) * DM, lane, vA);
          if (hasB) P0_ROW(vB, m + NGW); } }
#undef P0_ROW
}
__device__ __forceinline__ void unpack8(v4u w, float (&f)[8]) {
    f[0] = __uint_as_float(w.x << 16); f[1] = __uint_as_float(w.x & 0xffff0000u); f[2] = __uint_as_float(w.y << 16); f[3] = __uint_as_float(w.y & 0xffff0000u);
    f[4] = __uint_as_float(w.z << 16); f[5] = __uint_as_float(w.z & 0xffff0000u); f[6] = __uint_as_float(w.w << 16); f[7] = __uint_as_float(w.w & 0xffff0000u);
}
__device__ __forceinline__ v4u pack8(const float (&f)[8]) { v4u w; w.x = cvtpk(f[0], f[1]); w.y = cvtpk(f[2], f[3]); w.z = cvtpk(f[4], f[5]); w.w = cvtpk(f[6], f[7]); return w; }
__device__ __forceinline__ void phase_t2(const bf16* OA, const bf16* OB, bf16* AO, const float* g_out_a, const float* g_subln, const float* lp, float lam_init, int gw, int NGW, int lane) {
    const float sa = wave_sum(lp[lane] * lp[64 + lane]), sb = wave_sum(lp[128 + lane] * lp[192 + lane]);
    const float lam = expf(sa) - expf(sb) + lam_init;
    float ga[8], gb[8];
#pragma unroll
    for (int i = 0; i < 8; ++i) { ga[i] = g_out_a[8 * lane + i]; gb[i] = g_subln[(8 * lane + i) & 127] * (1.0f - lam_init); }
    for (int row = gw; row < NTOK; row += NGW) {
        const v4u wa = *(const GAS v4u*)(OA + (size_t)row * 512 + 8 * lane), w0 = *(const GAS v4u*)(OB + (size_t)row * 1024 + 8 * lane), w1 = *(const GAS v4u*)(OB + (size_t)row * 1024 + 512 + 8 * lane);
        float a[8], b0[8], b1[8]; unpack8(wa, a); unpack8(w0, b0); unpack8(w1, b1);
        float ssa = 0.f, ssb = 0.f;
#pragma unroll
        for (int i = 0; i < 8; ++i) { ssa += a[i] * a[i]; b0[i] = b0[i] - lam * b1[i]; ssb += b0[i] * b0[i]; }
        ssa = wave_sum(ssa);
        ssb += __shfl_xor(ssb, 1); ssb += __shfl_xor(ssb, 2); ssb += __shfl_xor(ssb, 4); ssb += __shfl_xor(ssb, 8);
        const float ra = 1.0f / sqrtf(ssa * (1.0f / 512.0f) + EPS), rb = 1.0f / sqrtf(ssb * (1.0f / 128.0f) + EPS);
#pragma unroll
        for (int i = 0; i < 8; ++i) { a[i] = a[i] * ra * ga[i]; b0[i] = b0[i] * rb * gb[i]; }
        if (PROJ_I8_OUT) { float am = 0.f;
#pragma unroll
            for (int i = 0; i < 8; ++i) am = fmaxf(am, fmaxf(fabsf(a[i]), fabsf(b0[i])));
#pragma unroll
            for (int o = 1; o < 64; o <<= 1) am = fmaxf(am, __shfl_xor(am, o));
            const float q = am > 0.f ? 127.0f / am : 0.f; unsigned char* rp = (unsigned char*)AO + (size_t)row * 1024;
            u32x2 wa_, wb_; wa_.x = pack4_i8(a[0] * q, a[1] * q, a[2] * q, a[3] * q); wa_.y = pack4_i8(a[4] * q, a[5] * q, a[6] * q, a[7] * q); wb_.x = pack4_i8(b0[0] * q, b0[1] * q, b0[2] * q, b0[3] * q); wb_.y = pack4_i8(b0[4] * q, b0[5] * q, b0[6] * q, b0[7] * q);
            *(GAS u32x2*)(rp + 8 * lane) = wa_; *(GAS u32x2*)(rp + 512 + 8 * lane) = wb_;
            if (lane == 0) ((float*)((unsigned char*)AO + (WS_SA2 - WS_AO)))[row] = am * (1.0f / 127.0f);
        } else { *(GAS v4u*)(AO + (size_t)row * 1024 + 8 * lane) = pack8(a); *(GAS v4u*)(AO + (size_t)row * 1024 + 512 + 8 * lane) = pack8(b0); }
    }
}
template <bool ROUTE, bool F8OUT = ROUTE, bool I8OUT = false>
__device__ __forceinline__ void phase_t3(const float* hsrc, float* hdst, const bf16* MIX, bf16* HN, const float* gpost, const float* gpre, const float* wrt, v4u* TOK, unsigned* WGB, gu32* cnt,
                                         LAS unsigned* lcnt, LAS f32x4* wrl, int vcu, int G, int wave, int lane, int tid) {
    f32x4 gp[4], gf[4];
#pragma unroll
    for (int j = 0; j < 4; ++j) { gp[j] = *(const GAS f32x4*)(gpost + 4 * lane + 256 * j); gf[j] = *(const GAS f32x4*)(gpre + 4 * lane + 256 * j); }
    if (ROUTE) { for (int i = tid; i < 2048; i += NWAVES * 64) { const int row = i >> 1, hf = i & 1; wrl[(((row >> 8) * 4 + (row & 3)) * 2 + hf) * 64 + ((row & 255) >> 2)] = *(const GAS f32x4*)(wrt + 4 * i); } __syncthreads(); }
#define T3_LOAD(HV, MV, r) do { ld_row_f32(hsrc + (size_t)(r) * DM, lane, HV); ld_row_bf16(MIX + (size_t)(r) * DM, lane, MV); } while (0)
#define T3_ROW(HV, MV, row) do { \
        const float r_ = rms_scale(MV); \
        _Pragma("unroll") for (int j = 0; j < 4; ++j) HV[j] = HV[j] + MV[j] * r_ * gp[j]; \
        st_row_f32(hdst + (size_t)(row) * DM, lane, HV); \
        const float r2_ = rms_scale(HV); \
        _Pragma("unroll") for (int j = 0; j < 4; ++j) MV[j] = HV[j] * r2_ * gf[j]; \
        if (F8OUT) { \
            _Pragma("unroll") for (int j = 0; j < 4; ++j) *(GAS unsigned*)((unsigned char*)HN + (size_t)(row) * DM + 4 * lane + 256 * j) = pg8::cvt4_fp8(MV[j][0] * A8SCALE, MV[j][1] * A8SCALE, MV[j][2] * A8SCALE, MV[j][3] * A8SCALE); \
        } else if (I8OUT) {                                    \
            float am_ = 0.f; \
            _Pragma("unroll") for (int j = 0; j < 4; ++j) am_ = fmaxf(fmaxf(fmaxf(am_, fabsf(MV[j][0])), fmaxf(fabsf(MV[j][1]), fabsf(MV[j][2]))), fabsf(MV[j][3])); \
            _Pragma("unroll") for (int o_ = 1; o_ < 64; o_ <<= 1) am_ = fmaxf(am_, __shfl_xor(am_, o_)); \
            const float q_ = am_ > 0.f ? 127.0f / am_ : 0.f; \
            _Pragma("unroll") for (int j = 0; j < 4; ++j) *(GAS unsigned*)((unsigned char*)HN + (size_t)(row) * DM + 4 * lane + 256 * j) = pack4_i8(MV[j][0] * q_, MV[j][1] * q_, MV[j][2] * q_, MV[j][3] * q_); \
            if (lane == 0) ((float*)((unsigned char*)HN + (WS_SA - WS_HN)))[row] = am_ * (1.0f / 127.0f); \
        } else st_row_bf16(HN + (size_t)(row) * DM, lane, MV); \
        if (ROUTE) { \
            float lg[8]; \
            _Pragma("unroll") for (int e = 0; e < 8; ++e) lg[e] = 0.f; \
            _Pragma("unroll") for (int j = 0; j < 4; ++j) \
            _Pragma("unroll") for (int k = 0; k < 4; ++k) { const float xv = MV[j][k]; const f32x4 w0_ = wrl[((j * 4 + k) * 2) * 64 + lane], w1_ = wrl[((j * 4 + k) * 2 + 1) * 64 + lane]; \
                _Pragma("unroll") for (int e = 0; e < 4; ++e) { lg[e] += xv * w0_[e]; lg[4 + e] += xv * w1_[e]; } } \
            _Pragma("unroll") for (int e = 0; e < 8; ++e) lg[e] = wave_sum(lg[e]); \
            int e0 = 0; float l0 = lg[0]; \
            _Pragma("unroll") for (int e = 1; e < 8; ++e) if (lg[e] > l0) { l0 = lg[e]; e0 = e; } \
            int e1 = -1; float l1 = -INFINITY; \
            _Pragma("unroll") for (int e = 0; e < 8; ++e) if (e != e0 && lg[e] > l1) { l1 = lg[e]; e1 = e; } \
            if (e1 < 0) e1 = (e0 + 1) & 7; \
            const float w0 = 1.0f / (1.0f + expf(l1 - l0)); \
            if (lane == 0) { const unsigned r0 = __hip_atomic_fetch_add(lcnt + e0, 1u, __ATOMIC_RELAXED, __HIP_MEMORY_SCOPE_WORKGROUP), r1 = __hip_atomic_fetch_add(lcnt + e1, 1u, __ATOMIC_RELAXED, __HIP_MEMORY_SCOPE_WORKGROUP); \
                v4u tk; tk.x = (unsigned)e0 | ((unsigned)e1 << 8); tk.y = r0; tk.z = r1; tk.w = __float_as_uint(w0); *(GAS v4u*)(TOK + (row)) = tk; } \
        } \
    } while (0)
    for (int blk = vcu; blk < NTOK / 256; blk += G) {
        if (ROUTE) { if (tid < 8) lcnt[tid] = 0u; __syncthreads(); }
        const int rowb = blk * 256 + wave;
        f32x4 hA[4], mA[4], hB[4], mB[4];
        T3_LOAD(hA, mA, rowb);
        for (int i = 0; i < 32; i += 2) {
            T3_LOAD(hB, mB, rowb + 8 * (i + 1));
            T3_ROW(hA, mA, rowb + 8 * i);
            if (i + 2 < 32) T3_LOAD(hA, mA, rowb + 8 * (i + 2));
            T3_ROW(hB, mB, rowb + 8 * (i + 1));
        }
        if (ROUTE) { __syncthreads(); if (tid < 8) { const unsigned c = lcnt[tid]; const unsigned base = __hip_atomic_fetch_add(cnt + tid, c, __ATOMIC_RELAXED, __HIP_MEMORY_SCOPE_AGENT); WGB[blk * 8 + tid] = base; } __syncthreads(); }
    }
#undef T3_LOAD
#undef T3_ROW
}
__device__ __forceinline__ void load_layout(gu32* cnt, int (&cn)[8], int (&ps)[8], int (&pe)[8]) {
    int acc = 0;
#pragma unroll
    for (int e = 0; e < 8; ++e) { const int c = __builtin_amdgcn_readfirstlane((int)__hip_atomic_load(cnt + e, RLX_AGENT)); cn[e] = c; ps[e] = acc; acc += (c + 511) & ~511; pe[e] = acc; }
}
__device__ __forceinline__ void phase_gather(const unsigned char* HN, unsigned char* XS, const v4u* TOK, const unsigned* WGB, gu32* cnt, LAS int* psl, int gw, int NGW, int lane, int tid) {
    int cn[8], ps[8], pe[8]; load_layout(cnt, cn, ps, pe);
    if (tid == 0) {
#pragma unroll
        for (int e = 0; e < 8; ++e) psl[e] = ps[e]; }
    __syncthreads();
    for (int row0 = gw; row0 < NTOK; row0 += 4 * NGW) {
        v4u tk[4], v0[4]; size_t d0[4], d1[4];
#pragma unroll
        for (int u = 0; u < 4; ++u) { const int row = row0 + u * NGW; tk[u] = *(const GAS v4u*)(TOK + row); v0[u] = *(const GAS v4u*)(HN + (size_t)row * DM + 16 * lane); }
#pragma unroll
        for (int u = 0; u < 4; ++u) { const int row = row0 + u * NGW; const int e0 = tk[u].x & 255, e1 = (tk[u].x >> 8) & 255;
            d0[u] = (size_t)(psl[e0] + (int)WGB[(row >> 8) * 8 + e0] + (int)tk[u].y); d1[u] = (size_t)(psl[e1] + (int)WGB[(row >> 8) * 8 + e1] + (int)tk[u].z); }
#pragma unroll
        for (int u = 0; u < 4; ++u) { *(GAS v4u*)(XS + d0[u] * DM + 16 * lane) = v0[u]; *(GAS v4u*)(XS + d1[u] * DM + 16 * lane) = v0[u]; }
    }
    const v4u z = (v4u){0u, 0u, 0u, 0u};
#pragma unroll
    for (int e = 0; e < 8; ++e)
        for (int r = ps[e] + cn[e] + gw; r < pe[e]; r += NGW) *(GAS v4u*)(XS + (size_t)r * DM + 16 * lane) = z;
}
template <bool MOE, bool NEXT>
__device__ __forceinline__ void phase_t4(float* h, const bf16* F, const v4u* TOK, const unsigned* WGB, gu32* cnt, LAS int* psl, const float* gpost, const float* gnext, bf16* HN, int gw, int NGW, int lane, int tid) {
    if (MOE) { int cn[8], ps[8], pe[8]; load_layout(cnt, cn, ps, pe);
        if (tid == 0) {
#pragma unroll
            for (int e = 0; e < 8; ++e) psl[e] = ps[e]; }
        __syncthreads(); }
    f32x4 gp[4], gn[4];
#pragma unroll
    for (int j = 0; j < 4; ++j) { gp[j] = *(const GAS f32x4*)(gpost + 4 * lane + 256 * j); gn[j] = NEXT ? *(const GAS f32x4*)(gnext + 4 * lane + 256 * j) : (f32x4){0.f, 0.f, 0.f, 0.f}; }
#define T4_META(TK, r) do { if (MOE) TK = *(const GAS v4u*)(TOK + (r)); } while (0)
#define T4_LOAD(FV, F1, HV, TK, r) do { \
        if (MOE) { const int e0_ = TK.x & 255, e1_ = (TK.x >> 8) & 255; \
            const size_t d0_ = (size_t)(psl[e0_] + (int)WGB[((r) >> 8) * 8 + e0_] + (int)TK.y), d1_ = (size_t)(psl[e1_] + (int)WGB[((r) >> 8) * 8 + e1_] + (int)TK.z); \
            ld_row_bf16(F + d0_ * DM, lane, FV); ld_row_bf16(F + d1_ * DM, lane, F1); } \
        else ld_row_bf16(F + (size_t)(r) * DM, lane, FV); \
        ld_row_f32(h + (size_t)(r) * DM, lane, HV); } while (0)
#define T4_ROW(FV, F1, HV, W0, row) do { \
        if (MOE) { const float w0_ = W0, w1_ = 1.0f - w0_; _Pragma("unroll") for (int j = 0; j < 4; ++j) FV[j] = FV[j] * w0_ + F1[j] * w1_; } \
        const float r_ = rms_scale(FV); \
        _Pragma("unroll") for (int j = 0; j < 4; ++j) HV[j] = HV[j] + FV[j] * r_ * gp[j]; \
        st_row_f32(h + (size_t)(row) * DM, lane, HV); \
        if (NEXT) { const float r2_ = rms_scale(HV); \
            _Pragma("unroll") for (int j = 0; j < 4; ++j) FV[j] = HV[j] * r2_ * gn[j]; \
            if (PROJ_I8_IN) st_row_i8((unsigned char*)HN + (size_t)(row) * DM, (float*)((unsigned char*)HN + (WS_SA - WS_HN)) + (row), lane, FV); else st_row_bf16(HN + (size_t)(row) * DM, lane, FV); } \
    } while (0)
    const int nrow = (NTOK - gw + NGW - 1) / NGW;
    f32x4 fA[4], gA[4], hA[4], fB[4], gB[4], hB[4]; v4u tA = (v4u){0u, 0u, 0u, 0u}, tB = tA, tN = tA; float wA = 0.f, wB = 0.f;
    if (nrow > 0) { T4_META(tA, gw); T4_LOAD(fA, gA, hA, tA, gw); wA = __uint_as_float(tA.w); if (nrow > 1) T4_META(tN, gw + NGW); }
    for (int i = 0; i < nrow; i += 2) {
        if (i + 1 < nrow) { tB = tN; T4_LOAD(fB, gB, hB, tB, gw + (i + 1) * NGW); wB = __uint_as_float(tB.w); if (i + 2 < nrow) T4_META(tN, gw + (i + 2) * NGW); }
        T4_ROW(fA, gA, hA, wA, gw + i * NGW);
        if (i + 1 < nrow) {
            if (i + 2 < nrow) { tA = tN; T4_LOAD(fA, gA, hA, tA, gw + (i + 2) * NGW); wA = __uint_as_float(tA.w); if (i + 3 < nrow) T4_META(tN, gw + (i + 3) * NGW); }
            T4_ROW(fB, gB, hB, wB, gw + (i + 1) * NGW);
        }
    }
#undef T4_META
#undef T4_LOAD
#undef T4_ROW
}
__device__ __forceinline__ void phase_vt(const bf16* VA, const bf16* VB, unsigned char* VT, LAS unsigned char* scr, int gw, int NGW, int lane) {
    const int k5 = lane & 31; const int slot = 32 * ((k5 >> 2) & 1) + (k5 & 3) + 4 * (k5 >> 3) + 16 * (lane >> 5);
    for (int tl = gw; tl < 6144; tl += NGW) {
        const bool isB = tl >= 2048; const int ti = isB ? tl - 2048 : tl, t = ti & 127, bh = ti >> 7, DVt = isB ? 128 : 64;
        const bf16* src = isB ? VB + ((size_t)(bh >> 2) * SEQL + 64 * t + lane) * 512 + 128 * (bh & 3) : VA + ((size_t)(bh >> 1) * SEQL + 64 * t + lane) * 128 + 64 * (bh & 1);
        unsigned char* dst = VT + (isB ? ((size_t)8 * MiB + (size_t)ti * 8192) : (size_t)ti * 4096);
        for (int c = 0; c < DVt / 8; ++c) { const v4u w = *(const GAS v4u*)(src + 8 * c); float f[8]; unpack8(w, f);
            const unsigned lo = pg8::cvt4_fp8(f[0] * attn_body::V8SCALE, f[1] * attn_body::V8SCALE, f[2] * attn_body::V8SCALE, f[3] * attn_body::V8SCALE), hi = pg8::cvt4_fp8(f[4] * attn_body::V8SCALE, f[5] * attn_body::V8SCALE, f[6] * attn_body::V8SCALE, f[7] * attn_body::V8SCALE);
#pragma unroll
            for (int i = 0; i < 4; ++i) { scr[(8 * c + i) * 64 + slot] = (unsigned char)(lo >> (8 * i)); scr[(8 * c + 4 + i) * 64 + slot] = (unsigned char)(hi >> (8 * i)); } }
        LDS_WAIT(); asm volatile("" ::: "memory");
        for (int it = 0; it < DVt / 16; ++it) { const int q = it * 64 + lane; *(GAS v4u*)(dst + 16 * q) = *(const LAS v4u*)(scr + 16 * q); }
        LDS_WAIT(); asm volatile("" ::: "memory");
    }
}
__device__ __forceinline__ void phase_quant_gu(KArgs A, LAS unsigned char* L, int gw, int NGW, int wave, int lane) {
    unsigned char* ws = A->ws; LAS float* scr = (LAS float*)(L + RING_OFF + wave * 16384);
    constexpr int I_FF = (DM / 64) * (DFF / 32);
    if (DENSE_I8) for (int it = gw; it < 2 * I_FF; it += NGW) { const int mtx = it / I_FF, sub = it % I_FF; ConvDesc d{A->in[12 + mtx], ws + WS_WGU_D, DM, DFF, 2 + mtx, 0}; f32x4 v[8];
        conv_load(d, sub, lane, v); conv_store_i8(d, sub, lane, v, scr, (gu32*)(ws + WS_CTL) + CW_CMAX + mtx * DFF, (float*)(ws + WS_SWGU)); }
    if (PROJ_I8) { constexpr int I_IN = (DM / 64) * (INW / 32), I_OUT = (DM / 64) * (DM / 32);
        for (int it = gw; it < 2 * I_IN + 2 * I_OUT; it += NGW) { f32x4 v[8];
            if (it < 2 * I_IN) { if (!PROJ_I8_IN) continue; const int l = it / I_IN, sub = it % I_IN; ConvDesc d{A->in[1] + (size_t)l * DM * INW, ws + WS_WIN + (size_t)l * INW * DM, DM, INW, 1, 0};
                conv_load(d, sub, lane, v); conv_store_i8(d, sub, lane, v, scr, (gu32*)(ws + WS_CTL) + CW_CMAX_IN + l * INW, (float*)(ws + WS_SWIN) + l * INW); }
            else { if (!PROJ_I8_OUT) continue; const int r = it - 2 * I_IN, l = r / I_OUT, sub = r % I_OUT; ConvDesc d{A->in[2] + (size_t)l * DM * DM, ws + WS_WOUT + (size_t)l * DM * DM, DM, DM, 0, 0};
                conv_load(d, sub, lane, v); conv_store_i8(d, sub, lane, v, scr, (gu32*)(ws + WS_CTL) + CW_CMAX_OUT + l * DM, (float*)(ws + WS_SWOUT) + l * DM); } } }
}
#ifndef MK_PER_PHASE
#define MK_PER_PHASE 0
#endif
#ifndef PROBE_BREP
#define PROBE_BREP 1
#endif
#ifndef PROBE_P0
#define PROBE_P0 1
#endif
#ifndef PROBE_G1
#define PROBE_G1 1
#endif
#ifndef PROBE_G2
#define PROBE_G2 1
#endif
#ifndef PROBE_G3
#define PROBE_G3 1
#endif
#ifndef PROBE_G4
#define PROBE_G4 1
#endif
#ifndef PROBE_T2
#define PROBE_T2 1
#endif
#ifndef MK_PH_HI
#define MK_PH_HI 1000
#endif
constexpr int N_PHASES = 31;
constexpr int TE_OFF = LDSCTL_OFF + 1024;
__device__ __forceinline__ int fill_tile_experts(gu32* cnt, LAS int* te, int tid) {
    int cn[8], ps[8], pe[8]; load_layout(cnt, cn, ps, pe);
    for (int i = tid; i < 528; i += NWAVES * 64) { const int row = i * 256; int e = 0;
#pragma unroll
        for (int j = 0; j < 7; ++j) e += (row >= pe[j]) ? 1 : 0;
        te[i] = e; }
    __syncthreads();
    return pe[7] / 256;
}
#define IN() (lo <= ph && ph < hi)
#define SEAM() do { if (lo <= ph && ph + 1 < hi) xcd_barrier(bar); ++ph; } while (0)
#define TIDO() int tid; asm volatile("v_mbcnt_lo_u32_b32 %0, -1, 0\n\tv_mbcnt_hi_u32_b32 %0, -1, %0" : "=v"(tid)); tid += wave_s * 64
#define LANE (tid & 63)
#define WAVE (__builtin_amdgcn_readfirstlane(tid >> 6))
#define GW (vcu * NWAVES + WAVE)
#define NGW (G * NWAVES)
#define LCNT ((LAS unsigned*)(L + LDSCTL_OFF))
#define PSL ((LAS int*)(L + LDSCTL_OFF + 64))
#define TE ((LAS int*)(L + TE_OFF))
template <int LAYER>
__device__ __forceinline__ void layer_body(LAS unsigned char* L, unsigned char* lds, const XcdBarrier& bar, int lo, int hi, int& ph, int G, int bx, int vcu, int wave_s) {
    constexpr int layer = LAYER;
    constexpr bool moe = (LAYER & 1) != 0;
    if (IN()) {
        KArgs A = kargs(); unsigned char* ws = A->ws;
        pg8::StaticOrder S; S.init(NTOK / 256, INW / 256, G, bx, 0);
        if constexpr (PROJ_I8_IN) {
            pg8::Gemm g{(const bf16*)(ws + WS_HN), (const bf16*)(ws + WS_WIN + (size_t)layer * INW * DM), NTOK, INW, DM / 2};
            pg8::EpiInProjI8 E{ws, WS_QA, WS_KA, WS_VA, WS_QB, WS_KB, WS_VB, A->in[7] + 64 * layer, A->in[8] + 64 * layer, attn_body::C2, (const float*)(ws + WS_SA), (const float*)(ws + WS_SWIN) + layer * INW};
            pg8::gemm_phase<pg8::EpiInProjI8, pg8::StaticOrder, true, true, false, true>(L + RING_OFF, g, S, E, wave_s);
        } else {
        pg8::Gemm g{(const bf16*)(ws + WS_HN), (const bf16*)(ws + WS_WIN) + (size_t)layer * INW * DM, NTOK, INW, DM};
        pg8::EpiInProj E{ws, WS_QA, WS_KA, WS_VA, WS_QB, WS_KB, WS_VB, A->in[7] + 64 * layer, A->in[8] + 64 * layer, attn_body::C2};
        for (int rep_ = 0; rep_ < PROBE_G1; ++rep_) pg8::gemm_phase<pg8::EpiInProj, pg8::StaticOrder, true, true>(L + RING_OFF, g, S, E, wave_s);
        }
    }
    SEAM();
    if (IN()) { TIDO(); unsigned char* ws = kargs()->ws; phase_vt((const bf16*)(ws + WS_VA), (const bf16*)(ws + WS_VB), ws + WS_VT8, L + RING_OFF + WAVE * 16384, GW, NGW, LANE); }
    SEAM();
    if (IN()) {
        for (int i = 0;; ++i) {
            int b, st, qb; bool grpB;
            if (G == 256) { if (i >= 16) break; const int grp = vcu >> 3, s = i >> 2; b = grp >> 2; grpB = s >= 2; st = 4 * (s & 1) + (grp & 3); qb = (vcu & 7) + 8 * (i & 3); }
            else { const int Lu = i * G + vcu; if (Lu >= 4096) break; grpB = Lu >= 2048; qb = Lu & 31; const int sm = (Lu & 2047) >> 5; b = sm >> 3; st = sm & 7; }
            unsigned char* ws = kargs()->ws;
            typedef attn_body::bf16 abf;
            const long rb = (long)b * SEQL, qrow = rb + 256 * qb;
            if (!grpB) { const int hq = st, kh = hq >> 2;
                attn_body::attn_unit8<64>((const abf*)(ws + WS_QA) + 64 * hq + qrow * 512, 512, (const abf*)(ws + WS_KA) + 64 * kh + rb * 128, 128, ws + WS_VT8 + (size_t)(b * 2 + kh) * 128 * 4096,
                                          (abf*)(ws + WS_OA) + 64 * hq + qrow * 512, 512, (char*)lds + RING_OFF, wave_s); }
            else for (int rep_ = 0; rep_ < PROBE_BREP; ++rep_) { const int h = st >> 1, m = st & 1;
                attn_body::attn_unit8<128>((const abf*)(ws + WS_QB) + 64 * st + qrow * 512, 512, (const abf*)(ws + WS_KB) + 64 * st + rb * 512, 512, ws + WS_VT8 + (size_t)8 * MiB + (size_t)(b * 4 + h) * 128 * 8192,
                                           (abf*)(ws + WS_OB) + 512 * m + 128 * h + qrow * 1024, 1024, (char*)lds + RING_OFF, wave_s); }
        }
    }
    SEAM();
    if (IN()) { TIDO(); KArgs A = kargs(); unsigned char* ws = A->ws; const float lam_init = 0.8f - 0.6f * expf(-0.3f * (float)layer);
        for (int rep_ = 0; rep_ < PROBE_T2; ++rep_) phase_t2((const bf16*)(ws + WS_OA), (const bf16*)(ws + WS_OB), (bf16*)(ws + WS_AO), A->in[9] + 512 * layer, A->in[11] + 128 * layer, A->in[10] + 256 * layer, lam_init, GW, NGW, LANE); }
    SEAM();
    if (IN()) {
        unsigned char* ws = kargs()->ws;
        pg8::StaticOrder S; S.init(NTOK / 256, DM / 256, G, bx, 0);
        if constexpr (PROJ_I8_OUT) {
            pg8::Gemm g{(const bf16*)(ws + WS_AO), (const bf16*)(ws + WS_WOUT + (size_t)layer * DM * DM), NTOK, DM, DM / 2};
            pg8::EpiBf16I8 E{(bf16*)(ws + WS_MIX), DM, (const float*)(ws + WS_SA2), (const float*)(ws + WS_SWOUT) + layer * DM};
            pg8::gemm_phase<pg8::EpiBf16I8, pg8::StaticOrder, true, true, false, true>(L + RING_OFF, g, S, E, wave_s);
        } else {
        pg8::Gemm g{(const bf16*)(ws + WS_AO), (const bf16*)(ws + WS_WOUT) + (size_t)layer * DM * DM, NTOK, DM, DM};
        pg8::EpiBf16 E{(bf16*)(ws + WS_MIX), DM};
        for (int rep_ = 0; rep_ < PROBE_G2; ++rep_) pg8::gemm_phase<pg8::EpiBf16, pg8::StaticOrder, true, true>(L + RING_OFF, g, S, E, wave_s);
        }
    }
    SEAM();
    if (IN()) {
        TIDO(); KArgs A = kargs(); unsigned char* ws = A->ws;
        const float* hsrc = layer == 0 ? A->in[0] : A->out;
        if constexpr (moe) phase_t3<true>(hsrc, A->out, (const bf16*)(ws + WS_MIX), (bf16*)(ws + WS_HN), A->in[4] + DM * layer, A->in[5] + DM * layer, A->in[15], (v4u*)(ws + WS_TOK), (unsigned*)(ws + WS_WGB), (gu32*)(ws + WS_CTL) + CW_CNT, LCNT, (LAS f32x4*)(L + RING_OFF), vcu, G, WAVE, LANE, tid);
        else phase_t3<false, DENSE_F8 != 0, DENSE_I8 != 0>(hsrc, A->out, (const bf16*)(ws + WS_MIX), (bf16*)(ws + WS_HN), A->in[4] + DM * layer, A->in[5] + DM * layer, A->in[15], (v4u*)(ws + WS_TOK), (unsigned*)(ws + WS_WGB), (gu32*)(ws + WS_CTL) + CW_CNT, LCNT, (LAS f32x4*)(L + RING_OFF), vcu, G, WAVE, LANE, tid);
    }
    SEAM();
    if constexpr (moe) { if (IN()) { TIDO(); unsigned char* ws = kargs()->ws; phase_gather(ws + WS_HN, ws + WS_XS, (const v4u*)(ws + WS_TOK), (const unsigned*)(ws + WS_WGB), (gu32*)(ws + WS_CTL) + CW_CNT, PSL, GW, NGW, LANE, tid); } SEAM(); }
    if constexpr (!moe) {
        for (int c = 0; c < 2; ++c) {
            const int pm0 = c * CHUNK_TILES;
            if (IN()) {
                unsigned char* ws = kargs()->ws;
                pg8::StaticOrder S; S.init(CHUNK_TILES, 2 * DFF / 256, G, bx, pm0);
                if constexpr (DENSE_I8) {
                    pg8::Gemm g{(const bf16*)(ws + WS_HN), (const bf16*)(ws + WS_WGU_D), 0, 2 * DFF, DM / 2};
                    pg8::EpiSwiGLUI8 E{(bf16*)(ws + WS_ACT) - (size_t)pm0 * 256 * DFF, DFF, (const float*)(ws + WS_SA), (const float*)(ws + WS_SWGU)};
                    pg8::gemm_phase<pg8::EpiSwiGLUI8, pg8::StaticOrder, true, true, false, true>(L + RING_OFF, g, S, E, wave_s);
                } else if constexpr (DENSE_F8) {
                    pg8::Gemm g{(const bf16*)(ws + WS_HN), (const bf16*)(ws + WS_WGU_D), 0, 2 * DFF, DM / 2};
                    pg8::EpiSwiGLU8 E{ws + WS_ACT - (size_t)pm0 * 256 * DFF, DFF, 1.0f / (A8SCALE * W8SCALE), H8SCALE};
                    pg8::gemm_phase<pg8::EpiSwiGLU8, pg8::StaticOrder, true, true, true>(L + RING_OFF, g, S, E, wave_s);
                } else {
                    pg8::Gemm g{(const bf16*)(ws + WS_HN), (const bf16*)(ws + WS_WGU_D), 0, 2 * DFF, DM};
                    pg8::EpiSwiGLU E{(bf16*)(ws + WS_ACT) - (size_t)pm0 * 256 * DFF, DFF};
                    for (int rep_ = 0; rep_ < PROBE_G3; ++rep_) pg8::gemm_phase<pg8::EpiSwiGLU, pg8::StaticOrder, true, true>(L + RING_OFF, g, S, E, wave_s);
                }
            }
            SEAM();
            if (IN()) {
                unsigned char* ws = kargs()->ws;
                pg8::StaticOrder S; S.init(CHUNK_TILES, DM / 256, G, bx, pm0);
                if constexpr (DENSE_F8) {
                    pg8::Gemm g{(const bf16*)(ws + WS_ACT - (size_t)pm0 * 256 * DFF), (const bf16*)(ws + WS_WDN_D), 0, DM, DFF / 2};
                    pg8::EpiBf16S E{(bf16*)(ws + WS_F), DM, 1.0f / (H8SCALE * W8SCALE)};
                    pg8::gemm_phase<pg8::EpiBf16S, pg8::StaticOrder, true, true, true>(L + RING_OFF, g, S, E, wave_s);
                } else {
                    pg8::Gemm g{(const bf16*)(ws + WS_ACT) - (size_t)pm0 * 256 * DFF, (const bf16*)(ws + WS_WDN_D), 0, DM, DFF};
                    pg8::EpiBf16 E{(bf16*)(ws + WS_F), DM};
                    for (int rep_ = 0; rep_ < PROBE_G4; ++rep_) pg8::gemm_phase<pg8::EpiBf16, pg8::StaticOrder, true, true>(L + RING_OFF, g, S, E, wave_s);
                }
            }
            SEAM();
        }
    } else {
        for (int c = 0; c < 5; ++c) {
            const int pm0 = c * CHUNK_TILES;
            if (IN()) {
                TIDO(); unsigned char* ws = kargs()->ws;
                const int n_used = fill_tile_experts((gu32*)(ws + WS_CTL) + CW_CNT, TE, tid);
                int nt = n_used - pm0; nt = nt > CHUNK_TILES ? CHUNK_TILES : nt;
                if (nt > 0) {
                    pg8::Gemm g{(const bf16*)(ws + WS_XS), (const bf16*)(ws + WS_WGU_M), 0, 2 * DFF, DM / 2};
                    pg8::StaticOrder S; S.init(nt, 2 * DFF / 256, G, bx, pm0); S.estride = (unsigned)(2 * DFF * DM); S.te = TE;
                    pg8::EpiSwiGLU8 E{ws + WS_ACT8 - (size_t)pm0 * 256 * DFF, DFF, 1.0f / (A8SCALE * W8SCALE), H8SCALE};
                    for (int rep_ = 0; rep_ < PROBE_G3; ++rep_) pg8::gemm_phase<pg8::EpiSwiGLU8, pg8::StaticOrder, true, true, true>(L + RING_OFF, g, S, E, wave_s);
                }
            }
            SEAM();
            if (IN()) {
                TIDO(); unsigned char* ws = kargs()->ws;
                const int n_used = fill_tile_experts((gu32*)(ws + WS_CTL) + CW_CNT, TE, tid);
                int nt = n_used - pm0; nt = nt > CHUNK_TILES ? CHUNK_TILES : nt;
                if (nt > 0) {
                    pg8::Gemm g{(const bf16*)(ws + WS_ACT8 - (size_t)pm0 * 256 * DFF), (const bf16*)(ws + WS_WDN_M), 0, DM, DFF / 2};
                    pg8::StaticOrder S; S.init(nt, DM / 256, G, bx, pm0); S.estride = (unsigned)(DM * DFF); S.te = TE;
                    pg8::EpiBf16S E{(bf16*)(ws + WS_YS), DM, 1.0f / (H8SCALE * W8SCALE)};
                    for (int rep_ = 0; rep_ < PROBE_G4; ++rep_) pg8::gemm_phase<pg8::EpiBf16S, pg8::StaticOrder, true, true, true>(L + RING_OFF, g, S, E, wave_s);
                }
            }
            SEAM();
        }
    }
    if (IN()) {
        TIDO(); KArgs A = kargs(); unsigned char* ws = A->ws;
        if constexpr (moe) phase_t4<true, false>(A->out, (const bf16*)(ws + WS_YS), (const v4u*)(ws + WS_TOK), (const unsigned*)(ws + WS_WGB), (gu32*)(ws + WS_CTL) + CW_CNT, PSL, A->in[6] + DM * layer, nullptr, (bf16*)(ws + WS_HN), GW, NGW, LANE, tid);
        else phase_t4<false, true>(A->out, (const bf16*)(ws + WS_F), (const v4u*)(ws + WS_TOK), (const unsigned*)(ws + WS_WGB), (gu32*)(ws + WS_CTL) + CW_CNT, PSL, A->in[6] + DM * layer, A->in[3] + DM * (layer + 1), (bf16*)(ws + WS_HN), GW, NGW, LANE, tid);
    }
    if constexpr (LAYER + 1 < NLAYER) SEAM();
}
__global__ void __launch_bounds__(NWAVES * 64, 2) fwd_kernel(Args args_unused) {
    extern __shared__ __attribute__((aligned(16))) unsigned char lds[];
    LAS unsigned char* L = (LAS unsigned char*)lds;
    const int tid0 = threadIdx.x; const int wave_s = __builtin_amdgcn_readfirstlane(tid0 >> 6);
    const int G = gridDim.x, bx = blockIdx.x;
    const int vcu = (G % 8 == 0) ? (bx % 8) * (G / 8) + bx / 8 : bx;
    for (int u = tid0; u < (LDS_BYTES - LDSCTL_OFF) / 4; u += NWAVES * 64) ((LAS unsigned*)(L + LDSCTL_OFF))[u] = 0u;
    __syncthreads();
    XcdBarrier bar;
    int lo, hi;
    { KArgs A = kargs(); lo = A->ph_lo; hi = A->ph_hi; bar = xcd_barrier_post((unsigned*)(A->ws + WS_CTL) + CW_BAR, (volatile LAS unsigned*)(L + MISC_OFF) + 8); }
    int ph = 0;

    if (IN()) { for (int rep_ = 0; rep_ < PROBE_P0; ++rep_) { TIDO(); phase_prologue(kargs(), L, GW, NGW, WAVE, LANE); } }
    SEAM();
    if (DENSE_I8 || PROJ_I8) { if (IN()) { TIDO(); phase_quant_gu(kargs(), L, GW, NGW, WAVE, LANE); } SEAM(); }
    layer_body<0>(L, lds, bar, lo, hi, ph, G, bx, vcu, wave_s);
    layer_body<1>(L, lds, bar, lo, hi, ph, G, bx, vcu, wave_s);
#undef IN
#undef SEAM
}

extern "C" void kernel_launch(void* const* d_in, const int* in_sizes, int n_in, void* d_out, int out_size, void* d_ws, size_t ws_size, hipStream_t stream) {
    static int grid = 0;
    if (grid == 0) {
        if (n_in != 19 || in_sizes[0] != NTOK * DM || out_size != NTOK * DM || ws_size < WS_END) {
            fprintf(stderr, "kernel_launch: built for 19 inputs, x/out of %d floats, >= %zu bytes of workspace; got n_in %d, in0 %d, out %d, ws %zu; nothing launched\n", NTOK * DM, (size_t)WS_END, n_in, n_in > 0 ? in_sizes[0] : -1, out_size, ws_size);
            grid = -1; return; }
        int dev = 0, cus = 0, per_cu = 0;
        if (hipGetDevice(&dev) != hipSuccess || hipDeviceGetAttribute(&cus, hipDeviceAttributeMultiprocessorCount, dev) != hipSuccess) { fprintf(stderr, "kernel_launch: device query failed\n"); grid = -1; return; }
        if (hipFuncSetAttribute((const void*)fwd_kernel, hipFuncAttributeMaxDynamicSharedMemorySize, LDS_BYTES) != hipSuccess) { fprintf(stderr, "kernel_launch: hipFuncSetAttribute failed\n"); grid = -1; return; }
        if (hipOccupancyMaxActiveBlocksPerMultiprocessor(&per_cu, (const void*)fwd_kernel, NWAVES * 64, LDS_BYTES) != hipSuccess || per_cu < 1)
            fprintf(stderr, "kernel_launch: note: occupancy query reports %d workgroups per CU\n", per_cu);
        (void)hipGetLastError();
        grid = cus;
    }
    if (grid < 0) return;
    if (hipMemsetAsync((char*)d_ws + WS_CTL, 0, CTL_ZERO_BYTES, stream) != hipSuccess) { fprintf(stderr, "kernel_launch: memset failed\n"); return; }
    Args a{};
    for (int i = 0; i < 19; ++i) a.in[i] = (const float*)d_in[i];
    a.out = (float*)d_out; a.ws = (unsigned char*)d_ws;
    const int ph_end = MK_PH_HI < N_PHASES ? MK_PH_HI : N_PHASES;
#if MK_PER_PHASE
    for (int p = 0; p < ph_end; ++p) { a.ph_lo = p; a.ph_hi = p + 1; hipLaunchKernelGGL(fwd_kernel, dim3(grid), dim3(NWAVES * 64), LDS_BYTES, stream, a); }
#else
    a.ph_lo = 0; a.ph_hi = ph_end;
    hipLaunchKernelGGL(fwd_kernel, dim3(grid), dim3(NWAVES * 64), LDS_BYTES, stream, a);
#endif
    const hipError_t le = hipPeekAtLastError();
    if (le != hipSuccess) fprintf(stderr, "kernel_launch: launch failed: %s\n", hipGetErrorName(le));
}
```

```cpp
#include <hip/hip_runtime.h>
#include <hip/hip_bf16.h>
#include <cstdio>
#include <cstdint>
#include <cmath>
namespace pg8 {
#define PG8_LAS __attribute__((address_space(3)))
typedef unsigned short bf16_t;
typedef short bf16x8 __attribute__((ext_vector_type(8)));
typedef float f32x4 __attribute__((ext_vector_type(4)));
typedef unsigned u32x4 __attribute__((ext_vector_type(4)));
typedef int i32x4 __attribute__((ext_vector_type(4)));
typedef int i32x8 __attribute__((ext_vector_type(8)));
constexpr int BM = 256, BK = 64, HALF = 128, HTB = HALF * BK * 2  , STAGE_BYTES = 8 * HTB, NXCD = 8, WGM = 8;

__host__ __device__ __forceinline__ int lds_byte(int r, int c) { const int st = (r >> 4) * 2 + (c >> 5), rr = r & 15, cc = c & 31, ob = rr * 64 + cc * 2; return st * 1024 + (ob ^ (((ob >> 9) & 1) << 5)); }
__host__ __device__ __forceinline__ void stage_rc(int b, int& R, int& C) { const int st = b / 1024, sb = b % 1024, swz = sb ^ (((sb >> 9) & 1) << 5); R = (st >> 1) * 16 + swz / 64; C = (st & 1) * 32 + (swz % 64) / 2; }
__host__ __device__ __forceinline__ int perm32(int rho) { const int n = rho >> 4, i = rho & 15; return 8 * (i >> 2) + 4 * n + (i & 3); }

struct Unit { int pm, pn; };
struct Gemm { const bf16_t* A; const bf16_t* Bt; int M, N, K; };

struct StaticOrder {
    int nM, nN, nwg, G, c, pm0; const PG8_LAS int* te; unsigned estride;
    __device__ void init(int nM_, int nN_, int G_, int c_, int pm0_) { nM = nM_; nN = nN_; nwg = nM * nN; G = G_; c = c_; pm0 = pm0_; estride = 0; te = nullptr; }
    __device__ bool next(int i, Unit& u) const {
        const long L = (long)i * G + c; if (L >= nwg) return false;
        int wgid = (int)L; { const int q = nwg / NXCD, r = nwg % NXCD, xcd = wgid % NXCD, off = wgid / NXCD; wgid = (xcd < r ? xcd * (q + 1) : r * (q + 1) + (xcd - r) * q) + off; }
        const int nig = WGM * nN, gid = wgid / nig, fm = gid * WGM, gsz = (nM - fm) < WGM ? (nM - fm) : WGM;
        u.pm = pm0 + fm + ((wgid % nig) % gsz); u.pn = (wgid % nig) / gsz; return true;
    }
    __device__ __forceinline__ size_t bofs(const Unit& u) const { if (estride == 0) return 0; const int e = __builtin_amdgcn_readfirstlane(te[u.pm]); return (size_t)e * estride; }
    __device__ __forceinline__ void a_ready(const Unit&) const {}
    __device__ __forceinline__ void done(const Unit&) const {}
};

__device__ __forceinline__ unsigned cvt_pk_bf16(float lo, float hi) { unsigned r; asm volatile("v_cvt_pk_bf16_f32 %0, %1, %2" : "=v"(r) : "v"(lo), "v"(hi)); return r; }

struct EpiBf16 {
    static constexpr bool PERM = true, AFTER_DRAIN = false;
    bf16_t* O; int ldc;
    __device__ __forceinline__ void operator()(const f32x4 (&acc)[2][2][4][2], const Unit& u, int wr, int wc, int fr, int fq) const {
        const int row0 = u.pm * BM + wr * 64 + fr; const int col0 = u.pn * BM + wc * 32 + 8 * fq;
#pragma unroll
        for (int ai = 0; ai < 2; ++ai)
#pragma unroll
            for (int m = 0; m < 4; ++m) { bf16_t* rowp = O + (size_t)(row0 + ai * HALF + m * 16) * ldc + col0;
#pragma unroll
                for (int bj = 0; bj < 2; ++bj) { const f32x4 v0 = acc[ai][bj][m][0], v1 = acc[ai][bj][m][1];
                    u32x4 w; w.x = cvt_pk_bf16(v0[0], v0[1]); w.y = cvt_pk_bf16(v0[2], v0[3]); w.z = cvt_pk_bf16(v1[0], v1[1]); w.w = cvt_pk_bf16(v1[2], v1[3]);
                    *(u32x4*)(rowp + bj * HALF) = w; } }
    }
};
__device__ __forceinline__ unsigned cvt4_fp8(float a, float b, float c, float d) {
    a = __builtin_amdgcn_fmed3f(a, -448.f, 448.f); b = __builtin_amdgcn_fmed3f(b, -448.f, 448.f); c = __builtin_amdgcn_fmed3f(c, -448.f, 448.f); d = __builtin_amdgcn_fmed3f(d, -448.f, 448.f);
    int w = 0; w = __builtin_amdgcn_cvt_pk_fp8_f32(a, b, w, false); w = __builtin_amdgcn_cvt_pk_fp8_f32(c, d, w, true); return (unsigned)w; }
struct EpiBf16S {
    static constexpr bool PERM = true, AFTER_DRAIN = false;
    bf16_t* O; int ldc; float s;
    __device__ __forceinline__ void operator()(const f32x4 (&acc)[2][2][4][2], const Unit& u, int wr, int wc, int fr, int fq) const {
        const int row0 = u.pm * BM + wr * 64 + fr; const int col0 = u.pn * BM + wc * 32 + 8 * fq;
#pragma unroll
        for (int ai = 0; ai < 2; ++ai)
#pragma unroll
            for (int m = 0; m < 4; ++m) { bf16_t* rowp = O + (size_t)(row0 + ai * HALF + m * 16) * ldc + col0;
#pragma unroll
                for (int bj = 0; bj < 2; ++bj) { const f32x4 v0 = acc[ai][bj][m][0] * s, v1 = acc[ai][bj][m][1] * s;
                    u32x4 w; w.x = cvt_pk_bf16(v0[0], v0[1]); w.y = cvt_pk_bf16(v0[2], v0[3]); w.z = cvt_pk_bf16(v1[0], v1[1]); w.w = cvt_pk_bf16(v1[2], v1[3]);
                    *(u32x4*)(rowp + bj * HALF) = w; } }
    }
};
struct EpiBf16I8 {
    static constexpr bool PERM = true, AFTER_DRAIN = false;
    bf16_t* O; int ldc; const float* sa; const float* sw;
    __device__ __forceinline__ void operator()(const f32x4 (&acc)[2][2][4][2], const Unit& u, int wr, int wc, int fr, int fq) const {
        const int row0 = u.pm * BM + wr * 64 + fr; const int col0 = u.pn * BM + wc * 32 + 8 * fq;
        f32x4 sv[2][2];
#pragma unroll
        for (int bj = 0; bj < 2; ++bj)
#pragma unroll
            for (int n = 0; n < 2; ++n) sv[bj][n] = *(const f32x4*)(sw + col0 + bj * HALF + 4 * n);
#pragma unroll
        for (int ai = 0; ai < 2; ++ai)
#pragma unroll
            for (int m = 0; m < 4; ++m) { const int row = row0 + ai * HALF + m * 16; bf16_t* rowp = O + (size_t)row * ldc + col0; const float a = sa[row];
#pragma unroll
                for (int bj = 0; bj < 2; ++bj) { const f32x4 v0 = __builtin_convertvector(__builtin_bit_cast(i32x4, acc[ai][bj][m][0]), f32x4) * (sv[bj][0] * a), v1 = __builtin_convertvector(__builtin_bit_cast(i32x4, acc[ai][bj][m][1]), f32x4) * (sv[bj][1] * a);
                    u32x4 w; w.x = cvt_pk_bf16(v0[0], v0[1]); w.y = cvt_pk_bf16(v0[2], v0[3]); w.z = cvt_pk_bf16(v1[0], v1[1]); w.w = cvt_pk_bf16(v1[2], v1[3]);
                    *(u32x4*)(rowp + bj * HALF) = w; } }
    }
};
__device__ __forceinline__ float silu_mul(float g, float u) { const float e = __builtin_amdgcn_exp2f(-1.4426950408889634f * g); return g * __builtin_amdgcn_rcpf(1.0f + e) * u; }
struct EpiSwiGLU {
    static constexpr bool PERM = true, AFTER_DRAIN = false;
    bf16_t* O; int ldc;
    __device__ __forceinline__ void operator()(const f32x4 (&acc)[2][2][4][2], const Unit& u, int wr, int wc, int fr, int fq) const {
        const int row0 = u.pm * BM + wr * 64 + fr; const int col0 = u.pn * HALF + wc * 32 + 8 * fq;
#pragma unroll
        for (int ai = 0; ai < 2; ++ai)
#pragma unroll
            for (int m = 0; m < 4; ++m) { bf16_t* rowp = O + (size_t)(row0 + ai * HALF + m * 16) * ldc + col0;
                const f32x4 g0 = acc[ai][0][m][0], g1 = acc[ai][0][m][1], u0 = acc[ai][1][m][0], u1 = acc[ai][1][m][1];
                u32x4 w; w.x = cvt_pk_bf16(silu_mul(g0[0], u0[0]), silu_mul(g0[1], u0[1])); w.y = cvt_pk_bf16(silu_mul(g0[2], u0[2]), silu_mul(g0[3], u0[3]));
                w.z = cvt_pk_bf16(silu_mul(g1[0], u1[0]), silu_mul(g1[1], u1[1])); w.w = cvt_pk_bf16(silu_mul(g1[2], u1[2]), silu_mul(g1[3], u1[3]));
                *(u32x4*)rowp = w; }
    }
};
struct EpiSwiGLUI8 {
    static constexpr bool PERM = true, AFTER_DRAIN = false;
    bf16_t* O; int ldc; const float* sa; const float* sw;
    __device__ __forceinline__ void operator()(const f32x4 (&acc)[2][2][4][2], const Unit& u, int wr, int wc, int fr, int fq) const {
        const int row0 = u.pm * BM + wr * 64 + fr; const int col0 = u.pn * HALF + wc * 32 + 8 * fq; const int brow0 = u.pn * BM + wc * 32 + 8 * fq;
        const f32x4 sg0 = *(const f32x4*)(sw + brow0), sg1 = *(const f32x4*)(sw + brow0 + 4), su0 = *(const f32x4*)(sw + brow0 + HALF), su1 = *(const f32x4*)(sw + brow0 + HALF + 4);
#pragma unroll
        for (int ai = 0; ai < 2; ++ai)
#pragma unroll
            for (int m = 0; m < 4; ++m) { const int row = row0 + ai * HALF + m * 16; bf16_t* rowp = O + (size_t)row * ldc + col0; const float a = sa[row];
                const i32x4 ig0 = __builtin_bit_cast(i32x4, acc[ai][0][m][0]), ig1 = __builtin_bit_cast(i32x4, acc[ai][0][m][1]), iu0 = __builtin_bit_cast(i32x4, acc[ai][1][m][0]), iu1 = __builtin_bit_cast(i32x4, acc[ai][1][m][1]);
                f32x4 g0, g1, u0, u1;
#pragma unroll
                for (int e = 0; e < 4; ++e) { g0[e] = (float)ig0[e] * (a * sg0[e]); g1[e] = (float)ig1[e] * (a * sg1[e]); u0[e] = (float)iu0[e] * (a * su0[e]); u1[e] = (float)iu1[e] * (a * su1[e]); }
                u32x4 w; w.x = cvt_pk_bf16(silu_mul(g0[0], u0[0]), silu_mul(g0[1], u0[1])); w.y = cvt_pk_bf16(silu_mul(g0[2], u0[2]), silu_mul(g0[3], u0[3]));
                w.z = cvt_pk_bf16(silu_mul(g1[0], u1[0]), silu_mul(g1[1], u1[1])); w.w = cvt_pk_bf16(silu_mul(g1[2], u1[2]), silu_mul(g1[3], u1[3]));
                *(u32x4*)rowp = w; }
    }
};
struct EpiSwiGLU8 {
    static constexpr bool PERM = true, AFTER_DRAIN = false;
    unsigned char* O; int ldc; float sin, sout;
    __device__ __forceinline__ void operator()(const f32x4 (&acc)[2][2][4][2], const Unit& u, int wr, int wc, int fr, int fq) const {
        typedef unsigned u32x2 __attribute__((ext_vector_type(2)));
        const int row0 = u.pm * BM + wr * 64 + fr; const int col0 = u.pn * HALF + wc * 32 + 8 * fq;
#pragma unroll
        for (int ai = 0; ai < 2; ++ai)
#pragma unroll
            for (int m = 0; m < 4; ++m) { unsigned char* rowp = O + (size_t)(row0 + ai * HALF + m * 16) * ldc + col0;
                const f32x4 g0 = acc[ai][0][m][0] * sin, g1 = acc[ai][0][m][1] * sin, u0 = acc[ai][1][m][0] * (sin * sout), u1 = acc[ai][1][m][1] * (sin * sout);
                u32x2 w; w.x = cvt4_fp8(silu_mul(g0[0], u0[0]), silu_mul(g0[1], u0[1]), silu_mul(g0[2], u0[2]), silu_mul(g0[3], u0[3]));
                w.y = cvt4_fp8(silu_mul(g1[0], u1[0]), silu_mul(g1[1], u1[1]), silu_mul(g1[2], u1[2]), silu_mul(g1[3], u1[3]));
                *(u32x2*)rowp = w; }
    }
};
template <bool I8> struct EpiInProjT {
    static constexpr bool PERM = false, AFTER_DRAIN = false;
    unsigned char* ws; size_t oQA, oKA, oVA, oQB, oKB, oVB; const float* gq; const float* gk; float qscale; const float* sa; const float* sw;
    __device__ __forceinline__ void operator()(const f32x4 (&acc)[2][2][4][2], const Unit& u, int wr, int wc, int fr_, int fq_) const {
        int fr = fr_, fq = fq_; asm volatile("" : "+v"(fr), "+v"(fq));
        const int pn = u.pn; int kind, pitch, col0; bf16_t* base;
        if (pn < 2) { kind = 0; base = (bf16_t*)(ws + oQA); pitch = 512; col0 = 64 * (4 * pn + wc); }
        else if (pn == 2) { if (wc < 2) { kind = 1; base = (bf16_t*)(ws + oKA); pitch = 128; col0 = 64 * wc; } else { kind = 2; base = (bf16_t*)(ws + oVA); pitch = 128; col0 = 64 * (wc - 2); } }
        else if (pn < 5) { kind = 3; base = (bf16_t*)(ws + oQB); pitch = 512; col0 = 64 * (4 * (pn - 3) + wc); }
        else if (pn < 7) { kind = 4; base = (bf16_t*)(ws + oKB); pitch = 512; col0 = 64 * (4 * (pn - 5) + wc); }
        else { kind = 2; base = (bf16_t*)(ws + oVB); pitch = 512; col0 = 64 * (4 * (pn - 7) + wc); }
        const int row0 = u.pm * BM + wr * 64 + fr;
        bf16_t* outp = base + (size_t)row0 * pitch + col0 + 16 * fq;
        const float* swp = I8 ? sw + u.pn * BM + 32 * wc + 4 * fq : nullptr;
#define IP_ACC(ai, bj, m, n, sar) (I8 ? __builtin_convertvector(__builtin_bit_cast(i32x4, acc[ai][bj][m][n]), f32x4) * (*(const f32x4*)(swp + 128 * (bj) + 16 * (n)) * (sar)) : acc[ai][bj][m][n])
        const float L2T = 13.287712379549449f;
        if (kind == 2) {
#pragma unroll
            for (int ai = 0; ai < 2; ++ai)
#pragma unroll
                for (int m = 0; m < 4; ++m) { bf16_t* rp = outp + (size_t)(ai * HALF + m * 16) * pitch; const float sar = I8 ? sa[row0 + ai * HALF + m * 16] : 1.f;
#pragma unroll
                    for (int bj = 0; bj < 2; ++bj) { const f32x4 v0 = IP_ACC(ai, bj, m, 0, sar), v1 = IP_ACC(ai, bj, m, 1, sar);
                        u32x4 w; w.x = cvt_pk_bf16(v0[0], v0[1]); w.y = cvt_pk_bf16(v0[2], v0[3]); w.z = cvt_pk_bf16(v1[0], v1[1]); w.w = cvt_pk_bf16(v1[2], v1[3]);
                        *(u32x4*)(rp + 8 * bj) = w; } }
        } else if (kind <= 1) {
            const float* g = kind == 0 ? gq : gk; const float sc = kind == 0 ? qscale : 1.0f;
            float inv[4];
#pragma unroll
            for (int e = 0; e < 4; ++e) inv[e] = __builtin_amdgcn_exp2f(-(float)(4 * fq + e) * (L2T / 16.0f)) * 0.15915494309189535f;
#pragma unroll
            for (int ai = 0; ai < 2; ++ai)
#pragma unroll
                for (int m = 0; m < 4; ++m) { const int row = row0 + ai * HALF + m * 16; const int t = row & 8191; const float pr = (float)(t >> 6), pc = (float)(t & 63);
                    f32x4 v[2][2]; float ss = 0.f; const float sar = I8 ? sa[row] : 1.f;
#pragma unroll
                    for (int bj = 0; bj < 2; ++bj)
#pragma unroll
                        for (int n = 0; n < 2; ++n) { v[bj][n] = IP_ACC(ai, bj, m, n, sar); ss += (v[bj][n][0] * v[bj][n][0] + v[bj][n][1] * v[bj][n][1]) + (v[bj][n][2] * v[bj][n][2] + v[bj][n][3] * v[bj][n][3]); }
                    ss += __shfl_xor(ss, 16); ss += __shfl_xor(ss, 32);
                    const float rinv = __builtin_amdgcn_rsqf(ss * (1.0f / 64.0f) + 1e-6f) * sc;
#pragma unroll
                    for (int bj = 0; bj < 2; ++bj) { const float pos = bj == 0 ? pr : pc; const f32x4 gv0 = *(const f32x4*)(g + 32 * bj + 4 * fq), gv1 = *(const f32x4*)(g + 32 * bj + 16 + 4 * fq);
#pragma unroll
                        for (int e = 0; e < 4; ++e) { float rev = pos * inv[e]; rev = rev - __builtin_floorf(rev);
                            const float sn = __builtin_amdgcn_sinf(rev), cs = __builtin_amdgcn_cosf(rev);
                            float x1 = v[bj][0][e] * rinv * gv0[e], x2 = v[bj][1][e] * rinv * gv1[e]; asm volatile("" : "+v"(x1), "+v"(x2));
                            v[bj][0][e] = x1 * cs - x2 * sn; v[bj][1][e] = x2 * cs + x1 * sn; } }
                    bf16_t* rp = outp + (size_t)(ai * HALF + m * 16) * pitch;
#pragma unroll
                    for (int bj = 0; bj < 2; ++bj) { const f32x4 v0 = v[bj][0], v1 = v[bj][1];
                        u32x4 w; w.x = cvt_pk_bf16(v0[0], v0[1]); w.y = cvt_pk_bf16(v0[2], v0[3]); w.z = cvt_pk_bf16(v1[0], v1[1]); w.w = cvt_pk_bf16(v1[2], v1[3]);
                        *(u32x4*)(rp + 8 * bj) = w; } }
        } else {
            const float sc = kind == 3 ? qscale : 1.0f;
            float inv[2][4];
#pragma unroll
            for (int n = 0; n < 2; ++n)
#pragma unroll
                for (int e = 0; e < 4; ++e) inv[n][e] = __builtin_amdgcn_exp2f(-(float)(16 * n + 4 * fq + e) * (L2T / 32.0f)) * 0.15915494309189535f;
#pragma unroll
            for (int ai = 0; ai < 2; ++ai)
#pragma unroll
                for (int m = 0; m < 4; ++m) { const int row = row0 + ai * HALF + m * 16; const float pos = (float)(row & 8191);
                    f32x4 v[2][2]; const float sar = I8 ? sa[row] : 1.f;
#pragma unroll
                    for (int n = 0; n < 2; ++n) { const f32x4 a1_ = IP_ACC(ai, 0, m, n, sar), a2_ = IP_ACC(ai, 1, m, n, sar);
#pragma unroll
                        for (int e = 0; e < 4; ++e) { float rev = pos * inv[n][e]; rev = rev - __builtin_floorf(rev);
                            const float sn = __builtin_amdgcn_sinf(rev) * sc, cs = __builtin_amdgcn_cosf(rev) * sc;
                            float x1 = a1_[e], x2 = a2_[e]; asm volatile("" : "+v"(x1), "+v"(x2));
                            v[0][n][e] = x1 * cs - x2 * sn; v[1][n][e] = x2 * cs + x1 * sn; } }
                    bf16_t* rp = outp + (size_t)(ai * HALF + m * 16) * pitch;
#pragma unroll
                    for (int bj = 0; bj < 2; ++bj) { const f32x4 v0 = v[bj][0], v1 = v[bj][1];
                        u32x4 w; w.x = cvt_pk_bf16(v0[0], v0[1]); w.y = cvt_pk_bf16(v0[2], v0[3]); w.z = cvt_pk_bf16(v1[0], v1[1]); w.w = cvt_pk_bf16(v1[2], v1[3]);
                        *(u32x4*)(rp + 8 * bj) = w; } }
        }
    }
#undef IP_ACC
};
typedef EpiInProjT<false> EpiInProj;
typedef EpiInProjT<true> EpiInProjI8;


template <class Epi, class Sched, bool ALIGN_EPI = false, bool SP2 = false, bool F8 = false, bool I8 = false>
__device__ __forceinline__ void gemm_phase(PG8_LAS unsigned char* lds, const Gemm g, const Sched& S, const Epi& E, int wave_in) {
    int tid_; asm volatile("v_mbcnt_lo_u32_b32 %0, -1, 0\n\tv_mbcnt_hi_u32_b32 %0, -1, %0" : "=v"(tid_)); tid_ += wave_in * 64;
    const int tid = tid_, wid = __builtin_amdgcn_readfirstlane(tid >> 6), lane = tid & 63, wr = wid >> 2, wc = wid & 3, fr = lane & 15, fq = lane >> 4;
    const int K = g.K, nt = K / BK;
    unsigned voffA, voffB;
    { int R, C; stage_rc(tid * 16, R, C); const int Rb = Epi::PERM ? ((R & ~31) + perm32(R & 31)) : R; voffA = (unsigned)(R * K + C) * 2u; voffB = (unsigned)(Rb * K + C) * 2u; }
    const size_t qstep = (size_t)64 * K * 2;
    const size_t kstep = (size_t)(BK * 2);
    const size_t hstep = (size_t)HALF * K * 2;
    const size_t tstep = 2 * hstep;
    const unsigned ldsw = (unsigned)wid * 1024u;
    const int aoff = F8 ? lds_byte(wr * 64 + fr, fq * 16) : lds_byte(wr * 64 + fr, fq * 8), boff = F8 ? lds_byte(wc * 32 + fr, fq * 16) : lds_byte(wc * 32 + fr, fq * 8);
#define PG8_SA(b, h) (((b) * 2 + (h)) * HTB)
#define PG8_SB(b, h) ((4 + (b) * 2 + (h)) * HTB)
#define PG8_STAGE(bufoff, gbase, voff) do { _Pragma("unroll") for (int _i = 0; _i < 2; ++_i) \
        __builtin_amdgcn_global_load_lds((const unsigned*)((const char*)(gbase) + _i * qstep + (voff)), (PG8_LAS unsigned*)(lds + (bufoff) + ldsw + _i * 8192), 16, 0, 0); } while (0)
#define PG8_LDF(off) (*(const PG8_LAS bf16x8*)(lds + (off)))
#define PG8_LDA(dst, b, h) do { if constexpr (!F8) { _Pragma("unroll") for (int m = 0; m < 4; ++m) _Pragma("unroll") for (int k = 0; k < 2; ++k) dst[m][k] = PG8_LDF(PG8_SA(b, h) + aoff + m * 2048 + k * 1024); } \
        else { _Pragma("unroll") for (int m = 0; m < 4; ++m) dst##8[m] = *(const PG8_LAS i32x8*)(lds + PG8_SA(b, h) + aoff + m * 2048); } } while (0)
#define PG8_LDB(dst, b, h) do { if constexpr (!F8) { _Pragma("unroll") for (int n = 0; n < 2; ++n) _Pragma("unroll") for (int k = 0; k < 2; ++k) dst[n][k] = PG8_LDF(PG8_SB(b, h) + boff + n * 2048 + k * 1024); } \
        else { _Pragma("unroll") for (int n = 0; n < 2; ++n) dst##8[n] = *(const PG8_LAS i32x8*)(lds + PG8_SB(b, h) + boff + n * 2048); } } while (0)
#define PG8_MMA(ai, bj, At, Bt) do { __builtin_amdgcn_s_setprio(1); if constexpr (!F8) { _Pragma("unroll") for (int m = 0; m < 4; ++m) _Pragma("unroll") for (int n = 0; n < 2; ++n) _Pragma("unroll") for (int k = 0; k < 2; ++k) \
        { if constexpr (I8) acc[ai][bj][m][n] = __builtin_bit_cast(f32x4, __builtin_amdgcn_mfma_i32_16x16x64_i8(__builtin_bit_cast(i32x4, Bt[n][k]), __builtin_bit_cast(i32x4, At[m][k]), __builtin_bit_cast(i32x4, acc[ai][bj][m][n]), 0, 0, 0)); \
          else acc[ai][bj][m][n] = __builtin_amdgcn_mfma_f32_16x16x32_bf16(Bt[n][k], At[m][k], acc[ai][bj][m][n], 0, 0, 0); } } else { \
        _Pragma("unroll") for (int m = 0; m < 4; ++m) _Pragma("unroll") for (int n = 0; n < 2; ++n) \
        asm volatile("v_mfma_scale_f32_16x16x128_f8f6f4 %0, %1, %2, %0, %3, %3 op_sel_hi:[0,0,0]" : "+v"(acc[ai][bj][m][n]) : "v"(Bt##8[n]), "v"(At##8[m]), "v"(f8scale)); } \
        __builtin_amdgcn_s_setprio(0); } while (0)
#define PG8_CAT(x, y) __builtin_shufflevector(__builtin_bit_cast(i32x4, x), __builtin_bit_cast(i32x4, y), 0, 1, 2, 3, 4, 5, 6, 7)
#define PG8_WAIT_V(n) asm volatile("s_waitcnt vmcnt(" #n ")" ::: "memory")
#define PG8_WAIT_L(n) asm volatile("s_waitcnt lgkmcnt(" #n ")" ::: "memory")
#define PG8_BAR __builtin_amdgcn_s_barrier()
#define PG8_SCHED __builtin_amdgcn_sched_barrier(0)
    Unit cur, nxt; int ui = 0;
    if (!S.next(0, cur)) return;
    f32x4 acc[2][2][4][2];
#pragma unroll
    for (int a = 0; a < 2; ++a)
#pragma unroll
        for (int b = 0; b < 2; ++b)
#pragma unroll
            for (int m = 0; m < 4; ++m)
#pragma unroll
                for (int n = 0; n < 2; ++n) acc[a][b][m][n] = (f32x4){0.f, 0.f, 0.f, 0.f};
    const int f8scale = 0x7f7f7f7f;
    bf16x8 At[4][2], B0[2][2], B1[2][2]; i32x8 At8[4], B08[2], B18[2];
    const char* cA = (const char*)g.A + (size_t)cur.pm * tstep; const char* cB = (const char*)g.Bt + S.bofs(cur) + (size_t)cur.pn * tstep;
    S.a_ready(cur);
    if constexpr (SP2) {
        PG8_STAGE(PG8_SB(0, 0), cB, voffB); PG8_STAGE(PG8_SB(0, 1), cB + hstep, voffB); PG8_STAGE(PG8_SA(0, 0), cA, voffA); PG8_STAGE(PG8_SA(0, 1), cA + hstep, voffA);
        if (wr == 1) PG8_BAR;
        PG8_WAIT_V(2); PG8_BAR;
        PG8_STAGE(PG8_SB(1, 0), cB + kstep, voffB); PG8_STAGE(PG8_SA(1, 0), cA + kstep, voffA); PG8_STAGE(PG8_SB(1, 1), cB + hstep + kstep, voffB);
        PG8_WAIT_V(6); PG8_BAR;
    } else {
        PG8_STAGE(PG8_SB(0, 0), cB, voffB); PG8_STAGE(PG8_SA(0, 0), cA, voffA); PG8_STAGE(PG8_SB(0, 1), cB + hstep, voffB); PG8_STAGE(PG8_SA(0, 1), cA + hstep, voffA);
        if (wr == 1) PG8_BAR;
        PG8_WAIT_V(4); PG8_BAR;
        PG8_STAGE(PG8_SB(1, 0), cB + kstep, voffB); PG8_STAGE(PG8_SA(1, 0), cA + kstep, voffA); PG8_STAGE(PG8_SB(1, 1), cB + hstep + kstep, voffB);
        PG8_WAIT_V(6); PG8_BAR;
    }
    for (;;) {
        const bool has_next = S.next(ui + 1, nxt);
        const char* nA = has_next ? (const char*)g.A + (size_t)nxt.pm * tstep : cA; const char* nB = has_next ? (const char*)g.Bt + S.bofs(nxt) + (size_t)nxt.pn * tstep : cB;
#pragma nounroll
        for (int t = 0; t < nt; t += 2) {
            const bool last = (t == nt - 2);
            const char* a1 = cA + (size_t)(t + 1) * kstep;
            const char* a2 = last ? nA : cA + (size_t)(t + 2) * kstep; const char* b2 = last ? nB : cB + (size_t)(t + 2) * kstep;
            const char* a3 = a2 + kstep; const char* b3 = b2 + kstep;
            if (last && has_next) S.a_ready(nxt);
            if constexpr (SP2) {
            PG8_LDB(B0, 0, 0); PG8_LDB(B1, 0, 1); PG8_SCHED; PG8_LDA(At, 0, 0); PG8_STAGE(PG8_SA(1, 1), a1 + hstep, voffA);
            PG8_WAIT_V(8); PG8_WAIT_L(0); PG8_BAR; PG8_MMA(0, 0, At, B0); PG8_MMA(0, 1, At, B1); PG8_BAR; PG8_SCHED;
            PG8_LDA(At, 0, 1); PG8_STAGE(PG8_SB(0, 0), b2, voffB); PG8_STAGE(PG8_SB(0, 1), b2 + hstep, voffB); PG8_STAGE(PG8_SA(0, 0), a2, voffA);
            PG8_WAIT_V(8); PG8_WAIT_L(0); PG8_BAR; PG8_MMA(1, 0, At, B0); PG8_MMA(1, 1, At, B1); PG8_BAR; PG8_SCHED;
            PG8_LDB(B0, 1, 0); PG8_LDB(B1, 1, 1); PG8_SCHED; PG8_LDA(At, 1, 0); PG8_STAGE(PG8_SA(0, 1), a2 + hstep, voffA);
            PG8_WAIT_V(8); PG8_WAIT_L(0); PG8_BAR; PG8_MMA(0, 0, At, B0); PG8_MMA(0, 1, At, B1); PG8_BAR; PG8_SCHED;
            PG8_LDA(At, 1, 1); PG8_STAGE(PG8_SB(1, 0), b3, voffB); PG8_STAGE(PG8_SB(1, 1), b3 + hstep, voffB); PG8_STAGE(PG8_SA(1, 0), a3, voffA);
            PG8_WAIT_V(8); PG8_WAIT_L(0); PG8_BAR; PG8_MMA(1, 0, At, B0); PG8_MMA(1, 1, At, B1); PG8_BAR; PG8_SCHED;
            } else {
            PG8_LDB(B0, 0, 0); PG8_SCHED; PG8_LDA(At, 0, 0); PG8_STAGE(PG8_SA(1, 1), a1 + hstep, voffA);
            PG8_WAIT_L(8); PG8_BAR; PG8_WAIT_L(0); PG8_MMA(0, 0, At, B0); PG8_BAR; PG8_SCHED;
            PG8_LDB(B1, 0, 1); PG8_STAGE(PG8_SB(0, 0), b2, voffB);
            PG8_BAR; PG8_WAIT_L(0); PG8_MMA(0, 1, At, B1); PG8_BAR;
            PG8_LDA(At, 0, 1); PG8_STAGE(PG8_SA(0, 0), a2, voffA);
            PG8_BAR; PG8_WAIT_L(0); PG8_MMA(1, 0, At, B0); PG8_BAR; PG8_SCHED;
            PG8_STAGE(PG8_SB(0, 1), b2 + hstep, voffB);
            PG8_WAIT_V(6); PG8_BAR; PG8_MMA(1, 1, At, B1); PG8_BAR;
            PG8_LDB(B0, 1, 0); PG8_SCHED; PG8_LDA(At, 1, 0); PG8_STAGE(PG8_SA(0, 1), a2 + hstep, voffA);
            PG8_WAIT_L(8); PG8_BAR; PG8_WAIT_L(0); PG8_MMA(0, 0, At, B0); PG8_BAR; PG8_SCHED;
            PG8_LDB(B1, 1, 1); PG8_STAGE(PG8_SB(1, 0), b3, voffB);
            PG8_BAR; PG8_WAIT_L(0); PG8_MMA(0, 1, At, B1); PG8_BAR;
            PG8_LDA(At, 1, 1); PG8_STAGE(PG8_SA(1, 0), a3, voffA);
            PG8_BAR; PG8_WAIT_L(0); PG8_MMA(1, 0, At, B0); PG8_BAR; PG8_SCHED;
            PG8_STAGE(PG8_SB(1, 1), b3 + hstep, voffB);
            PG8_WAIT_V(6); PG8_BAR; PG8_MMA(1, 1, At, B1); PG8_BAR;
            }
        }
        if constexpr (F8) { asm volatile("s_nop 15\n\ts_nop 15\n\ts_nop 15\n\ts_nop 15" ::: "memory");
            _Pragma("unroll") for (int m = 0; m < 4; ++m) asm volatile("" :: "v"(At8[m]));
            _Pragma("unroll") for (int n = 0; n < 2; ++n) asm volatile("" :: "v"(B08[n]), "v"(B18[n])); }
        if constexpr (ALIGN_EPI) { if (wr == 0) PG8_BAR; }
        if constexpr (!Epi::AFTER_DRAIN) { E(acc, cur, wr, wc, fr, fq); S.done(cur); }
        if (!has_next) break;
#pragma unroll
        for (int a = 0; a < 2; ++a)
#pragma unroll
            for (int b = 0; b < 2; ++b)
#pragma unroll
                for (int m = 0; m < 4; ++m)
#pragma unroll
                    for (int n = 0; n < 2; ++n) acc[a][b][m][n] = (f32x4){0.f, 0.f, 0.f, 0.f};
        cur = nxt; cA = nA; cB = nB; ++ui;
        if constexpr (ALIGN_EPI) { if (wr == 1) PG8_BAR; }
    }
    PG8_WAIT_V(0);
    if constexpr (!ALIGN_EPI) { if (wr == 0) PG8_BAR; }
    PG8_BAR;
    if constexpr (Epi::AFTER_DRAIN) { E.fused(acc, cur, wr, wc, fr, fq, lds, wid, lane); S.done(cur); }
#undef PG8_SA
#undef PG8_SB
#undef PG8_STAGE
#undef PG8_LDA
#undef PG8_LDF
#undef PG8_LDB
#undef PG8_MMA
#undef PG8_CAT
#undef PG8_WAIT_V
#undef PG8_WAIT_L
#undef PG8_BAR
#undef PG8_SCHED
}
}
namespace attn_body {
using bf16=__hip_bfloat16;
using bf16x8=__attribute__((ext_vector_type(8)))short;
using s16x4=__attribute__((ext_vector_type(4)))short;
using f32x16=__attribute__((ext_vector_type(16)))float;
using u32x4=__attribute__((ext_vector_type(4)))unsigned;
constexpr int SEQ=8192,D=64;
constexpr int NW=8,QBLK=32,QB=QBLK*NW,KVBLK=64,NQB=SEQ/QB;
constexpr int ATTN_UNIT_ROWS=QB;
__device__ __forceinline__ int crow(int r,int hi){return (r&3)+8*(r>>2)+4*hi;}
#define SBAR() __builtin_amdgcn_sched_barrier(0)
__device__ __forceinline__ void cmask(f32x16&p0,f32x16&p1,int jb,int qrel,int hi){
  const float NEG=-INFINITY; int kb=64*jb+4*hi;
  #pragma unroll
  for(int r=0;r<16;++r){int kv=kb+(r&3)+8*(r>>2); if(kv>qrel)p0[r]=NEG; if(kv+32>qrel)p1[r]=NEG;}
}

constexpr int NSLOT=3, SLOTB=8192;
constexpr int LDS_K=0, LDS_V=NSLOT*SLOTB, LDS_WS=LDS_V+NSLOT*2*SLOTB, LDS_OST=LDS_WS+NW*64*4, LDS_BYTES=LDS_OST+NW*4096;
constexpr float C2=0.125f*1.4426950408889634f;
__device__ __forceinline__ void glds16(const void*gsrc,unsigned lds_dst){unsigned keep;
  asm volatile("s_mov_b32 %0, m0\n\ts_mov_b32 m0, %2\n\ts_nop 0\n\tglobal_load_lds_dwordx4 %1, off\n\ts_mov_b32 m0, %0":"=&s"(keep):"v"(gsrc),"s"(lds_dst):"memory");}
__device__ __forceinline__ float max3f(float a,float b,float c){float r;asm("v_max3_f32 %0, %1, %2, %3":"=v"(r):"v"(a),"v"(b),"v"(c));return r;}
__device__ __forceinline__ float max2f(float a,float b){float r;asm("v_max_f32_e32 %0, %1, %2":"=v"(r):"v"(a),"v"(b));return r;}
__device__ __forceinline__ float fadd_s(float a,float b){float r;asm("v_add_f32_e32 %0, %1, %2":"=v"(r):"v"(a),"v"(b));return r;}
__device__ __forceinline__ float fsub_s(float a,float b){float r;asm("v_sub_f32_e32 %0, %1, %2":"=v"(r):"v"(a),"v"(b));return r;}
typedef float f32x2_t __attribute__((ext_vector_type(2))); typedef __bf16 bf16x2_t __attribute__((ext_vector_type(2)));
__device__ __forceinline__ unsigned cvtpk_s(float lo,float hi){f32x2_t v={lo,hi};bf16x2_t b=__builtin_convertvector(v,bf16x2_t);return __builtin_bit_cast(unsigned,b);}
#define WAIT_BAR(N) asm volatile("s_waitcnt vmcnt(" #N ") lgkmcnt(0)\n\ts_barrier":::"memory")

__device__ __forceinline__ void qkt(f32x16&p0,f32x16&p1,const char*Kslot,const bf16x8*qr,const f32x16&negm,int r32,int hi){
  const char*kb=Kslot+hi*1024+r32*16;
  #pragma unroll
  for(int d0=0;d0<4;++d0){
    const bf16x8 b0=*reinterpret_cast<const bf16x8*>(kb+d0*2048);
    const bf16x8 b1=*reinterpret_cast<const bf16x8*>(kb+d0*2048+512);
    if(d0==0){p0=__builtin_amdgcn_mfma_f32_32x32x16_bf16(b0,qr[0],negm,0,0,0);p1=__builtin_amdgcn_mfma_f32_32x32x16_bf16(b1,qr[0],negm,0,0,0);}
    else{p0=__builtin_amdgcn_mfma_f32_32x32x16_bf16(b0,qr[d0],p0,0,0,0);p1=__builtin_amdgcn_mfma_f32_32x32x16_bf16(b1,qr[d0],p1,0,0,0);}}
}
typedef __attribute__((address_space(3))) const char* lds_cptr;
typedef short v4i16_t __attribute__((ext_vector_type(4)));
__device__ __forceinline__ void kload8(bf16x8*kf,lds_cptr kp){
  kf[0]=*(const __attribute__((address_space(3))) bf16x8*)(kp);      kf[1]=*(const __attribute__((address_space(3))) bf16x8*)(kp+512);
  kf[2]=*(const __attribute__((address_space(3))) bf16x8*)(kp+2048); kf[3]=*(const __attribute__((address_space(3))) bf16x8*)(kp+2560);
  kf[4]=*(const __attribute__((address_space(3))) bf16x8*)(kp+4096); kf[5]=*(const __attribute__((address_space(3))) bf16x8*)(kp+4608);
  kf[6]=*(const __attribute__((address_space(3))) bf16x8*)(kp+6144); kf[7]=*(const __attribute__((address_space(3))) bf16x8*)(kp+6656);
}
__device__ __forceinline__ void kload2(bf16x8*kf,lds_cptr kp,int j){ kf[2*j]=*(const __attribute__((address_space(3))) bf16x8*)(kp+j*2048); kf[2*j+1]=*(const __attribute__((address_space(3))) bf16x8*)(kp+j*2048+512); }
__device__ __forceinline__ s16x4 vtr(lds_cptr p){ return __builtin_bit_cast(s16x4,__builtin_amdgcn_ds_read_tr16_b64_v4i16((__attribute__((address_space(3))) v4i16_t*)p)); }
__device__ __forceinline__ float rowmax(const f32x16&p0,const f32x16&p1){
  float a=max3f(p0[0],p0[1],p1[0]),b=max3f(p0[2],p0[3],p1[1]);a=max3f(a,p1[2],p1[3]);
  #pragma unroll
  for(int r=4;r<16;r+=4){a=max3f(a,p0[r],p0[r+1]);b=max3f(b,p0[r+2],p0[r+3]);a=max3f(a,p1[r],p1[r+1]);b=max3f(b,p1[r+2],p1[r+3]);}
  const float m=max2f(a,b);
  auto rr=__builtin_amdgcn_permlane32_swap(__float_as_uint(m),__float_as_uint(m),false,false);
  return max2f(__uint_as_float(rr[0]),__uint_as_float(rr[1]));
}
template<int NOB> __device__ __forceinline__ void pv(f32x16*o,int vb,bf16x8 pa0,bf16x8 pa1,bf16x8 pa2,bf16x8 pa3){
  #pragma unroll
  for(int d0=0;d0<NOB;++d0){s16x4 lo[4],hi[4];
    #pragma unroll
    for(int ks=0;ks<4;++ks){
      asm volatile("ds_read_b64_tr_b16 %0,%1 offset:%c2":"=&v"(lo[ks]):"v"(vb),"i"(d0*4096+ks*1024):"memory");
      asm volatile("ds_read_b64_tr_b16 %0,%1 offset:%c2":"=&v"(hi[ks]):"v"(vb),"i"(d0*4096+ks*1024+512):"memory");}
    asm volatile("s_waitcnt lgkmcnt(0)":::"memory");SBAR();
    #define PK(k) (bf16x8){lo[k][0],lo[k][1],lo[k][2],lo[k][3],hi[k][0],hi[k][1],hi[k][2],hi[k][3]}
    o[d0]=__builtin_amdgcn_mfma_f32_32x32x16_bf16(pa0,PK(0),o[d0],0,0,0);
    o[d0]=__builtin_amdgcn_mfma_f32_32x32x16_bf16(pa1,PK(1),o[d0],0,0,0);
    o[d0]=__builtin_amdgcn_mfma_f32_32x32x16_bf16(pa2,PK(2),o[d0],0,0,0);
    o[d0]=__builtin_amdgcn_mfma_f32_32x32x16_bf16(pa3,PK(3),o[d0],0,0,0);
    #undef PK
  }
}

#ifndef ATTN_STORE16
#define ATTN_STORE16(p,v) (*(u32x4*)(p)=(v))
#endif
template<int THRL,int DV> __device__ __forceinline__ void attn_unit(const bf16*Qu,int QP,const bf16*__restrict__ Kh,int KP,const bf16*__restrict__ Vh,int VP,bf16*Ou,int OP,char*shm,int wave_in){
  int tid_; asm volatile("v_mbcnt_lo_u32_b32 %0, -1, 0\n\tv_mbcnt_hi_u32_b32 %0, -1, %0":"=v"(tid_)); tid_+=wave_in*64; const int tid=tid_,lane=tid&63,r32=lane&31,hi=lane>>5; const int wid=__builtin_amdgcn_readfirstlane(tid>>6);
  const bf16*Qw=Qu+(long)(wid*QBLK)*QP;
  constexpr int VS=DV/64, NOB=DV/32;
  const unsigned lds0=(unsigned)(uintptr_t)shm;
  float*wsf=(float*)(shm+LDS_WS)+wid*64;
  const bf16*ksrc=Kh+(long)lane*KP+wid*8;
  const bf16*vsrc=Vh+(long)(16*(wid&3)+(lane>>2))*VP+(wid>>2)*32+(lane&3)*8;
  const unsigned kdst=lds0+LDS_K+wid*1024, vdst=lds0+LDS_V+wid*1024;
  #define DMA_K(t,slot) glds16(ksrc+(long)(t)*KVBLK*KP,(unsigned)__builtin_amdgcn_readfirstlane(kdst+(slot)))
  #define DMA_V(t,slot) do{ glds16(vsrc+(long)(t)*KVBLK*VP,(unsigned)__builtin_amdgcn_readfirstlane(vdst+VS*(slot))); if constexpr(VS==2) glds16(vsrc+(long)(t)*KVBLK*VP+64,(unsigned)__builtin_amdgcn_readfirstlane(vdst+VS*(slot)+8192)); }while(0)
  const int vb0=(int)(lds0+LDS_V)+((lane>>4)&1)*32+(lane&3)*8+(4*hi+((lane&15)>>2))*64;
  const char*Kbase=shm+LDS_K; bf16x8 kf[8];
  const lds_cptr shm3=(lds_cptr)shm; const lds_cptr kp0=shm3+LDS_K+hi*1024+r32*16; const lds_cptr vp0=shm3+LDS_V+((lane>>4)&1)*32+(lane&3)*8+(4*hi+((lane&15)>>2))*64;
  constexpr int NT=SEQ/KVBLK;
  DMA_K(0,0);DMA_V(0,0);DMA_K(1,SLOTB);
  bf16x8 qr[4];
  #pragma unroll
  for(int d0=0;d0<4;++d0)qr[d0]=*reinterpret_cast<const bf16x8*>(&Qw[(long)r32*QP+d0*16+hi*8]);
  float mhat=0.f,l_reg=0.f;f32x16 o[NOB];
  #pragma unroll
  for(int d_=0;d_<NOB;++d_)o[d_]=f32x16{};
  f32x16 negm=f32x16{};asm volatile("":"+v"(negm));
  #define CMASK(P0,P1,t) do{}while(0)
  bool resc=false;
  #define START(P0,P1) do{ const float rm=rowmax(P0,P1); resc=false; \
    { const float dl=rm; mhat=fadd_s(mhat,dl); \
      _Pragma("unroll") for(int r=0;r<16;++r){P0[r]=fsub_s(P0[r],dl);P1[r]=fsub_s(P1[r],dl);} \
      _Pragma("unroll") for(int r=0;r<16;++r)negm[r]=-mhat; asm volatile("":"+v"(negm)); } \
    _Pragma("unroll") for(int r=0;r<16;++r)P0[r]=__builtin_amdgcn_exp2f(P0[r]); }while(0)
  #define RESC() do{ if(resc){ asm volatile("s_waitcnt lgkmcnt(0)":::"memory"); \
      _Pragma("unroll") for(int d_=0;d_<NOB;++d_) _Pragma("unroll") for(int r=0;r<16;++r)o[d_][r]*=wsf[crow(r,hi)]; } }while(0)
  f32x16 pA0,pA1,pB0,pB1;
  int sl_prev=0,sl_cur=0,sl_next=SLOTB;
  #define ROT() do{sl_prev=sl_cur;sl_cur=sl_next;sl_next=(sl_next==(NSLOT-1)*SLOTB)?0:sl_next+SLOTB;}while(0)
  #define WBV(N,N2) do{ if constexpr(VS==2){WAIT_BAR(N2);} else {WAIT_BAR(N);} }while(0)
  DMA_K(2,2*SLOTB);
  WAIT_BAR(3);
  qkt(pA0,pA1,Kbase,qr,negm,r32,hi);asm volatile("s_nop 15\n\ts_nop 7":"+v"(pA0),"+v"(pA1));CMASK(pA0,pA1,0);
  START(pA0,pA1);
  _Pragma("unroll") for(int r=0;r<16;++r)pA1[r]=__builtin_amdgcn_exp2f(pA1[r]);
  WAIT_BAR(0);
  DMA_K(3,0);DMA_V(1,SLOTB);
  ROT();
  kload8(kf,kp0+sl_cur);
  WBV(2,3);
  s16x4 vlo[8],vhi[8]; u32x4 pw0,pw1,pw2,pw3;
  #define PKW(P,B) cvtpk_s(P[B],P[B+1])
  #define PAF(k) __builtin_bit_cast(bf16x8,pw##k)
  #define VFR(i) (bf16x8){vlo[i][0],vlo[i][1],vlo[i][2],vlo[i][3],vhi[i][0],vhi[i][1],vhi[i][2],vhi[i][3]}
  #define PIN(x) asm volatile("":"+v"(x))
  #define MX3(a,b,c) __builtin_fmaxf(__builtin_fmaxf((a),(b)),(c))
  #define GAPA(MF,A0,A1,A2,A3,W0,W1,PW) do{ MF; sacc+=A0; sacc+=A1; sacc+=A2; sacc+=A3; PIN(sacc); W0; W1; PIN(PW); SBAR(); }while(0)
  #define EX(v) __builtin_amdgcn_exp2f(v)
  #define GAPB(MF,X,B) do{ MF; X[B]=EX(X[B]); X[B+1]=EX(X[B+1]); X[B+2]=EX(X[B+2]); X[B+3]=EX(X[B+3]); PIN(X); SBAR(); }while(0)
  #define GAPB2(MF,RD,X,B) do{ MF; RD; X[B]=EX(X[B]); X[B+1]=EX(X[B+1]); PIN(X); SBAR(); }while(0)
  #define VRD2(i) do{ vlo[i]=vtr(vp_+(8192+((i)>>2)*4096+((i)&3)*1024)); vhi[i]=vtr(vp_+(8192+((i)>>2)*4096+((i)&3)*1024+512)); }while(0)
  #define VRD(i) do{ vlo[i]=vtr(vp_+(((i)>>2)*4096+((i)&3)*1024)); vhi[i]=vtr(vp_+(((i)>>2)*4096+((i)&3)*1024+512)); }while(0)
  #define KRD(G,j) do{ if(G){ kload2(kf,kp0+sl_next,j); SBAR(); } }while(0)
  #define STEP(C0,C1,P0,P1,t,GK,GV,GL) do{ SBAR(); \
    const lds_cptr vp_=vp0+VS*sl_prev; \
    VRD(0); SBAR(); float sacc=(P0[0]+P0[1]); \
    GAPA(C0=__builtin_amdgcn_mfma_f32_32x32x16_bf16(kf[0],qr[0],negm,0,0,0), P0[2],P0[3],P0[4],P0[5],     pw0[0]=PKW(P0,0), pw0[1]=PKW(P0,2), pw0); \
    VRD(4); SBAR(); GAPA(C1=__builtin_amdgcn_mfma_f32_32x32x16_bf16(kf[1],qr[0],negm,0,0,0), P0[6],P0[7],P0[8],P0[9],     pw0[2]=PKW(P0,4), pw0[3]=PKW(P0,6), pw0); \
    VRD(1); SBAR(); GAPA(C0=__builtin_amdgcn_mfma_f32_32x32x16_bf16(kf[2],qr[1],C0,0,0,0),   P0[10],P0[11],P0[12],P0[13], pw1[0]=PKW(P0,8), pw1[1]=PKW(P0,10), pw1); \
    VRD(5); SBAR(); GAPA(C1=__builtin_amdgcn_mfma_f32_32x32x16_bf16(kf[3],qr[1],C1,0,0,0),   P0[14],P0[15],P1[0],P1[1],   pw1[2]=PKW(P0,12),pw1[3]=PKW(P0,14), pw1); \
    VRD(2); SBAR(); GAPA(C0=__builtin_amdgcn_mfma_f32_32x32x16_bf16(kf[4],qr[2],C0,0,0,0),   P1[2],P1[3],P1[4],P1[5],     pw2[0]=PKW(P1,0), pw2[1]=PKW(P1,2), pw2); \
    VRD(6); SBAR(); GAPA(C1=__builtin_amdgcn_mfma_f32_32x32x16_bf16(kf[5],qr[2],C1,0,0,0),   P1[6],P1[7],P1[8],P1[9],     pw2[2]=PKW(P1,4), pw2[3]=PKW(P1,6), pw2); \
    VRD(3); SBAR(); GAPA(C0=__builtin_amdgcn_mfma_f32_32x32x16_bf16(kf[6],qr[3],C0,0,0,0),   P1[10],P1[11],P1[12],P1[13], pw3[0]=PKW(P1,8), pw3[1]=PKW(P1,10), pw3); \
    VRD(7); SBAR(); GAPA(C1=__builtin_amdgcn_mfma_f32_32x32x16_bf16(kf[7],qr[3],C1,0,0,0),   P1[14],P1[15],0.f,0.f,       pw3[2]=PKW(P1,12),pw3[3]=PKW(P1,14), pw3); \
    l_reg+=sacc; \
    if(GK){DMA_K((t)+3,sl_cur);} if(GV){DMA_V((t)+1,sl_next);} \
    CMASK(C0,C1,t); \
    { float a=MX3(C0[0],C0[1],C1[0]),b=MX3(C0[2],C0[3],C1[1]); a=MX3(a,C1[2],C1[3]); \
      _Pragma("unroll") for(int r=4;r<16;r+=4){a=MX3(a,C0[r],C0[r+1]);b=MX3(b,C0[r+2],C0[r+3]);a=MX3(a,C1[r],C1[r+1]);b=MX3(b,C1[r+2],C1[r+3]);} \
      float rm=__builtin_fmaxf(a,b); { auto rr=__builtin_amdgcn_permlane32_swap(__float_as_uint(rm),__float_as_uint(rm),false,false); rm=__builtin_fmaxf(__uint_as_float(rr[0]),__uint_as_float(rr[1])); } \
      resc=false; \
      if(__builtin_expect(__any(rm>(float)THRL),0)){ const float dl=__builtin_fmaxf(rm,0.f); mhat+=dl; \
        _Pragma("unroll") for(int r=0;r<16;++r){C0[r]-=dl;C1[r]-=dl;} \
        _Pragma("unroll") for(int r=0;r<16;++r)negm[r]=-mhat; asm volatile("":"+v"(negm)); \
        const float f=__builtin_amdgcn_exp2f(-dl); l_reg*=f; if(hi==0)wsf[r32]=f; resc=true; } } \
    SBAR(); \
    if constexpr(VS==1){ \
    GAPB(o[0]=__builtin_amdgcn_mfma_f32_32x32x16_bf16(PAF(0),VFR(0),o[0],0,0,0), C0,0); \
    GAPB(o[1]=__builtin_amdgcn_mfma_f32_32x32x16_bf16(PAF(0),VFR(4),o[1],0,0,0), C0,4); \
    KRD(GL,0); GAPB(o[0]=__builtin_amdgcn_mfma_f32_32x32x16_bf16(PAF(1),VFR(1),o[0],0,0,0), C0,8); \
    KRD(GL,1); GAPB(o[1]=__builtin_amdgcn_mfma_f32_32x32x16_bf16(PAF(1),VFR(5),o[1],0,0,0), C0,12); \
    KRD(GL,2); GAPB(o[0]=__builtin_amdgcn_mfma_f32_32x32x16_bf16(PAF(2),VFR(2),o[0],0,0,0), C1,0); \
    KRD(GL,3); GAPB(o[1]=__builtin_amdgcn_mfma_f32_32x32x16_bf16(PAF(2),VFR(6),o[1],0,0,0), C1,4); \
    GAPB(o[0]=__builtin_amdgcn_mfma_f32_32x32x16_bf16(PAF(3),VFR(3),o[0],0,0,0), C1,8); \
    GAPB(o[1]=__builtin_amdgcn_mfma_f32_32x32x16_bf16(PAF(3),VFR(7),o[1],0,0,0), C1,12); \
    } else { \
    GAPB2(o[0]=__builtin_amdgcn_mfma_f32_32x32x16_bf16(PAF(0),VFR(0),o[0],0,0,0), VRD2(0), C0,0); \
    GAPB2(o[1]=__builtin_amdgcn_mfma_f32_32x32x16_bf16(PAF(0),VFR(4),o[1],0,0,0), VRD2(4), C0,2); \
    GAPB2(o[0]=__builtin_amdgcn_mfma_f32_32x32x16_bf16(PAF(1),VFR(1),o[0],0,0,0), VRD2(1), C0,4); \
    GAPB2(o[1]=__builtin_amdgcn_mfma_f32_32x32x16_bf16(PAF(1),VFR(5),o[1],0,0,0), VRD2(5), C0,6); \
    GAPB2(o[0]=__builtin_amdgcn_mfma_f32_32x32x16_bf16(PAF(2),VFR(2),o[0],0,0,0), VRD2(2), C0,8); \
    GAPB2(o[1]=__builtin_amdgcn_mfma_f32_32x32x16_bf16(PAF(2),VFR(6),o[1],0,0,0), VRD2(6), C0,10); \
    GAPB2(o[0]=__builtin_amdgcn_mfma_f32_32x32x16_bf16(PAF(3),VFR(3),o[0],0,0,0), VRD2(3), C0,12); \
    GAPB2(o[1]=__builtin_amdgcn_mfma_f32_32x32x16_bf16(PAF(3),VFR(7),o[1],0,0,0), VRD2(7), C0,14); \
    GAPB2(o[2]=__builtin_amdgcn_mfma_f32_32x32x16_bf16(PAF(0),VFR(0),o[2],0,0,0), (void)0, C1,0); \
    GAPB2(o[3]=__builtin_amdgcn_mfma_f32_32x32x16_bf16(PAF(0),VFR(4),o[3],0,0,0), (void)0, C1,2); \
    KRD(GL,0); GAPB2(o[2]=__builtin_amdgcn_mfma_f32_32x32x16_bf16(PAF(1),VFR(1),o[2],0,0,0), (void)0, C1,4); \
    KRD(GL,1); GAPB2(o[3]=__builtin_amdgcn_mfma_f32_32x32x16_bf16(PAF(1),VFR(5),o[3],0,0,0), (void)0, C1,6); \
    KRD(GL,2); GAPB2(o[2]=__builtin_amdgcn_mfma_f32_32x32x16_bf16(PAF(2),VFR(2),o[2],0,0,0), (void)0, C1,8); \
    KRD(GL,3); GAPB2(o[3]=__builtin_amdgcn_mfma_f32_32x32x16_bf16(PAF(2),VFR(6),o[3],0,0,0), (void)0, C1,10); \
    GAPB2(o[2]=__builtin_amdgcn_mfma_f32_32x32x16_bf16(PAF(3),VFR(3),o[2],0,0,0), (void)0, C1,12); \
    GAPB2(o[3]=__builtin_amdgcn_mfma_f32_32x32x16_bf16(PAF(3),VFR(7),o[3],0,0,0), (void)0, C1,14); \
    } \
    }while(0)
  int t=1;
  for(;t+5<NT;t+=2){
    STEP(pB0,pB1,pA0,pA1,t,true,true,true);     WBV(2,3); RESC(); ROT();
    STEP(pA0,pA1,pB0,pB1,t+1,true,true,true);   WBV(2,3); RESC(); ROT();
  }
  #define ENDW(tt) do{ if((tt)+3<NT){WBV(2,3);} else if((tt)+2<NT){WBV(1,2);} else {WAIT_BAR(0);} }while(0)
  for(;t+1<NT;t+=2){
    STEP(pB0,pB1,pA0,pA1,t,(t+3<NT),(t+1<NT),(t+1<NT));       ENDW(t);   RESC(); ROT();
    STEP(pA0,pA1,pB0,pB1,t+1,(t+4<NT),(t+2<NT),(t+2<NT));     ENDW(t+1); RESC(); ROT();
  }
  STEP(pB0,pB1,pA0,pA1,NT-1,false,false,false); RESC();
  { float sacc=pB0[0]+pB0[1]; _Pragma("unroll") for(int r=2;r<16;++r)sacc+=pB0[r]; _Pragma("unroll") for(int r=0;r<16;++r)sacc+=pB1[r]; l_reg+=sacc;
    pw0=(u32x4){PKW(pB0,0),PKW(pB0,2),PKW(pB0,4),PKW(pB0,6)};pw1=(u32x4){PKW(pB0,8),PKW(pB0,10),PKW(pB0,12),PKW(pB0,14)};pw2=(u32x4){PKW(pB1,0),PKW(pB1,2),PKW(pB1,4),PKW(pB1,6)};pw3=(u32x4){PKW(pB1,8),PKW(pB1,10),PKW(pB1,12),PKW(pB1,14)};
    SBAR(); pv<NOB>(o,vb0+VS*sl_cur,PAF(0),PAF(1),PAF(2),PAF(3)); }
  #undef PKW
  #undef PAF
  #undef VFR
  #undef PIN
  #undef MX3
  #undef GAPA
  #undef GAPB
  #undef GAPB2
  #undef VRD2
  #undef WBV
  #undef EX
  #undef VRD
  #undef KRD
  #undef STEP
  #undef ENDW
  {auto rr=__builtin_amdgcn_permlane32_swap(__float_as_uint(l_reg),__float_as_uint(l_reg),false,false);l_reg=__uint_as_float(rr[0])+__uint_as_float(rr[1]);}
  if(hi==0)wsf[32+r32]=l_reg;asm volatile("s_waitcnt lgkmcnt(0)":::"memory");
  float rli[16];
  #pragma unroll
  for(int r=0;r<16;++r)rli[r]=__builtin_amdgcn_rcpf(wsf[32+crow(r,hi)]);
  bf16*Ow=Ou+(long)(wid*QBLK)*OP;
  { bf16*stg=(bf16*)(shm+LDS_OST)+wid*2048;
    #pragma unroll
    for(int ps=0;ps<VS;++ps){
    #pragma unroll
    for(int r=0;r<16;++r){const int orow=crow(r,hi);
      #pragma unroll
      for(int d0=0;d0<2;++d0)stg[orow*64+d0*32+r32]=__float2bfloat16(o[2*ps+d0][r]*rli[r]);}
    asm volatile("s_waitcnt lgkmcnt(0)":::"memory");
    #pragma unroll
    for(int i=0;i<4;++i){const int row=i*8+(lane>>3),ch=lane&7; const u32x4 v=*(const u32x4*)(stg+row*64+ch*8); ATTN_STORE16(Ow+(long)row*OP+ps*64+ch*8,v);}
    asm volatile("s_waitcnt lgkmcnt(0)":::"memory"); } }
  asm volatile("s_waitcnt lgkmcnt(0)\n\ts_barrier":::"memory");
  #undef DMA_K
  #undef DMA_V
  #undef CMASK
  #undef START
  #undef RESC
  #undef ROT
}
constexpr float V8SCALE=8.f, P8BIAS=2.f;
template<int DV> __device__ __forceinline__ void attn_unit8(const bf16*Qu,int QP,const bf16*__restrict__ Kh,int KP,const unsigned char*__restrict__ Vt,bf16*Ou,int OP,char*shm,int wave_in){
  int tid_; asm volatile("v_mbcnt_lo_u32_b32 %0, -1, 0\n\tv_mbcnt_hi_u32_b32 %0, -1, %0":"=v"(tid_)); tid_+=wave_in*64; const int tid=tid_,lane=tid&63,r32=lane&31,hi=lane>>5; const int wid=__builtin_amdgcn_readfirstlane(tid>>6);
  const bf16*Qw=Qu+(long)(wid*QBLK)*QP;
  constexpr int VS=DV/64, NOB=DV/32;
  const unsigned lds0=(unsigned)(uintptr_t)shm;
  constexpr int NKS=4, L8_K=0, L8_V=NKS*SLOTB, L8_WS=L8_V+4*8192, L8_OST=L8_WS+NW*64*4;
  static_assert(L8_OST+NW*4096<=131072,"attn_unit8 LDS");
  float*wsf=(float*)(shm+L8_WS)+wid*64;
  const bf16*ksrc=Kh+(long)lane*KP+wid*8;
  const int vgrp=(DV==128)?(wid>>2):0;
  const unsigned char*vsrc=Vt+(64*vgrp+lane)*64+(wid&3)*16;
  const unsigned kdst=lds0+L8_K+wid*1024, vdst=lds0+L8_V+(wid&3)*(DV*16)+vgrp*1024;
  #define DMA_K(t,slot) glds16(ksrc+(long)(t)*KVBLK*KP,(unsigned)__builtin_amdgcn_readfirstlane(kdst+(slot)))
  #define VSL(t) ((((t))&3)*8192)
  #define DMA_V(t) glds16(vsrc+(long)(t)*(DV*64),(unsigned)__builtin_amdgcn_readfirstlane(vdst+VSL(t)))
  const char*Kbase=shm+L8_K; bf16x8 kf[8];
  const lds_cptr shm3=(lds_cptr)shm; const lds_cptr kp0=shm3+L8_K+hi*1024+r32*16; const lds_cptr vp0=shm3+L8_V+(2*hi)*(DV*16)+r32*16;
  constexpr int NT=SEQ/KVBLK;
  DMA_K(0,0);DMA_V(0);DMA_K(1,SLOTB);
  bf16x8 qr[4];
  #pragma unroll
  for(int d0=0;d0<4;++d0)qr[d0]=*reinterpret_cast<const bf16x8*>(&Qw[(long)r32*QP+d0*16+hi*8]);
  float mhat=0.f,l_reg=0.f;f32x16 o[NOB];
  #pragma unroll
  for(int d_=0;d_<NOB;++d_)o[d_]=f32x16{};
  f32x16 negm=f32x16{};asm volatile("":"+v"(negm));
  typedef int i32x8_t __attribute__((ext_vector_type(8))); i32x8_t v8[NOB]; i32x8_t p8={0,0,0,0,0,0,0,0}; const int one8=0x7f7f7f7f; f32x16 osum=f32x16{}; i32x8_t ones8={0x38383838,0x38383838,0x38383838,0x38383838,0x38383838,0x38383838,0x38383838,0x38383838}; asm volatile("":"+v"(ones8));
  typedef int i32x4_t __attribute__((ext_vector_type(4)));
  #define PK8(g,P,B) do{ int w_=p8[g]; w_=__builtin_amdgcn_cvt_pk_fp8_f32(P[B],P[(B)+1],w_,false); w_=__builtin_amdgcn_cvt_pk_fp8_f32(P[(B)+2],P[(B)+3],w_,true); p8[g]=w_; }while(0)
  #define PS8() asm volatile("v_mfma_scale_f32_32x32x64_f8f6f4 %0, %1, %2, %0, %3, %3 op_sel_hi:[0,0,0]":"+v"(osum):"v"(p8),"v"(ones8),"v"(one8))
  #define PV8(db) asm volatile("v_mfma_scale_f32_32x32x64_f8f6f4 %0, %1, %2, %0, %3, %3 op_sel_hi:[0,0,0]":"+v"(o[db]):"v"(p8),"v"(v8[db]),"v"(one8))
  #define VRD8(db) do{ const i32x4_t lo_=*(const __attribute__((address_space(3))) i32x4_t*)(vp_+(db)*512), hi_=*(const __attribute__((address_space(3))) i32x4_t*)(vp_+(db)*512+DV*16); v8[db]=__builtin_shufflevector(lo_,hi_,0,1,2,3,4,5,6,7); }while(0)
  #define MX3(a,b,c) __builtin_fmaxf(__builtin_fmaxf((a),(b)),(c))
  #define MF(A,B,C) __builtin_amdgcn_mfma_f32_32x32x16_bf16(A,B,C,0,0,0)
  #define WAIT_Y() asm volatile("s_waitcnt lgkmcnt(0)\n\ts_barrier":::"memory")
  DMA_K(2,2*SLOTB);DMA_K(3,3*SLOTB);
  WAIT_BAR(4);
  f32x16 C0,C1;
  qkt(C0,C1,Kbase,qr,negm,r32,hi);asm volatile("s_nop 15\n\ts_nop 7":"+v"(C0),"+v"(C1));
  { const float rm=rowmax(C0,C1); const float dl=rm-P8BIAS; mhat=fadd_s(mhat,dl);
    _Pragma("unroll") for(int r=0;r<16;++r){C0[r]=fsub_s(C0[r],dl);C1[r]=fsub_s(C1[r],dl);}
    _Pragma("unroll") for(int r=0;r<16;++r)negm[r]=-mhat; asm volatile("":"+v"(negm));
    _Pragma("unroll") for(int r=0;r<16;++r){C0[r]=__builtin_amdgcn_exp2f(C0[r]);C1[r]=__builtin_amdgcn_exp2f(C1[r]);}
    if constexpr(false){ float sacc=C0[0]+C0[1]; _Pragma("unroll") for(int r=2;r<16;++r)sacc+=C0[r]; _Pragma("unroll") for(int r=0;r<16;++r)sacc+=C1[r]; l_reg=sacc; }
    PK8(0,C0,0);PK8(1,C0,4);PK8(2,C0,8);PK8(3,C0,12);PK8(4,C1,0);PK8(5,C1,4);PK8(6,C1,8);PK8(7,C1,12); }
  WAIT_BAR(0);
  DMA_V(1);DMA_K(4,0);DMA_V(2);
  int sl_cur=SLOTB,sl_next=2*SLOTB;
  kload8(kf,kp0+sl_cur);
  WAIT_BAR(3);
  if(wid>=4) asm volatile("s_barrier":::"memory");
  #define AMX3(d,x,y,z) asm("v_max3_f32 %0, %1, %2, %3":"=v"(d):"v"(x),"v"(y),"v"(z))
  #define BODY(GK,GV,GW) do{ \
    SBAR(); \
    __builtin_amdgcn_s_setprio(1); \
    { const lds_cptr vp_=vp0+VSL(t-1); \
      _Pragma("unroll") for(int db=0;db<NOB;++db)VRD8(db); } \
    SBAR(); \
    C0=MF(kf[0],qr[0],negm); asm volatile("":"+v"(C0)); C1=MF(kf[1],qr[0],negm); asm volatile("":"+v"(C1)); SBAR(); kload2(kf,kp0+sl_next,0); SBAR(); \
    C0=MF(kf[2],qr[1],C0); asm volatile("":"+v"(C0)); C1=MF(kf[3],qr[1],C1); asm volatile("":"+v"(C1)); SBAR(); kload2(kf,kp0+sl_next,1); SBAR(); \
    C0=MF(kf[4],qr[2],C0); asm volatile("":"+v"(C0)); C1=MF(kf[5],qr[2],C1); asm volatile("":"+v"(C1)); SBAR(); kload2(kf,kp0+sl_next,2); SBAR(); \
    C0=MF(kf[6],qr[3],C0); asm volatile("":"+v"(C0)); C1=MF(kf[7],qr[3],C1); asm volatile("":"+v"(C1)); SBAR(); kload2(kf,kp0+sl_next,3); SBAR(); \
    if constexpr(NOB==2){ PS8(); SBAR(); if(GK){DMA_K(t+4,sl_cur);} SBAR(); PV8(0); SBAR(); if(GV){DMA_V(t+2);} SBAR(); PV8(1); } \
    else { PS8(); PV8(0); SBAR(); if(GK){DMA_K(t+4,sl_cur);} SBAR(); PV8(1); SBAR(); if(GV){DMA_V(t+2);} SBAR(); PV8(2); PV8(3); } \
    __builtin_amdgcn_s_setprio(0); \
    SBAR(); \
    if(GW){WAIT_BAR(4);} else {WAIT_BAR(0);} \
    SBAR(); \
    _Pragma("unroll") for(int db=0;db<NOB;++db) asm volatile(""::"v"(v8[db]),"v"(p8)); \
    asm volatile("":"+v"(C0),"+v"(C1)); \
    { float a,b; \
      asm("v_max3_f32 %0, %2, %3, %4\n\tv_max3_f32 %1, %5, %6, %7\n\tv_max3_f32 %0, %0, %8, %9":"=&v"(a),"=&v"(b):"v"(C0[0]),"v"(C0[1]),"v"(C1[0]),"v"(C0[2]),"v"(C0[3]),"v"(C1[1]),"v"(C1[2]),"v"(C1[3])); \
      asm("v_max3_f32 %0, %0, %2, %3\n\tv_max3_f32 %1, %1, %4, %5\n\tv_max3_f32 %0, %0, %6, %7\n\tv_max3_f32 %1, %1, %8, %9":"+v"(a),"+v"(b):"v"(C0[4]),"v"(C0[5]),"v"(C0[6]),"v"(C0[7]),"v"(C1[4]),"v"(C1[5]),"v"(C1[6]),"v"(C1[7])); \
      asm("v_max3_f32 %0, %0, %2, %3\n\tv_max3_f32 %1, %1, %4, %5\n\tv_max3_f32 %0, %0, %6, %7\n\tv_max3_f32 %1, %1, %8, %9":"+v"(a),"+v"(b):"v"(C0[8]),"v"(C0[9]),"v"(C0[10]),"v"(C0[11]),"v"(C1[8]),"v"(C1[9]),"v"(C1[10]),"v"(C1[11])); \
      float rm; \
      asm("v_max3_f32 %0, %0, %3, %4\n\tv_max3_f32 %1, %1, %5, %6\n\tv_max3_f32 %0, %0, %7, %8\n\tv_max3_f32 %1, %1, %9, %10\n\tv_max_f32 %2, %0, %1":"+v"(a),"+v"(b),"=&v"(rm):"v"(C0[12]),"v"(C0[13]),"v"(C0[14]),"v"(C0[15]),"v"(C1[12]),"v"(C1[13]),"v"(C1[14]),"v"(C1[15])); \
      if(__builtin_expect(__any(rm>8.0f),0)){ { auto rr=__builtin_amdgcn_permlane32_swap(__float_as_uint(rm),__float_as_uint(rm),false,false); rm=__builtin_fmaxf(__uint_as_float(rr[0]),__uint_as_float(rr[1])); } \
        const float dl=__builtin_fmaxf(rm-P8BIAS,0.f); mhat+=dl; \
        _Pragma("unroll") for(int r=0;r<16;++r){C0[r]-=dl;C1[r]-=dl;} \
        _Pragma("unroll") for(int r=0;r<16;++r)negm[r]=-mhat; asm volatile("":"+v"(negm)); \
        const float f=__builtin_amdgcn_exp2f(-dl); l_reg*=f; if(hi==0)wsf[r32]=f; \
        asm volatile("s_nop 15\n\ts_nop 15\n\ts_nop 15\n\ts_nop 15\n\ts_nop 15\n\ts_nop 15\n\ts_waitcnt lgkmcnt(0)":::"memory"); \
        _Pragma("unroll") for(int d_=0;d_<NOB;++d_) _Pragma("unroll") for(int r=0;r<16;++r)o[d_][r]*=wsf[crow(r,hi)]; \
        if constexpr(true){ _Pragma("unroll") for(int r=0;r<16;++r)osum[r]*=wsf[crow(r,hi)]; } } } \
    _Pragma("unroll") for(int r=0;r<16;++r){C0[r]=__builtin_amdgcn_exp2f(C0[r]);C1[r]=__builtin_amdgcn_exp2f(C1[r]);} \
    if constexpr(false){ float sacc=C0[0]+C0[1]; _Pragma("unroll") for(int r=2;r<16;++r)sacc+=C0[r]; _Pragma("unroll") for(int r=0;r<16;++r)sacc+=C1[r]; l_reg+=sacc; } \
    PK8(0,C0,0);PK8(1,C0,4);PK8(2,C0,8);PK8(3,C0,12);PK8(4,C1,0);PK8(5,C1,4);PK8(6,C1,8);PK8(7,C1,12); \
    asm volatile("":"+v"(p8)); asm volatile("":"+v"(l_reg)); \
    SBAR(); \
    WAIT_Y(); \
    SBAR(); \
    sl_cur=sl_next; sl_next=(sl_next==(NKS-1)*SLOTB)?0:sl_next+SLOTB; \
  }while(0)
  int t=1;
  #pragma nounroll
  for(;t+4<NT;++t) BODY(true,true,true);
  #pragma nounroll
  for(;t<NT;++t) BODY((t+4<NT),(t+2<NT),(t+4<NT));
  #undef BODY
  #undef AMX3
  if(wid<4) asm volatile("s_barrier":::"memory");
  { SBAR(); { const lds_cptr vp_=vp0+VSL(NT-1);
      #pragma unroll
      for(int db=0;db<NOB;++db)VRD8(db);
      PS8();
      #pragma unroll
      for(int db=0;db<NOB;++db)PV8(db);
      asm volatile("s_nop 15\n\ts_nop 15\n\ts_nop 15\n\ts_nop 15\n\ts_nop 15\n\ts_nop 15\n\ts_nop 15\n\ts_nop 15\n\ts_nop 15\n\ts_nop 15":::"memory");
      #pragma unroll
      for(int db=0;db<NOB;++db) asm volatile("":"+v"(o[db]):"v"(v8[db]),"v"(p8));
      asm volatile("":"+v"(osum):"v"(ones8),"v"(p8)); } }
  #undef PK8
  #undef PV8
  #undef PS8
  #undef VRD8
  #undef MX3
  #undef MF
  #undef WAIT_Y
  float rli[16];
  if constexpr(true){
    #pragma unroll
    for(int r=0;r<16;++r)rli[r]=__builtin_amdgcn_rcpf(osum[r])*(1.0f/V8SCALE);
  } else {
    {auto rr=__builtin_amdgcn_permlane32_swap(__float_as_uint(l_reg),__float_as_uint(l_reg),false,false);l_reg=__uint_as_float(rr[0])+__uint_as_float(rr[1]);}
    if(hi==0)wsf[32+r32]=l_reg;asm volatile("s_waitcnt lgkmcnt(0)":::"memory");
    #pragma unroll
    for(int r=0;r<16;++r)rli[r]=__builtin_amdgcn_rcpf(wsf[32+crow(r,hi)])*(1.0f/V8SCALE);
  }
  bf16*Ow=Ou+(long)(wid*QBLK)*OP;
  { bf16*stg=(bf16*)(shm+L8_OST)+wid*2048;
    #pragma unroll
    for(int ps=0;ps<VS;++ps){
    #pragma unroll
    for(int r=0;r<16;++r){const int orow=crow(r,hi);
      #pragma unroll
      for(int d0=0;d0<2;++d0)stg[orow*64+d0*32+r32]=__float2bfloat16(o[2*ps+d0][r]*rli[r]);}
    asm volatile("s_waitcnt lgkmcnt(0)":::"memory");
    #pragma unroll
    for(int i=0;i<4;++i){const int row=i*8+(lane>>3),ch=lane&7; const u32x4 v=*(const u32x4*)(stg+row*64+ch*8); ATTN_STORE16(Ow+(long)row*OP+ps*64+ch*8,v);}
    asm volatile("s_waitcnt lgkmcnt(0)":::"memory"); } }
  asm volatile("s_waitcnt lgkmcnt(0)\n\ts_barrier":::"memory");
  #undef DMA_K
  #undef DMA_V
  #undef VSL
}

constexpr int ATTN_LDS_BYTES=LDS_BYTES;
#undef SBAR
#undef WAIT_BAR
}
constexpr int NWAVES = 8;
constexpr int NTOK = 65536, SEQL = 8192, DM = 1024, INW = 2304, DFF = 3584, NEXP = 8, NLAYER = 2;
constexpr float EPS = 1e-6f;
constexpr size_t MiB = 1u << 20;
constexpr size_t WS_CTL = 0, CTL_ZERO_BYTES = 128 * 1024;
constexpr size_t WS_WIN = 1 * MiB;
constexpr size_t WS_WOUT = 10 * MiB;
constexpr size_t WS_WGU_D = 14 * MiB;
constexpr size_t WS_WDN_D = 28 * MiB;
constexpr size_t WS_WGU_M = 35 * MiB;
constexpr size_t WS_WDN_M = 91 * MiB;
constexpr size_t WS_HN = 203 * MiB;
constexpr size_t WS_QA = 331 * MiB, WS_QB = 395 * MiB, WS_KA = 459 * MiB, WS_VA = 475 * MiB, WS_KB = 491 * MiB, WS_VB = 555 * MiB;
constexpr size_t WS_OA = 619 * MiB, WS_OB = 683 * MiB;
constexpr size_t WS_AO = 331 * MiB;
constexpr size_t WS_MIX = 491 * MiB;
constexpr size_t WS_XS = 331 * MiB;
constexpr size_t WS_YS = 463 * MiB;
constexpr size_t WS_ACT8 = 727 * MiB;
constexpr float A8SCALE = 16.f, W8SCALE = 256.f, H8SCALE = 8.f;
constexpr size_t WS_ACT = 595 * MiB;
constexpr size_t WS_F = 819 * MiB;
constexpr size_t WS_VT8 = WS_F;
constexpr size_t WS_TOK = 947 * MiB;
constexpr size_t WS_WGB = 948 * MiB;
constexpr size_t WS_END = 949 * MiB;
#ifndef PROJ_I8
#define PROJ_I8 1
#endif
#define PROJ_I8_IN ((PROJ_I8 & 1) != 0)
#define PROJ_I8_OUT ((PROJ_I8 & 2) != 0)
#ifndef DENSE_I8
#define DENSE_I8 1
#endif
#ifndef DENSE_F8
#define DENSE_F8 0
#endif
constexpr int CHUNK_TILES = 128;
constexpr int CW_TMO = 0, CW_CODE = 1, CW_BAR = 4096, CW_CNT = 8192, CW_CMAX = 9000;
constexpr int CW_CMAX_IN = 16384, CW_CMAX_OUT = 21000;
constexpr size_t WS_SWIN = WS_WIN + 5 * MiB, WS_SWOUT = WS_WOUT + 3 * MiB;
constexpr size_t WS_SA2 = WS_AO + 64 * MiB;
constexpr size_t WS_SWGU = WS_WGU_D + 8 * MiB;
constexpr size_t WS_SA = WS_HN + 64 * MiB;
constexpr int RING_OFF = 0, RING_BYTES = 131072;
constexpr int LDSCTL_OFF = RING_BYTES, MISC_OFF = LDSCTL_OFF + 320;
constexpr int LDS_BYTES = 147456;
#define GAS __attribute__((address_space(1)))
#define LAS __attribute__((address_space(3)))
typedef unsigned short bf16;
typedef unsigned v4u __attribute__((ext_vector_type(4)));
typedef float f32x4 __attribute__((ext_vector_type(4)));
typedef short bf16x8 __attribute__((ext_vector_type(8)));
typedef GAS unsigned gu32;
typedef GAS unsigned long long gu64;
#define RLX_AGENT __ATOMIC_RELAXED, __HIP_MEMORY_SCOPE_AGENT
#define LDS_WAIT() asm volatile("s_waitcnt lgkmcnt(0)" ::: "memory")
#define VM_WAIT() asm volatile("s_waitcnt vmcnt(0)" ::: "memory")
__device__ __forceinline__ unsigned long long rt() { return __builtin_amdgcn_s_memrealtime(); }
__device__ __forceinline__ unsigned f2bf(float f) { unsigned u = __builtin_bit_cast(unsigned, f); return (u + 0x7fffu + ((u >> 16) & 1u)) >> 16; }
__device__ __forceinline__ unsigned pk2(float lo, float hi) { return f2bf(lo) | (f2bf(hi) << 16); }

#define XB_TMO      128
#define XB_XCNT(j)  (256  + 64 * (j))
#define XB_XSUB(j)  (1280 + 64 * (j))
#define XB_XGEN(j)  (2304 + 64 * (j))
#define XB_TOP      3328
#define XB_TOPGEN   3392
#define XCD_BAR_WORDS 3456
#define XB_SPIN_CAP (1u << 18)

__device__ __forceinline__ unsigned xb_ld(unsigned* p)              { return __hip_atomic_load(p, __ATOMIC_RELAXED, __HIP_MEMORY_SCOPE_AGENT); }
__device__ __forceinline__ unsigned xb_add(unsigned* p, unsigned v) { return __hip_atomic_fetch_add(p, v, __ATOMIC_RELAXED, __HIP_MEMORY_SCOPE_AGENT); }
__device__ __forceinline__ unsigned xb_xcc_id() { return (unsigned)__builtin_amdgcn_s_getreg((3 << 11) | 20) & 0xFu; }
#define XB_SPIN(cond, bar) do { unsigned _sp = 0; while (cond) { __builtin_amdgcn_s_sleep(1); \
    if ((++_sp & 255u) == 0u) { if (xb_ld(&(bar)[XB_TMO])) break; if (_sp > XB_SPIN_CAP) { atomicAdd(&(bar)[XB_TMO], 1u); break; } } } } while (0)

struct XcdBarrier {
    unsigned* bar; unsigned x;
    volatile LAS unsigned* st;
};

__device__ __forceinline__ XcdBarrier xcd_barrier_post(unsigned* bar, volatile LAS unsigned* st) {
    XcdBarrier b; b.bar = bar; b.x = xb_xcc_id(); b.st = st;
    if (threadIdx.x == 0) (void)xb_add(&bar[XB_XCNT(b.x)], 1u);
    return b;
}
__device__ __forceinline__ void xcd_barrier_complete(unsigned* bar, unsigned x, unsigned& nloc, unsigned& nx) {
    const unsigned G = gridDim.x * gridDim.y * gridDim.z;
    unsigned sum, cnt, mine, sp = 0u;
    for (;;) {
        sum = 0u; cnt = 0u; mine = 0u;
#pragma unroll
        for (unsigned j = 0; j < 16; ++j) { const unsigned c = xb_ld(&bar[XB_XCNT(j)]); sum += c; cnt += (c > 0u) ? 1u : 0u; mine = (j == x) ? c : mine; }
        if (sum == G) break;
        __builtin_amdgcn_s_sleep(1);
        if ((++sp & 255u) == 0u) { if (xb_ld(&bar[XB_TMO])) break; if (sp > XB_SPIN_CAP) { atomicAdd(&bar[XB_TMO], 1u); break; } }
    }
    nloc = mine > 0u ? mine : 1u; nx = cnt > 0u ? cnt : 1u;
}

__device__ __forceinline__ void xcd_barrier(const XcdBarrier& b) {
    asm volatile("s_waitcnt vmcnt(0)" ::: "memory");
    __syncthreads();
    if (threadIdx.x == 0) {
        unsigned* bar = b.bar;
        __builtin_amdgcn_s_waitcnt(0);
        unsigned nloc = b.st[0], nx = b.st[1];
        if (nloc == 0u) { xcd_barrier_complete(bar, b.x, nloc, nx); b.st[0] = nloc; b.st[1] = nx; }
        const unsigned old = xb_add(&bar[XB_XSUB(b.x)], 1u);
        const unsigned gen = old / nloc;
        if (old + 1u == (gen + 1u) * nloc) {
            __builtin_amdgcn_fence(__ATOMIC_RELEASE, "agent");
            asm volatile("s_waitcnt vmcnt(0)" ::: "memory");
            const unsigned og = xb_add(&bar[XB_TOP], 1u);
            const unsigned tg = og / nx;
            if (og + 1u == (tg + 1u) * nx) xb_add(&bar[XB_TOPGEN], 1u);
            else XB_SPIN(xb_ld(&bar[XB_TOPGEN]) == tg, bar);
            __builtin_amdgcn_fence(__ATOMIC_ACQUIRE, "agent");
            xb_add(&bar[XB_XGEN(b.x)], 1u);
            asm volatile("s_waitcnt vmcnt(0)" ::: "memory");
        } else {
            XB_SPIN(xb_ld(&bar[XB_XGEN(b.x)]) == gen, bar);
            __builtin_amdgcn_fence(__ATOMIC_ACQUIRE, "agent");
            asm volatile("s_waitcnt vmcnt(0)" ::: "memory");
        }
    }
    __syncthreads();
}
typedef unsigned u32x2 __attribute__((ext_vector_type(2)));
__device__ __forceinline__ float wave_sum(float v) {
#pragma unroll
    for (int o = 1; o < 64; o <<= 1) v += __shfl_xor(v, o);
    return v;
}
__device__ __forceinline__ unsigned cvtpk(float lo, float hi) { return pg8::cvt_pk_bf16(lo, hi); }
__device__ __forceinline__ f32x4 unpack4(u32x2 w) { return (f32x4){__uint_as_float(w.x << 16), __uint_as_float(w.x & 0xffff0000u), __uint_as_float(w.y << 16), __uint_as_float(w.y & 0xffff0000u)}; }
__device__ __forceinline__ u32x2 pack4(f32x4 v) { u32x2 r; r.x = cvtpk(v[0], v[1]); r.y = cvtpk(v[2], v[3]); return r; }
__device__ __forceinline__ float sumsq4(f32x4 v) { return (v[0] * v[0] + v[1] * v[1]) + (v[2] * v[2] + v[3] * v[3]); }
__device__ __forceinline__ void ld_row_f32(const float* row, int lane, f32x4 (&v)[4]) {
#pragma unroll
    for (int j = 0; j < 4; ++j) v[j] = *(const GAS f32x4*)(row + 4 * lane + 256 * j);
}
__device__ __forceinline__ void st_row_f32(float* row, int lane, const f32x4 (&v)[4]) {
#pragma unroll
    for (int j = 0; j < 4; ++j) *(GAS f32x4*)(row + 4 * lane + 256 * j) = v[j];
}
__device__ __forceinline__ void ld_row_bf16(const bf16* row, int lane, f32x4 (&v)[4]) {
#pragma unroll
    for (int j = 0; j < 4; ++j) v[j] = unpack4(*(const GAS u32x2*)(row + 4 * lane + 256 * j));
}
__device__ __forceinline__ void st_row_bf16(bf16* row, int lane, const f32x4 (&v)[4]) {
#pragma unroll
    for (int j = 0; j < 4; ++j) *(GAS u32x2*)(row + 4 * lane + 256 * j) = pack4(v[j]);
}
__device__ __forceinline__ float rms_scale(const f32x4 (&v)[4]) {
    const float s = wave_sum((sumsq4(v[0]) + sumsq4(v[1])) + (sumsq4(v[2]) + sumsq4(v[3])));
    return 1.0f / sqrtf(s * (1.0f / DM) + EPS);
}

__device__ __forceinline__ int tau_in(int c) {
    int tile, wc, d, isv;
    if (c < 512) { const int hq = c >> 6; tile = hq >> 2; wc = hq & 3; isv = 0; }
    else if (c < 640) { tile = 2; wc = (c - 512) >> 6; isv = 0; }
    else if (c < 768) { tile = 2; wc = 2 + ((c - 640) >> 6); isv = 1; }
    else if (c < 1280) { const int j = (c - 768) >> 6; tile = 3 + (j >> 2); wc = j & 3; isv = 0; }
    else if (c < 1792) { const int j = (c - 1280) >> 6; tile = 5 + (j >> 2); wc = j & 3; isv = 0; }
    else { const int j = (c - 1792) >> 6; tile = 7 + (j >> 2); wc = j & 3; isv = 1; }
    d = c & 63;
    const int slot = isv ? (128 * ((d >> 3) & 1) + 32 * wc + 16 * ((d >> 2) & 1) + 4 * (d >> 4) + (d & 3)) : (128 * (d >> 5) + 32 * wc + (d & 31));
    return 256 * tile + slot;
}
__device__ __forceinline__ void conv_item(const float* W, int K, int N, bf16* WT, int mode, LAS float* scr, int item, int lane) {
    const int nblk = N / 32, kb = item / nblk, nb = item % nblk, k0 = 64 * kb, n0 = 32 * nb;
#pragma unroll 8
    for (int i = 0; i < 32; ++i) { const int kk = 2 * i + (lane >> 5); scr[kk * 33 + (lane & 31)] = W[(size_t)(k0 + kk) * N + n0 + (lane & 31)]; }
    LDS_WAIT(); asm volatile("" ::: "memory");
    const int c = lane & 7;
#pragma unroll
    for (int j = 0; j < 4; ++j) { const int n = (lane >> 3) + 8 * j; const LAS float* s = scr + (8 * c) * 33 + n; const int sn = n0 + n;
        const int dr = mode == 0 ? sn : mode == 1 ? tau_in(sn) : (256 * (sn >> 7) + (sn & 127) + (mode == 3 ? 128 : 0));
        v4u o; o.x = cvtpk(s[0 * 33], s[1 * 33]); o.y = cvtpk(s[2 * 33], s[3 * 33]); o.z = cvtpk(s[4 * 33], s[5 * 33]); o.w = cvtpk(s[6 * 33], s[7 * 33]);
        *(GAS v4u*)(WT + (size_t)dr * K + k0 + 8 * c) = o; }
    LDS_WAIT(); asm volatile("" ::: "memory");
}
__device__ __forceinline__ void conv_item8(const float* W, int K, int N, unsigned char* WT, int mode, float scale, LAS float* scr, int item, int lane) {
    const int nblk = N / 32, kb = item / nblk, nb = item % nblk, k0 = 64 * kb, n0 = 32 * nb;
#pragma unroll 8
    for (int i = 0; i < 32; ++i) { const int kk = 2 * i + (lane >> 5); scr[kk * 33 + (lane & 31)] = W[(size_t)(k0 + kk) * N + n0 + (lane & 31)]; }
    LDS_WAIT(); asm volatile("" ::: "memory");
    const int c = lane & 7;
#pragma unroll
    for (int j = 0; j < 4; ++j) { const int n = (lane >> 3) + 8 * j; const LAS float* s = scr + (8 * c) * 33 + n; const int sn = n0 + n;
        const int dr = mode == 0 ? sn : (256 * (sn >> 7) + (sn & 127) + (mode == 3 ? 128 : 0));
        u32x2 o; o.x = pg8::cvt4_fp8(s[0 * 33] * scale, s[1 * 33] * scale, s[2 * 33] * scale, s[3 * 33] * scale); o.y = pg8::cvt4_fp8(s[4 * 33] * scale, s[5 * 33] * scale, s[6 * 33] * scale, s[7 * 33] * scale);
        *(GAS u32x2*)(WT + (size_t)dr * K + k0 + 8 * c) = o; }
    LDS_WAIT(); asm volatile("" ::: "memory");
}
struct ConvDesc { const float* W; unsigned char* dst; int K, N, mode, f8; };
__device__ __forceinline__ void conv_load(const ConvDesc& d, int sub, int lane, f32x4 (&v)[8]) {
    const int nblk = d.N / 32, kb = sub / nblk, nb = sub % nblk, k0 = 64 * kb, n0 = 32 * nb;
#pragma unroll
    for (int u = 0; u < 8; ++u) v[u] = *(const GAS f32x4*)(d.W + (size_t)(k0 + 8 * u + (lane >> 3)) * d.N + n0 + 4 * (lane & 7));
}
__device__ __forceinline__ void conv_store(const ConvDesc& d, int sub, int lane, const f32x4 (&v)[8], LAS float* scr) {
    const int nblk = d.N / 32, kb = sub / nblk, nb = sub % nblk, k0 = 64 * kb, n0 = 32 * nb;
#pragma unroll
    for (int u = 0; u < 8; ++u)
#pragma unroll
        for (int e = 0; e < 4; ++e) scr[(8 * u + (lane >> 3)) * 33 + 4 * (lane & 7) + e] = v[u][e];
    LDS_WAIT(); asm volatile("" ::: "memory");
    const int c = lane & 7;
#pragma unroll
    for (int j = 0; j < 4; ++j) { const int n = (lane >> 3) + 8 * j; const LAS float* s = scr + (8 * c) * 33 + n; const int sn = n0 + n;
        const int dr = d.mode == 0 ? sn : d.mode == 1 ? tau_in(sn) : (256 * (sn >> 7) + (sn & 127) + (d.mode == 3 ? 128 : 0));
        if (d.f8) { u32x2 o; o.x = pg8::cvt4_fp8(s[0 * 33] * W8SCALE, s[1 * 33] * W8SCALE, s[2 * 33] * W8SCALE, s[3 * 33] * W8SCALE); o.y = pg8::cvt4_fp8(s[4 * 33] * W8SCALE, s[5 * 33] * W8SCALE, s[6 * 33] * W8SCALE, s[7 * 33] * W8SCALE);
            *(GAS u32x2*)(d.dst + (size_t)dr * d.K + k0 + 8 * c) = o; }
        else { v4u o; o.x = cvtpk(s[0 * 33], s[1 * 33]); o.y = cvtpk(s[2 * 33], s[3 * 33]); o.z = cvtpk(s[4 * 33], s[5 * 33]); o.w = cvtpk(s[6 * 33], s[7 * 33]);
            *(GAS v4u*)((bf16*)d.dst + (size_t)dr * d.K + k0 + 8 * c) = o; } }
    LDS_WAIT(); asm volatile("" ::: "memory");
}
__device__ __forceinline__ void conv_colmax(const ConvDesc& d, int sub, int lane, const f32x4 (&v)[8], gu32* cmax) {
    const int nblk = d.N / 32, nb = sub % nblk, n0 = 32 * nb;
    f32x4 m = (f32x4){0.f, 0.f, 0.f, 0.f};
#pragma unroll
    for (int u = 0; u < 8; ++u)
#pragma unroll
        for (int e = 0; e < 4; ++e) m[e] = fmaxf(m[e], fabsf(v[u][e]));
#pragma unroll
    for (int e = 0; e < 4; ++e) { m[e] = fmaxf(m[e], __shfl_xor(m[e], 8)); m[e] = fmaxf(m[e], __shfl_xor(m[e], 16)); m[e] = fmaxf(m[e], __shfl_xor(m[e], 32)); }
    if (lane < 8) {
#pragma unroll
        for (int e = 0; e < 4; ++e) __hip_atomic_fetch_max(cmax + n0 + 4 * lane + e, __float_as_uint(m[e]), __ATOMIC_RELAXED, __HIP_MEMORY_SCOPE_AGENT); }
}
__device__ __forceinline__ unsigned pack4_i8(float a, float b, float c, float d) {
    const int ia = (int)__builtin_amdgcn_fmed3f(__builtin_rintf(a), -127.f, 127.f), ib = (int)__builtin_amdgcn_fmed3f(__builtin_rintf(b), -127.f, 127.f), ic = (int)__builtin_amdgcn_fmed3f(__builtin_rintf(c), -127.f, 127.f), id = (int)__builtin_amdgcn_fmed3f(__builtin_rintf(d), -127.f, 127.f);
    return (unsigned)(ia & 255) | ((unsigned)(ib & 255) << 8) | ((unsigned)(ic & 255) << 16) | ((unsigned)id << 24);
}
__device__ __forceinline__ void conv_store_i8(const ConvDesc& d, int sub, int lane, const f32x4 (&v)[8], LAS float* scr, gu32* cmax, float* swout) {
    const int nblk = d.N / 32, kb = sub / nblk, nb = sub % nblk, k0 = 64 * kb, n0 = 32 * nb;
#pragma unroll
    for (int u = 0; u < 8; ++u)
#pragma unroll
        for (int e = 0; e < 4; ++e) scr[(8 * u + (lane >> 3)) * 33 + 4 * (lane & 7) + e] = v[u][e];
    LDS_WAIT(); asm volatile("" ::: "memory");
    const int c = lane & 7;
#pragma unroll
    for (int j = 0; j < 4; ++j) { const int n = (lane >> 3) + 8 * j; const LAS float* s = scr + (8 * c) * 33 + n; const int sn = n0 + n;
        const int dr = d.mode == 0 ? sn : d.mode == 1 ? tau_in(sn) : (256 * (sn >> 7) + (sn & 127) + (d.mode == 3 ? 128 : 0));
        const float cm = __uint_as_float(__hip_atomic_load(cmax + sn, RLX_AGENT)); const float q = cm > 0.f ? 127.0f / cm : 0.f;
        u32x2 o; o.x = pack4_i8(s[0 * 33] * q, s[1 * 33] * q, s[2 * 33] * q, s[3 * 33] * q); o.y = pack4_i8(s[4 * 33] * q, s[5 * 33] * q, s[6 * 33] * q, s[7 * 33] * q);
        *(GAS u32x2*)(d.dst + (size_t)dr * d.K + k0 + 8 * c) = o;
        if (k0 == 0 && c == 0) swout[dr] = cm * (1.0f / 127.0f); }
    LDS_WAIT(); asm volatile("" ::: "memory");
}
__device__ __forceinline__ void st_row_i8(unsigned char* rowp, float* sap, int lane, const f32x4 (&v)[4]) {
    float am = 0.f;
#pragma unroll
    for (int j = 0; j < 4; ++j) am = fmaxf(fmaxf(fmaxf(am, fabsf(v[j][0])), fmaxf(fabsf(v[j][1]), fabsf(v[j][2]))), fabsf(v[j][3]));
#pragma unroll
    for (int o = 1; o < 64; o <<= 1) am = fmaxf(am, __shfl_xor(am, o));
    const float q = am > 0.f ? 127.0f / am : 0.f;
#pragma unroll
    for (int j = 0; j < 4; ++j) *(GAS unsigned*)(rowp + 4 * lane + 256 * j) = pack4_i8(v[j][0] * q, v[j][1] * q, v[j][2] * q, v[j][3] * q);
    if (lane == 0) *sap = am * (1.0f / 127.0f);
}
struct Args { const float* in[19]; float* out; unsigned char* ws; int ph_lo, ph_hi; };
typedef const __attribute__((address_space(4))) Args* KArgs;
__device__ __forceinline__ KArgs kargs() { KArgs p = (KArgs)__builtin_amdgcn_kernarg_segment_ptr(); asm volatile("" : "+s"(p)); return p; }
__device__ __forceinline__ void phase_prologue(KArgs A, LAS unsigned char* L, int gw, int NGW, int wave, int lane) {
    unsigned char* ws = A->ws;
    LAS float* scr = (LAS float*)(L + RING_OFF + wave * 16384);
    constexpr int I_IN = (DM / 64) * (INW / 32), I_OUT = (DM / 64) * (DM / 32), I_FF = (DM / 64) * (DFF / 32);
    static_assert((DFF / 64) * (DM / 32) == I_FF, "item counts");
    constexpr int NITEMS = 2 * I_IN + 2 * I_OUT + 27 * I_FF;
    auto desc = [&](int it, ConvDesc& d, int& sub) {
        int r = it;
        if (r < 2 * I_IN) { const int l = r / I_IN; d = ConvDesc{A->in[1] + (size_t)l * DM * INW, ws + WS_WIN + (size_t)l * INW * DM * 2, DM, INW, 1, PROJ_I8_IN ? 3 : 0}; sub = r % I_IN; return; } r -= 2 * I_IN;
        if (r < 2 * I_OUT) { const int l = r / I_OUT; d = ConvDesc{A->in[2] + (size_t)l * DM * DM, ws + WS_WOUT + (size_t)l * DM * DM * 2, DM, DM, 0, PROJ_I8_OUT ? 3 : 0}; sub = r % I_OUT; return; } r -= 2 * I_OUT;
        const int mtx = r / I_FF; sub = r % I_FF;
        if (mtx == 0) d = ConvDesc{A->in[12], ws + WS_WGU_D, DM, DFF, 2, DENSE_I8 ? 3 : DENSE_F8};
        else if (mtx == 1) d = ConvDesc{A->in[13], ws + WS_WGU_D, DM, DFF, 3, DENSE_I8 ? 3 : DENSE_F8};
        else if (mtx == 2) d = ConvDesc{A->in[14], ws + WS_WDN_D, DFF, DM, 0, DENSE_F8};
        else if (mtx < 11) { const int e = mtx - 3; d = ConvDesc{A->in[16] + (size_t)e * DM * DFF, ws + WS_WGU_M + (size_t)e * 2 * DFF * DM, DM, DFF, 2, 1}; }
        else if (mtx < 19) { const int e = mtx - 11; d = ConvDesc{A->in[17] + (size_t)e * DM * DFF, ws + WS_WGU_M + (size_t)e * 2 * DFF * DM, DM, DFF, 3, 1}; }
        else { const int e = mtx - 19; d = ConvDesc{A->in[18] + (size_t)e * DFF * DM, ws + WS_WDN_M + (size_t)e * DM * DFF, DFF, DM, 0, 1}; }
    };
    {
        ConvDesc dA{}, dB{}; int sA = 0, sB = 0; f32x4 vA[8], vB[8];
        int it = gw;
        if (it < NITEMS) { desc(it, dA, sA); if (dA.f8 != 3) conv_load(dA, sA, lane, vA); }
        for (; it < NITEMS; it += 2 * NGW) {
            const bool hasB = it + NGW < NITEMS;
            if (hasB) { desc(it + NGW, dB, sB); if (dB.f8 != 3) conv_load(dB, sB, lane, vB); }
            if (dA.f8 != 3) conv_store(dA, sA, lane, vA, scr);
            if (it + 2 * NGW < NITEMS) { desc(it + 2 * NGW, dA, sA); if (dA.f8 != 3) conv_load(dA, sA, lane, vA); }
            if (hasB && dB.f8 != 3) conv_store(dB, sB, lane, vB, scr);
        }
    }
    if (PROJ_I8) {
        for (int it = gw; it < 2 * I_IN + 2 * I_OUT; it += NGW) { f32x4 v[8];
            if (it < 2 * I_IN) { if (!PROJ_I8_IN) continue; const int l = it / I_IN, sub = it % I_IN; ConvDesc d{A->in[1] + (size_t)l * DM * INW, nullptr, DM, INW, 1, 0}; conv_load(d, sub, lane, v); conv_colmax(d, sub, lane, v, (gu32*)(ws + WS_CTL) + CW_CMAX_IN + l * INW); }
            else { if (!PROJ_I8_OUT) continue; const int r = it - 2 * I_IN, l = r / I_OUT, sub = r % I_OUT; ConvDesc d{A->in[2] + (size_t)l * DM * DM, nullptr, DM, DM, 0, 0}; conv_load(d, sub, lane, v); conv_colmax(d, sub, lane, v, (gu32*)(ws + WS_CTL) + CW_CMAX_OUT + l * DM); } }
    }
    if (DENSE_I8) {
        for (int it = gw; it < 2 * I_FF; it += NGW) { const int mtx = it / I_FF, sub = it % I_FF; ConvDesc d{A->in[12 + mtx], nullptr, DM, DFF, 2 + mtx, 0}; f32x4 v[8];
            conv_load(d, sub, lane, v); conv_colmax(d, sub, lane, v, (gu32*)(ws + WS_CTL) + CW_CMAX + mtx * DFF); }
    }
    const float* x = A->in[0]; const float* g = A->in[3]; bf16* HN = (bf16*)(ws + WS_HN);
    f32x4 gv[4];
#pragma unroll
    for (int j = 0; j < 4; ++j) gv[j] = *(const GAS f32x4*)(g + 4 * lane + 256 * j);
#define P0_ROW(V, m_) do { const float r_ = rms_scale(V); _Pragma("unroll") for (int j = 0; j < 4; ++j) V[j] = V[j] * r_ * gv[j]; \
        if (PROJ_I8_IN) st_row_i8((unsigned char*)HN + (size_t)(m_) * DM, (float*)(ws + WS_SA) + (m_), lane, V); else st_row_bf16(HN + (size_t)(m_) * DM, lane, V); } while (0)
    { f32x4 vA[4], vB[4]; int m = gw;
      if (m < NTOK) ld_row_f32(x + (size_t)m * DM, lane, vA);
      for (; m < NTOK; m += 2 * NGW) { const bool hasB = m + NGW < NTOK;
          if (hasB) ld_row_f32(x + (size_t)(m + NGW) * DM, lane, vB);
          P0_ROW(vA, m);
          if (m + 2 * NGW < NTOK) ld_row_f32(x + (size_t)(m + 2 * NGW) * DM, lane, vA);
          if (hasB) P0_ROW(vB, m + NGW); } }
#undef P0_ROW
}
__device__ __forceinline__ void unpack8(v4u w, float (&f)[8]) {
    f[0] = __uint_as_float(w.x << 16); f[1] = __uint_as_float(w.x & 0xffff0000u); f[2] = __uint_as_float(w.y << 16); f[3] = __uint_as_float(w.y & 0xffff0000u);
    f[4] = __uint_as_float(w.z << 16); f[5] = __uint_as_float(w.z & 0xffff0000u); f[6] = __uint_as_float(w.w << 16); f[7] = __uint_as_float(w.w & 0xffff0000u);
}
__device__ __forceinline__ v4u pack8(const float (&f)[8]) { v4u w; w.x = cvtpk(f[0], f[1]); w.y = cvtpk(f[2], f[3]); w.z = cvtpk(f[4], f[5]); w.w = cvtpk(f[6], f[7]); return w; }
__device__ __forceinline__ void phase_t2(const bf16* OA, const bf16* OB, bf16* AO, const float* g_out_a, const float* g_subln, const float* lp, float lam_init, int gw, int NGW, int lane) {
    const float sa = wave_sum(lp[lane] * lp[64 + lane]), sb = wave_sum(lp[128 + lane] * lp[192 + lane]);
    const float lam = expf(sa) - expf(sb) + lam_init;
    float ga[8], gb[8];
#pragma unroll
    for (int i = 0; i < 8; ++i) { ga[i] = g_out_a[8 * lane + i]; gb[i] = g_subln[(8 * lane + i) & 127] * (1.0f - lam_init); }
    for (int row = gw; row < NTOK; row += NGW) {
        const v4u wa = *(const GAS v4u*)(OA + (size_t)row * 512 + 8 * lane), w0 = *(const GAS v4u*)(OB + (size_t)row * 1024 + 8 * lane), w1 = *(const GAS v4u*)(OB + (size_t)row * 1024 + 512 + 8 * lane);
        float a[8], b0[8], b1[8]; unpack8(wa, a); unpack8(w0, b0); unpack8(w1, b1);
        float ssa = 0.f, ssb = 0.f;
#pragma unroll
        for (int i = 0; i < 8; ++i) { ssa += a[i] * a[i]; b0[i] = b0[i] - lam * b1[i]; ssb += b0[i] * b0[i]; }
        ssa = wave_sum(ssa);
        ssb += __shfl_xor(ssb, 1); ssb += __shfl_xor(ssb, 2); ssb += __shfl_xor(ssb, 4); ssb += __shfl_xor(ssb, 8);
        const float ra = 1.0f / sqrtf(ssa * (1.0f / 512.0f) + EPS), rb = 1.0f / sqrtf(ssb * (1.0f / 128.0f) + EPS);
#pragma unroll
        for (int i = 0; i < 8; ++i) { a[i] = a[i] * ra * ga[i]; b0[i] = b0[i] * rb * gb[i]; }
        if (PROJ_I8_OUT) { float am = 0.f;
#pragma unroll
            for (int i = 0; i < 8; ++i) am = fmaxf(am, fmaxf(fabsf(a[i]), fabsf(b0[i])));
#pragma unroll
            for (int o = 1; o < 64; o <<= 1) am = fmaxf(am, __shfl_xor(am, o));
            const float q = am > 0.f ? 127.0f / am : 0.f; unsigned char* rp = (unsigned char*)AO + (size_t)row * 1024;
            u32x2 wa_, wb_; wa_.x = pack4_i8(a[0] * q, a[1] * q, a[2] * q, a[3] * q); wa_.y = pack4_i8(a[4] * q, a[5] * q, a[6] * q, a[7] * q); wb_.x = pack4_i8(b0[0] * q, b0[1] * q, b0[2] * q, b0[3] * q); wb_.y = pack4_i8(b0[4] * q, b0[5] * q, b0[6] * q, b0[7] * q);
            *(GAS u32x2*)(rp + 8 * lane) = wa_; *(GAS u32x2*)(rp + 512 + 8 * lane) = wb_;
            if (lane == 0) ((float*)((unsigned char*)AO + (WS_SA2 - WS_AO)))[row] = am * (1.0f / 127.0f);
        } else { *(GAS v4u*)(AO + (size_t)row * 1024 + 8 * lane) = pack8(a); *(GAS v4u*)(AO + (size_t)row * 1024 + 512 + 8 * lane) = pack8(b0); }
    }
}
template <bool ROUTE, bool F8OUT = ROUTE, bool I8OUT = false>
__device__ __forceinline__ void phase_t3(const float* hsrc, float* hdst, const bf16* MIX, bf16* HN, const float* gpost, const float* gpre, const float* wrt, v4u* TOK, unsigned* WGB, gu32* cnt,
                                         LAS unsigned* lcnt, LAS f32x4* wrl, int vcu, int G, int wave, int lane, int tid) {
    f32x4 gp[4], gf[4];
#pragma unroll
    for (int j = 0; j < 4; ++j) { gp[j] = *(const GAS f32x4*)(gpost + 4 * lane + 256 * j); gf[j] = *(const GAS f32x4*)(gpre + 4 * lane + 256 * j); }
    if (ROUTE) { for (int i = tid; i < 2048; i += NWAVES * 64) { const int row = i >> 1, hf = i & 1; wrl[(((row >> 8) * 4 + (row & 3)) * 2 + hf) * 64 + ((row & 255) >> 2)] = *(const GAS f32x4*)(wrt + 4 * i); } __syncthreads(); }
#define T3_LOAD(HV, MV, r) do { ld_row_f32(hsrc + (size_t)(r) * DM, lane, HV); ld_row_bf16(MIX + (size_t)(r) * DM, lane, MV); } while (0)
#define T3_ROW(HV, MV, row) do { \
        const float r_ = rms_scale(MV); \
        _Pragma("unroll") for (int j = 0; j < 4; ++j) HV[j] = HV[j] + MV[j] * r_ * gp[j]; \
        st_row_f32(hdst + (size_t)(row) * DM, lane, HV); \
        const float r2_ = rms_scale(HV); \
        _Pragma("unroll") for (int j = 0; j < 4; ++j) MV[j] = HV[j] * r2_ * gf[j]; \
        if (F8OUT) { \
            _Pragma("unroll") for (int j = 0; j < 4; ++j) *(GAS unsigned*)((unsigned char*)HN + (size_t)(row) * DM + 4 * lane + 256 * j) = pg8::cvt4_fp8(MV[j][0] * A8SCALE, MV[j][1] * A8SCALE, MV[j][2] * A8SCALE, MV[j][3] * A8SCALE); \
        } else if (I8OUT) {                                    \
            float am_ = 0.f; \
            _Pragma("unroll") for (int j = 0; j < 4; ++j) am_ = fmaxf(fmaxf(fmaxf(am_, fabsf(MV[j][0])), fmaxf(fabsf(MV[j][1]), fabsf(MV[j][2]))), fabsf(MV[j][3])); \
            _Pragma("unroll") for (int o_ = 1; o_ < 64; o_ <<= 1) am_ = fmaxf(am_, __shfl_xor(am_, o_)); \
            const float q_ = am_ > 0.f ? 127.0f / am_ : 0.f; \
            _Pragma("unroll") for (int j = 0; j < 4; ++j) *(GAS unsigned*)((unsigned char*)HN + (size_t)(row) * DM + 4 * lane + 256 * j) = pack4_i8(MV[j][0] * q_, MV[j][1] * q_, MV[j][2] * q_, MV[j][3] * q_); \
            if (lane == 0) ((float*)((unsigned char*)HN + (WS_SA - WS_HN)))[row] = am_ * (1.0f / 127.0f); \
        } else st_row_bf16(HN + (size_t)(row) * DM, lane, MV); \
        if (ROUTE) { \
            float lg[8]; \
            _Pragma("unroll") for (int e = 0; e < 8; ++e) lg[e] = 0.f; \
            _Pragma("unroll") for (int j = 0; j < 4; ++j) \
            _Pragma("unroll") for (int k = 0; k < 4; ++k) { const float xv = MV[j][k]; const f32x4 w0_ = wrl[((j * 4 + k) * 2) * 64 + lane], w1_ = wrl[((j * 4 + k) * 2 + 1) * 64 + lane]; \
                _Pragma("unroll") for (int e = 0; e < 4; ++e) { lg[e] += xv * w0_[e]; lg[4 + e] += xv * w1_[e]; } } \
            _Pragma("unroll") for (int e = 0; e < 8; ++e) lg[e] = wave_sum(lg[e]); \
            int e0 = 0; float l0 = lg[0]; \
            _Pragma("unroll") for (int e = 1; e < 8; ++e) if (lg[e] > l0) { l0 = lg[e]; e0 = e; } \
            int e1 = -1; float l1 = -INFINITY; \
            _Pragma("unroll") for (int e = 0; e < 8; ++e) if (e != e0 && lg[e] > l1) { l1 = lg[e]; e1 = e; } \
            if (e1 < 0) e1 = (e0 + 1) & 7; \
            const float w0 = 1.0f / (1.0f + expf(l1 - l0)); \
            if (lane == 0) { const unsigned r0 = __hip_atomic_fetch_add(lcnt + e0, 1u, __ATOMIC_RELAXED, __HIP_MEMORY_SCOPE_WORKGROUP), r1 = __hip_atomic_fetch_add(lcnt + e1, 1u, __ATOMIC_RELAXED, __HIP_MEMORY_SCOPE_WORKGROUP); \
                v4u tk; tk.x = (unsigned)e0 | ((unsigned)e1 << 8); tk.y = r0; tk.z = r1; tk.w = __float_as_uint(w0); *(GAS v4u*)(TOK + (row)) = tk; } \
        } \
    } while (0)
    for (int blk = vcu; blk < NTOK / 256; blk += G) {
        if (ROUTE) { if (tid < 8) lcnt[tid] = 0u; __syncthreads(); }
        const int rowb = blk * 256 + wave;
        f32x4 hA[4], mA[4], hB[4], mB[4];
        T3_LOAD(hA, mA, rowb);
        for (int i = 0; i < 32; i += 2) {
            T3_LOAD(hB, mB, rowb + 8 * (i + 1));
            T3_ROW(hA, mA, rowb + 8 * i);
            if (i + 2 < 32) T3_LOAD(hA, mA, rowb + 8 * (i + 2));
            T3_ROW(hB, mB, rowb + 8 * (i + 1));
        }
        if (ROUTE) { __syncthreads(); if (tid < 8) { const unsigned c = lcnt[tid]; const unsigned base = __hip_atomic_fetch_add(cnt + tid, c, __ATOMIC_RELAXED, __HIP_MEMORY_SCOPE_AGENT); WGB[blk * 8 + tid] = base; } __syncthreads(); }
    }
#undef T3_LOAD
#undef T3_ROW
}
__device__ __forceinline__ void load_layout(gu32* cnt, int (&cn)[8], int (&ps)[8], int (&pe)[8]) {
    int acc = 0;
#pragma unroll
    for (int e = 0; e < 8; ++e) { const int c = __builtin_amdgcn_readfirstlane((int)__hip_atomic_load(cnt + e, RLX_AGENT)); cn[e] = c; ps[e] = acc; acc += (c + 511) & ~511; pe[e] = acc; }
}
__device__ __forceinline__ void phase_gather(const unsigned char* HN, unsigned char* XS, const v4u* TOK, const unsigned* WGB, gu32* cnt, LAS int* psl, int gw, int NGW, int lane, int tid) {
    int cn[8], ps[8], pe[8]; load_layout(cnt, cn, ps, pe);
    if (tid == 0) {
#pragma unroll
        for (int e = 0; e < 8; ++e) psl[e] = ps[e]; }
    __syncthreads();
    for (int row0 = gw; row0 < NTOK; row0 += 4 * NGW) {
        v4u tk[4], v0[4]; size_t d0[4], d1[4];
#pragma unroll
        for (int u = 0; u < 4; ++u) { const int row = row0 + u * NGW; tk[u] = *(const GAS v4u*)(TOK + row); v0[u] = *(const GAS v4u*)(HN + (size_t)row * DM + 16 * lane); }
#pragma unroll
        for (int u = 0; u < 4; ++u) { const int row = row0 + u * NGW; const int e0 = tk[u].x & 255, e1 = (tk[u].x >> 8) & 255;
            d0[u] = (size_t)(psl[e0] + (int)WGB[(row >> 8) * 8 + e0] + (int)tk[u].y); d1[u] = (size_t)(psl[e1] + (int)WGB[(row >> 8) * 8 + e1] + (int)tk[u].z); }
#pragma unroll
        for (int u = 0; u < 4; ++u) { *(GAS v4u*)(XS + d0[u] * DM + 16 * lane) = v0[u]; *(GAS v4u*)(XS + d1[u] * DM + 16 * lane) = v0[u]; }
    }
    const v4u z = (v4u){0u, 0u, 0u, 0u};
#pragma unroll
    for (int e = 0; e < 8; ++e)
        for (int r = ps[e] + cn[e] + gw; r < pe[e]; r += NGW) *(GAS v4u*)(XS + (size_t)r * DM + 16 * lane) = z;
}
template <bool MOE, bool NEXT>
__device__ __forceinline__ void phase_t4(float* h, const bf16* F, const v4u* TOK, const unsigned* WGB, gu32* cnt, LAS int* psl, const float* gpost, const float* gnext, bf16* HN, int gw, int NGW, int lane, int tid) {
    if (MOE) { int cn[8], ps[8], pe[8]; load_layout(cnt, cn, ps, pe);
        if (tid == 0) {
#pragma unroll
            for (int e = 0; e < 8; ++e) psl[e] = ps[e]; }
        __syncthreads(); }
    f32x4 gp[4], gn[4];
#pragma unroll
    for (int j = 0; j < 4; ++j) { gp[j] = *(const GAS f32x4*)(gpost + 4 * lane + 256 * j); gn[j] = NEXT ? *(const GAS f32x4*)(gnext + 4 * lane + 256 * j) : (f32x4){0.f, 0.f, 0.f, 0.f}; }
#define T4_META(TK, r) do { if (MOE) TK = *(const GAS v4u*)(TOK + (r)); } while (0)
#define T4_LOAD(FV, F1, HV, TK, r) do { \
        if (MOE) { const int e0_ = TK.x & 255, e1_ = (TK.x >> 8) & 255; \
            const size_t d0_ = (size_t)(psl[e0_] + (int)WGB[((r) >> 8) * 8 + e0_] + (int)TK.y), d1_ = (size_t)(psl[e1_] + (int)WGB[((r) >> 8) * 8 + e1_] + (int)TK.z); \
            ld_row_bf16(F + d0_ * DM, lane, FV); ld_row_bf16(F + d1_ * DM, lane, F1); } \
        else ld_row_bf16(F + (size_t)(r) * DM, lane, FV); \
        ld_row_f32(h + (size_t)(r) * DM, lane, HV); } while (0)
#define T4_ROW(FV, F1, HV, W0, row) do { \
        if (MOE) { const float w0_ = W0, w1_ = 1.0f - w0_; _Pragma("unroll") for (int j = 0; j < 4; ++j) FV[j] = FV[j] * w0_ + F1[j] * w1_; } \
        const float r_ = rms_scale(FV); \
        _Pragma("unroll") for (int j = 0; j < 4; ++j) HV[j] = HV[j] + FV[j] * r_ * gp[j]; \
        st_row_f32(h + (size_t)(row) * DM, lane, HV); \
        if (NEXT) { const float r2_ = rms_scale(HV); \
            _Pragma("unroll") for (int j = 0; j < 4; ++j) FV[j] = HV[j] * r2_ * gn[j]; \
            if (PROJ_I8_IN) st_row_i8((unsigned char*)HN + (size_t)(row) * DM, (float*)((unsigned char*)HN + (WS_SA - WS_HN)) + (row), lane, FV); else st_row_bf16(HN + (size_t)(row) * DM, lane, FV); } \
    } while (0)
    const int nrow = (NTOK - gw + NGW - 1) / NGW;
    f32x4 fA[4], gA[4], hA[4], fB[4], gB[4], hB[4]; v4u tA = (v4u){0u, 0u, 0u, 0u}, tB = tA, tN = tA; float wA = 0.f, wB = 0.f;
    if (nrow > 0) { T4_META(tA, gw); T4_LOAD(fA, gA, hA, tA, gw); wA = __uint_as_float(tA.w); if (nrow > 1) T4_META(tN, gw + NGW); }
    for (int i = 0; i < nrow; i += 2) {
        if (i + 1 < nrow) { tB = tN; T4_LOAD(fB, gB, hB, tB, gw + (i + 1) * NGW); wB = __uint_as_float(tB.w); if (i + 2 < nrow) T4_META(tN, gw + (i + 2) * NGW); }
        T4_ROW(fA, gA, hA, wA, gw + i * NGW);
        if (i + 1 < nrow) {
            if (i + 2 < nrow) { tA = tN; T4_LOAD(fA, gA, hA, tA, gw + (i + 2) * NGW); wA = __uint_as_float(tA.w); if (i + 3 < nrow) T4_META(tN, gw + (i + 3) * NGW); }
            T4_ROW(fB, gB, hB, wB, gw + (i + 1) * NGW);
        }
    }
#undef T4_META
#undef T4_LOAD
#undef T4_ROW
}
__device__ __forceinline__ void phase_vt(const bf16* VA, const bf16* VB, unsigned char* VT, LAS unsigned char* scr, int gw, int NGW, int lane) {
    const int k5 = lane & 31; const int slot = 32 * ((k5 >> 2) & 1) + (k5 & 3) + 4 * (k5 >> 3) + 16 * (lane >> 5);
    for (int tl = gw; tl < 6144; tl += NGW) {
        const bool isB = tl >= 2048; const int ti = isB ? tl - 2048 : tl, t = ti & 127, bh = ti >> 7, DVt = isB ? 128 : 64;
        const bf16* src = isB ? VB + ((size_t)(bh >> 2) * SEQL + 64 * t + lane) * 512 + 128 * (bh & 3) : VA + ((size_t)(bh >> 1) * SEQL + 64 * t + lane) * 128 + 64 * (bh & 1);
        unsigned char* dst = VT + (isB ? ((size_t)8 * MiB + (size_t)ti * 8192) : (size_t)ti * 4096);
        for (int c = 0; c < DVt / 8; ++c) { const v4u w = *(const GAS v4u*)(src + 8 * c); float f[8]; unpack8(w, f);
            const unsigned lo = pg8::cvt4_fp8(f[0] * attn_body::V8SCALE, f[1] * attn_body::V8SCALE, f[2] * attn_body::V8SCALE, f[3] * attn_body::V8SCALE), hi = pg8::cvt4_fp8(f[4] * attn_body::V8SCALE, f[5] * attn_body::V8SCALE, f[6] * attn_body::V8SCALE, f[7] * attn_body::V8SCALE);
#pragma unroll
            for (int i = 0; i < 4; ++i) { scr[(8 * c + i) * 64 + slot] = (unsigned char)(lo >> (8 * i)); scr[(8 * c + 4 + i) * 64 + slot] = (unsigned char)(hi >> (8 * i)); } }
        LDS_WAIT(); asm volatile("" ::: "memory");
        for (int it = 0; it < DVt / 16; ++it) { const int q = it * 64 + lane; *(GAS v4u*)(dst + 16 * q) = *(const LAS v4u*)(scr + 16 * q); }
        LDS_WAIT(); asm volatile("" ::: "memory");
    }
}
__device__ __forceinline__ void phase_quant_gu(KArgs A, LAS unsigned char* L, int gw, int NGW, int wave, int lane) {
    unsigned char* ws = A->ws; LAS float* scr = (LAS float*)(L + RING_OFF + wave * 16384);
    constexpr int I_FF = (DM / 64) * (DFF / 32);
    if (DENSE_I8) for (int it = gw; it < 2 * I_FF; it += NGW) { const int mtx = it / I_FF, sub = it % I_FF; ConvDesc d{A->in[12 + mtx], ws + WS_WGU_D, DM, DFF, 2 + mtx, 0}; f32x4 v[8];
        conv_load(d, sub, lane, v); conv_store_i8(d, sub, lane, v, scr, (gu32*)(ws + WS_CTL) + CW_CMAX + mtx * DFF, (float*)(ws + WS_SWGU)); }
    if (PROJ_I8) { constexpr int I_IN = (DM / 64) * (INW / 32), I_OUT = (DM / 64) * (DM / 32);
        for (int it = gw; it < 2 * I_IN + 2 * I_OUT; it += NGW) { f32x4 v[8];
            if (it < 2 * I_IN) { if (!PROJ_I8_IN) continue; const int l = it / I_IN, sub = it % I_IN; ConvDesc d{A->in[1] + (size_t)l * DM * INW, ws + WS_WIN + (size_t)l * INW * DM, DM, INW, 1, 0};
                conv_load(d, sub, lane, v); conv_store_i8(d, sub, lane, v, scr, (gu32*)(ws + WS_CTL) + CW_CMAX_IN + l * INW, (float*)(ws + WS_SWIN) + l * INW); }
            else { if (!PROJ_I8_OUT) continue; const int r = it - 2 * I_IN, l = r / I_OUT, sub = r % I_OUT; ConvDesc d{A->in[2] + (size_t)l * DM * DM, ws + WS_WOUT + (size_t)l * DM * DM, DM, DM, 0, 0};
                conv_load(d, sub, lane, v); conv_store_i8(d, sub, lane, v, scr, (gu32*)(ws + WS_CTL) + CW_CMAX_OUT + l * DM, (float*)(ws + WS_SWOUT) + l * DM); } } }
}
#ifndef MK_PER_PHASE
#define MK_PER_PHASE 0
#endif
#ifndef PROBE_BREP
#define PROBE_BREP 1
#endif
#ifndef PROBE_P0
#define PROBE_P0 1
#endif
#ifndef PROBE_G1
#define PROBE_G1 1
#endif
#ifndef PROBE_G2
#define PROBE_G2 1
#endif
#ifndef PROBE_G3
#define PROBE_G3 1
#endif
#ifndef PROBE_G4
#define PROBE_G4 1
#endif
#ifndef PROBE_T2
#define PROBE_T2 1
#endif
#ifndef MK_PH_HI
#define MK_PH_HI 1000
#endif
constexpr int N_PHASES = 31;
constexpr int TE_OFF = LDSCTL_OFF + 1024;
__device__ __forceinline__ int fill_tile_experts(gu32* cnt, LAS int* te, int tid) {
    int cn[8], ps[8], pe[8]; load_layout(cnt, cn, ps, pe);
    for (int i = tid; i < 528; i += NWAVES * 64) { const int row = i * 256; int e = 0;
#pragma unroll
        for (int j = 0; j < 7; ++j) e += (row >= pe[j]) ? 1 : 0;
        te[i] = e; }
    __syncthreads();
    return pe[7] / 256;
}
#define IN() (lo <= ph && ph < hi)
#define SEAM() do { if (lo <= ph && ph + 1 < hi) xcd_barrier(bar); ++ph; } while (0)
#define TIDO() int tid; asm volatile("v_mbcnt_lo_u32_b32 %0, -1, 0\n\tv_mbcnt_hi_u32_b32 %0, -1, %0" : "=v"(tid)); tid += wave_s * 64
#define LANE (tid & 63)
#define WAVE (__builtin_amdgcn_readfirstlane(tid >> 6))
#define GW (vcu * NWAVES + WAVE)
#define NGW (G * NWAVES)
#define LCNT ((LAS unsigned*)(L + LDSCTL_OFF))
#define PSL ((LAS int*)(L + LDSCTL_OFF + 64))
#define TE ((LAS int*)(L + TE_OFF))
template <int LAYER>
__device__ __forceinline__ void layer_body(LAS unsigned char* L, unsigned char* lds, const XcdBarrier& bar, int lo, int hi, int& ph, int G, int bx, int vcu, int wave_s) {
    constexpr int layer = LAYER;
    constexpr bool moe = (LAYER & 1) != 0;
    if (IN()) {
        KArgs A = kargs(); unsigned char* ws = A->ws;
        pg8::StaticOrder S; S.init(NTOK / 256, INW / 256, G, bx, 0);
        if constexpr (PROJ_I8_IN) {
            pg8::Gemm g{(const bf16*)(ws + WS_HN), (const bf16*)(ws + WS_WIN + (size_t)layer * INW * DM), NTOK, INW, DM / 2};
            pg8::EpiInProjI8 E{ws, WS_QA, WS_KA, WS_VA, WS_QB, WS_KB, WS_VB, A->in[7] + 64 * layer, A->in[8] + 64 * layer, attn_body::C2, (const float*)(ws + WS_SA), (const float*)(ws + WS_SWIN) + layer * INW};
            pg8::gemm_phase<pg8::EpiInProjI8, pg8::StaticOrder, true, true, false, true>(L + RING_OFF, g, S, E, wave_s);
        } else {
        pg8::Gemm g{(const bf16*)(ws + WS_HN), (const bf16*)(ws + WS_WIN) + (size_t)layer * INW * DM, NTOK, INW, DM};
        pg8::EpiInProj E{ws, WS_QA, WS_KA, WS_VA, WS_QB, WS_KB, WS_VB, A->in[7] + 64 * layer, A->in[8] + 64 * layer, attn_body::C2};
        for (int rep_ = 0; rep_ < PROBE_G1; ++rep_) pg8::gemm_phase<pg8::EpiInProj, pg8::StaticOrder, true, true>(L + RING_OFF, g, S, E, wave_s);
        }
    }
    SEAM();
    if (IN()) { TIDO(); unsigned char* ws = kargs()->ws; phase_vt((const bf16*)(ws + WS_VA), (const bf16*)(ws + WS_VB), ws + WS_VT8, L + RING_OFF + WAVE * 16384, GW, NGW, LANE); }
    SEAM();
    if (IN()) {
        for (int i = 0;; ++i) {
            int b, st, qb; bool grpB;
            if (G == 256) { if (i >= 16) break; const int grp = vcu >> 3, s = i >> 2; b = grp >> 2; grpB = s >= 2; st = 4 * (s & 1) + (grp & 3); qb = (vcu & 7) + 8 * (i & 3); }
            else { const int Lu = i * G + vcu; if (Lu >= 4096) break; grpB = Lu >= 2048; qb = Lu & 31; const int sm = (Lu & 2047) >> 5; b = sm >> 3; st = sm & 7; }
            unsigned char* ws = kargs()->ws;
            typedef attn_body::bf16 abf;
            const long rb = (long)b * SEQL, qrow = rb + 256 * qb;
            if (!grpB) { const int hq = st, kh = hq >> 2;
                attn_body::attn_unit8<64>((const abf*)(ws + WS_QA) + 64 * hq + qrow * 512, 512, (const abf*)(ws + WS_KA) + 64 * kh + rb * 128, 128, ws + WS_VT8 + (size_t)(b * 2 + kh) * 128 * 4096,
                                          (abf*)(ws + WS_OA) + 64 * hq + qrow * 512, 512, (char*)lds + RING_OFF, wave_s); }
            else for (int rep_ = 0; rep_ < PROBE_BREP; ++rep_) { const int h = st >> 1, m = st & 1;
                attn_body::attn_unit8<128>((const abf*)(ws + WS_QB) + 64 * st + qrow * 512, 512, (const abf*)(ws + WS_KB) + 64 * st + rb * 512, 512, ws + WS_VT8 + (size_t)8 * MiB + (size_t)(b * 4 + h) * 128 * 8192,
                                           (abf*)(ws + WS_OB) + 512 * m + 128 * h + qrow * 1024, 1024, (char*)lds + RING_OFF, wave_s); }
        }
    }
    SEAM();
    if (IN()) { TIDO(); KArgs A = kargs(); unsigned char* ws = A->ws; const float lam_init = 0.8f - 0.6f * expf(-0.3f * (float)layer);
        for (int rep_ = 0; rep_ < PROBE_T2; ++rep_) phase_t2((const bf16*)(ws + WS_OA), (const bf16*)(ws + WS_OB), (bf16*)(ws + WS_AO), A->in[9] + 512 * layer, A->in[11] + 128 * layer, A->in[10] + 256 * layer, lam_init, GW, NGW, LANE); }
    SEAM();
    if (IN()) {
        unsigned char* ws = kargs()->ws;
        pg8::StaticOrder S; S.init(NTOK / 256, DM / 256, G, bx, 0);
        if constexpr (PROJ_I8_OUT) {
            pg8::Gemm g{(const bf16*)(ws + WS_AO), (const bf16*)(ws + WS_WOUT + (size_t)layer * DM * DM), NTOK, DM, DM / 2};
            pg8::EpiBf16I8 E{(bf16*)(ws + WS_MIX), DM, (const float*)(ws + WS_SA2), (const float*)(ws + WS_SWOUT) + layer * DM};
            pg8::gemm_phase<pg8::EpiBf16I8, pg8::StaticOrder, true, true, false, true>(L + RING_OFF, g, S, E, wave_s);
        } else {
        pg8::Gemm g{(const bf16*)(ws + WS_AO), (const bf16*)(ws + WS_WOUT) + (size_t)layer * DM * DM, NTOK, DM, DM};
        pg8::EpiBf16 E{(bf16*)(ws + WS_MIX), DM};
        for (int rep_ = 0; rep_ < PROBE_G2; ++rep_) pg8::gemm_phase<pg8::EpiBf16, pg8::StaticOrder, true, true>(L + RING_OFF, g, S, E, wave_s);
        }
    }
    SEAM();
    if (IN()) {
        TIDO(); KArgs A = kargs(); unsigned char* ws = A->ws;
        const float* hsrc = layer == 0 ? A->in[0] : A->out;
        if constexpr (moe) phase_t3<true>(hsrc, A->out, (const bf16*)(ws + WS_MIX), (bf16*)(ws + WS_HN), A->in[4] + DM * layer, A->in[5] + DM * layer, A->in[15], (v4u*)(ws + WS_TOK), (unsigned*)(ws + WS_WGB), (gu32*)(ws + WS_CTL) + CW_CNT, LCNT, (LAS f32x4*)(L + RING_OFF), vcu, G, WAVE, LANE, tid);
        else phase_t3<false, DENSE_F8 != 0, DENSE_I8 != 0>(hsrc, A->out, (const bf16*)(ws + WS_MIX), (bf16*)(ws + WS_HN), A->in[4] + DM * layer, A->in[5] + DM * layer, A->in[15], (v4u*)(ws + WS_TOK), (unsigned*)(ws + WS_WGB), (gu32*)(ws + WS_CTL) + CW_CNT, LCNT, (LAS f32x4*)(L + RING_OFF), vcu, G, WAVE, LANE, tid);
    }
    SEAM();
    if constexpr (moe) { if (IN()) { TIDO(); unsigned char* ws = kargs()->ws; phase_gather(ws + WS_HN, ws + WS_XS, (const v4u*)(ws + WS_TOK), (const unsigned*)(ws + WS_WGB), (gu32*)(ws + WS_CTL) + CW_CNT, PSL, GW, NGW, LANE, tid); } SEAM(); }
    if constexpr (!moe) {
        for (int c = 0; c < 2; ++c) {
            const int pm0 = c * CHUNK_TILES;
            if (IN()) {
                unsigned char* ws = kargs()->ws;
                pg8::StaticOrder S; S.init(CHUNK_TILES, 2 * DFF / 256, G, bx, pm0);
                if constexpr (DENSE_I8) {
                    pg8::Gemm g{(const bf16*)(ws + WS_HN), (const bf16*)(ws + WS_WGU_D), 0, 2 * DFF, DM / 2};
                    pg8::EpiSwiGLUI8 E{(bf16*)(ws + WS_ACT) - (size_t)pm0 * 256 * DFF, DFF, (const float*)(ws + WS_SA), (const float*)(ws + WS_SWGU)};
                    pg8::gemm_phase<pg8::EpiSwiGLUI8, pg8::StaticOrder, true, true, false, true>(L + RING_OFF, g, S, E, wave_s);
                } else if constexpr (DENSE_F8) {
                    pg8::Gemm g{(const bf16*)(ws + WS_HN), (const bf16*)(ws + WS_WGU_D), 0, 2 * DFF, DM / 2};
                    pg8::EpiSwiGLU8 E{ws + WS_ACT - (size_t)pm0 * 256 * DFF, DFF, 1.0f / (A8SCALE * W8SCALE), H8SCALE};
                    pg8::gemm_phase<pg8::EpiSwiGLU8, pg8::StaticOrder, true, true, true>(L + RING_OFF, g, S, E, wave_s);
                } else {
                    pg8::Gemm g{(const bf16*)(ws + WS_HN), (const bf16*)(ws + WS_WGU_D), 0, 2 * DFF, DM};
                    pg8::EpiSwiGLU E{(bf16*)(ws + WS_ACT) - (size_t)pm0 * 256 * DFF, DFF};
                    for (int rep_ = 0; rep_ < PROBE_G3; ++rep_) pg8::gemm_phase<pg8::EpiSwiGLU, pg8::StaticOrder, true, true>(L + RING_OFF, g, S, E, wave_s);
                }
            }
            SEAM();
            if (IN()) {
                unsigned char* ws = kargs()->ws;
                pg8::StaticOrder S; S.init(CHUNK_TILES, DM / 256, G, bx, pm0);
                if constexpr (DENSE_F8) {
                    pg8::Gemm g{(const bf16*)(ws + WS_ACT - (size_t)pm0 * 256 * DFF), (const bf16*)(ws + WS_WDN_D), 0, DM, DFF / 2};
                    pg8::EpiBf16S E{(bf16*)(ws + WS_F), DM, 1.0f / (H8SCALE * W8SCALE)};
                    pg8::gemm_phase<pg8::EpiBf16S, pg8::StaticOrder, true, true, true>(L + RING_OFF, g, S, E, wave_s);
                } else {
                    pg8::Gemm g{(const bf16*)(ws + WS_ACT) - (size_t)pm0 * 256 * DFF, (const bf16*)(ws + WS_WDN_D), 0, DM, DFF};
                    pg8::EpiBf16 E{(bf16*)(ws + WS_F), DM};
                    for (int rep_ = 0; rep_ < PROBE_G4; ++rep_) pg8::gemm_phase<pg8::EpiBf16, pg8::StaticOrder, true, true>(L + RING_OFF, g, S, E, wave_s);
                }
            }
            SEAM();
        }
    } else {
        for (int c = 0; c < 5; ++c) {
            const int pm0 = c * CHUNK_TILES;
            if (IN()) {
                TIDO(); unsigned char* ws = kargs()->ws;
                const int n_used = fill_tile_experts((gu32*)(ws + WS_CTL) + CW_CNT, TE, tid);
                int nt = n_used - pm0; nt = nt > CHUNK_TILES ? CHUNK_TILES : nt;
                if (nt > 0) {
                    pg8::Gemm g{(const bf16*)(ws + WS_XS), (const bf16*)(ws + WS_WGU_M), 0, 2 * DFF, DM / 2};
                    pg8::StaticOrder S; S.init(nt, 2 * DFF / 256, G, bx, pm0); S.estride = (unsigned)(2 * DFF * DM); S.te = TE;
                    pg8::EpiSwiGLU8 E{ws + WS_ACT8 - (size_t)pm0 * 256 * DFF, DFF, 1.0f / (A8SCALE * W8SCALE), H8SCALE};
                    for (int rep_ = 0; rep_ < PROBE_G3; ++rep_) pg8::gemm_phase<pg8::EpiSwiGLU8, pg8::StaticOrder, true, true, true>(L + RING_OFF, g, S, E, wave_s);
                }
            }
            SEAM();
            if (IN()) {
                TIDO(); unsigned char* ws = kargs()->ws;
                const int n_used = fill_tile_experts((gu32*)(ws + WS_CTL) + CW_CNT, TE, tid);
                int nt = n_used - pm0; nt = nt > CHUNK_TILES ? CHUNK_TILES : nt;
                if (nt > 0) {
                    pg8::Gemm g{(const bf16*)(ws + WS_ACT8 - (size_t)pm0 * 256 * DFF), (const bf16*)(ws + WS_WDN_M), 0, DM, DFF / 2};
                    pg8::StaticOrder S; S.init(nt, DM / 256, G, bx, pm0); S.estride = (unsigned)(DM * DFF); S.te = TE;
                    pg8::EpiBf16S E{(bf16*)(ws + WS_YS), DM, 1.0f / (H8SCALE * W8SCALE)};
                    for (int rep_ = 0; rep_ < PROBE_G4; ++rep_) pg8::gemm_phase<pg8::EpiBf16S, pg8::StaticOrder, true, true, true>(L + RING_OFF, g, S, E, wave_s);
                }
            }
            SEAM();
        }
    }
    if (IN()) {
        TIDO(); KArgs A = kargs(); unsigned char* ws = A->ws;
        if constexpr (moe) phase_t4<true, false>(A->out, (const bf16*)(ws + WS_YS), (const v4u*)(ws + WS_TOK), (const unsigned*)(ws + WS_WGB), (gu32*)(ws + WS_CTL) + CW_CNT, PSL, A->in[6] + DM * layer, nullptr, (bf16*)(ws + WS_HN), GW, NGW, LANE, tid);
        else phase_t4<false, true>(A->out, (const bf16*)(ws + WS_F), (const v4u*)(ws + WS_TOK), (const unsigned*)(ws + WS_WGB), (gu32*)(ws + WS_CTL) + CW_CNT, PSL, A->in[6] + DM * layer, A->in[3] + DM * (layer + 1), (bf16*)(ws + WS_HN), GW, NGW, LANE, tid);
    }
    if constexpr (LAYER + 1 < NLAYER) SEAM();
}
__global__ void __launch_bounds__(NWAVES * 64, 2) fwd_kernel(Args args_unused) {
    extern __shared__ __attribute__((aligned(16))) unsigned char lds[];
    LAS unsigned char* L = (LAS unsigned char*)lds;
    const int tid0 = threadIdx.x; const int wave_s = __builtin_amdgcn_readfirstlane(tid0 >> 6);
    const int G = gridDim.x, bx = blockIdx.x;
    const int vcu = (G % 8 == 0) ? (bx % 8) * (G / 8) + bx / 8 : bx;
    for (int u = tid0; u < (LDS_BYTES - LDSCTL_OFF) / 4; u += NWAVES * 64) ((LAS unsigned*)(L + LDSCTL_OFF))[u] = 0u;
    __syncthreads();
    XcdBarrier bar;
    int lo, hi;
    { KArgs A = kargs(); lo = A->ph_lo; hi = A->ph_hi; bar = xcd_barrier_post((unsigned*)(A->ws + WS_CTL) + CW_BAR, (volatile LAS unsigned*)(L + MISC_OFF) + 8); }
    int ph = 0;

    if (IN()) { for (int rep_ = 0; rep_ < PROBE_P0; ++rep_) { TIDO(); phase_prologue(kargs(), L, GW, NGW, WAVE, LANE); } }
    SEAM();
    if (DENSE_I8 || PROJ_I8) { if (IN()) { TIDO(); phase_quant_gu(kargs(), L, GW, NGW, WAVE, LANE); } SEAM(); }
    layer_body<0>(L, lds, bar, lo, hi, ph, G, bx, vcu, wave_s);
    layer_body<1>(L, lds, bar, lo, hi, ph, G, bx, vcu, wave_s);
#undef IN
#undef SEAM
}

extern "C" void kernel_launch(void* const* d_in, const int* in_sizes, int n_in, void* d_out, int out_size, void* d_ws, size_t ws_size, hipStream_t stream) {
    static int grid = 0;
    if (grid == 0) {
        if (n_in != 19 || in_sizes[0] != NTOK * DM || out_size != NTOK * DM || ws_size < WS_END) {
            fprintf(stderr, "kernel_launch: built for 19 inputs, x/out of %d floats, >= %zu bytes of workspace; got n_in %d, in0 %d, out %d, ws %zu; nothing launched\n", NTOK * DM, (size_t)WS_END, n_in, n_in > 0 ? in_sizes[0] : -1, out_size, ws_size);
            grid = -1; return; }
        int dev = 0, cus = 0, per_cu = 0;
        if (hipGetDevice(&dev) != hipSuccess || hipDeviceGetAttribute(&cus, hipDeviceAttributeMultiprocessorCount, dev) != hipSuccess) { fprintf(stderr, "kernel_launch: device query failed\n"); grid = -1; return; }
        if (hipFuncSetAttribute((const void*)fwd_kernel, hipFuncAttributeMaxDynamicSharedMemorySize, LDS_BYTES) != hipSuccess) { fprintf(stderr, "kernel_launch: hipFuncSetAttribute failed\n"); grid = -1; return; }
        if (hipOccupancyMaxActiveBlocksPerMultiprocessor(&per_cu, (const void*)fwd_kernel, NWAVES * 64, LDS_BYTES) != hipSuccess || per_cu < 1)
            fprintf(stderr, "kernel_launch: note: occupancy query reports %d workgroups per CU\n", per_cu);
        (void)hipGetLastError();
        grid = cus;
    }
    if (grid < 0) return;
    if (hipMemsetAsync((char*)d_ws + WS_CTL, 0, CTL_ZERO_BYTES, stream) != hipSuccess) { fprintf(stderr, "kernel_launch: memset failed\n"); return; }
    Args a{};
    for (int i = 0; i < 19; ++i) a.in[i] = (const float*)d_in[i];
    a.out = (float*)d_out; a.ws = (unsigned char*)d_ws;
    const int ph_end = MK_PH_HI < N_PHASES ? MK_PH_HI : N_PHASES;
#if MK_PER_PHASE
    for (int p = 0; p < ph_end; ++p) { a.ph_lo = p; a.ph_hi = p + 1; hipLaunchKernelGGL(fwd_kernel, dim3(grid), dim3(NWAVES * 64), LDS_BYTES, stream, a); }
#else
    a.ph_lo = 0; a.ph_hi = ph_end;
    hipLaunchKernelGGL(fwd_kernel, dim3(grid), dim3(NWAVES * 64), LDS_BYTES, stream, a);
#endif
    const hipError_t le = hipPeekAtLastError();
    if (le != hipSuccess) fprintf(stderr, "kernel_launch: launch failed: %s\n", hipGetErrorName(le));
}
```
